# Optimizing an MI355X kernel written in HIP

```python
import math
import jax, jax.numpy as jnp
from jax import lax
import numpy as np

D_MODEL = 1024
BATCH = 1
SEQ = 16384
DEPTH = 4

N_MIXERS = 3
N_MEM = 256
GRID_W = 64
HEAD_DIM = 64
ROPE_THETA = 10000.0
LN_EPS = 1e-5
RMS_EPS = 1e-6
MASK_VALUE = -1e30

FNET_GROUPS = 4
GQA_Q_HEADS = D_MODEL // HEAD_DIM
GQA_KV_HEADS = GQA_Q_HEADS // 4
Q_BLOCK = 128
DIL_PAIRS = ((128, 1), (512, 4), (2048, 16))
DIL_GROUPS = len(DIL_PAIRS)
DIL_HEADS = D_MODEL // HEAD_DIM
DIL_WIDTH = DIL_GROUPS * DIL_HEADS * HEAD_DIM
MEM_HEADS = 4
MEM_WIDTH = MEM_HEADS * HEAD_DIM
BRANCH_WIDTH = D_MODEL
INNER = BRANCH_WIDTH + MEM_WIDTH
TAIL = INNER + MEM_WIDTH
COLS_A = TAIL
COLS_B = GQA_Q_HEADS * HEAD_DIM + 2 * GQA_KV_HEADS * HEAD_DIM + TAIL
COLS_C = 3 * DIL_WIDTH + TAIL
N_LAYERS_A = (DEPTH + 2) // 3
N_LAYERS_B = (DEPTH + 1) // 3
N_LAYERS_C = DEPTH // 3
DEEPNORM_ALPHA = (2.0 * DEPTH) ** 0.25
DEEPNORM_BETA = (8.0 * DEPTH) ** -0.25

kernel_name = "hybrid_fnet_gqa_dilated_encoder"


def layer_norm(x, g, b):
    xf = x.astype(jnp.float32)
    mu = jnp.mean(xf, axis=-1, keepdims=True)
    var = jnp.mean(jnp.square(xf - mu), axis=-1, keepdims=True)
    y = (xf - mu) * lax.rsqrt(var + LN_EPS) * g.astype(jnp.float32) + b.astype(jnp.float32)
    return y.astype(x.dtype)


def rms_norm(x, g):
    xf = x.astype(jnp.float32)
    return xf * lax.rsqrt(jnp.mean(jnp.square(xf), axis=-1, keepdims=True) + RMS_EPS) * g.astype(jnp.float32)


def rope_angles(pos, dim):
    inv_freq = ROPE_THETA ** (-(jnp.arange(0, dim, 2, dtype=jnp.float32) / dim))
    return pos.astype(jnp.float32)[:, None] * inv_freq[None, :]


def apply_rope(x, ang):
    x1, x2 = jnp.split(x, 2, axis=-1)
    c = jnp.cos(ang)[:, None, :]
    s = jnp.sin(ang)[:, None, :]
    return jnp.concatenate([x1 * c - x2 * s, x2 * c + x1 * s], axis=-1)


def apply_axial_rope(x, ang_row, ang_col):
    half = x.shape[-1] // 2
    return jnp.concatenate([apply_rope(x[..., :half], ang_row), apply_rope(x[..., half:], ang_col)], axis=-1)


def fourier_mix(h):
    B, S, D = h.shape
    hg = h.astype(jnp.float32).reshape(B, S, FNET_GROUPS, D // FNET_GROUPS)
    y = jnp.fft.fftn(hg, axes=(1, 3), norm="ortho").real
    return y.astype(jnp.float32).reshape(B, S, D)


def gqa_block_attention(q, k, v):
    B, S, Hq, Dh = q.shape
    Hkv = k.shape[2]
    G = Hq // Hkv
    nb = S // Q_BLOCK
    qb = q.reshape(B, nb, Q_BLOCK, Hkv, G, Dh).transpose(1, 0, 3, 4, 2, 5)
    kt = k.transpose(0, 2, 1, 3)
    vt = v.transpose(0, 2, 1, 3)
    scale = Dh ** -0.5

    def one_block(qblk):
        s = jnp.einsum("bhgqd,bhkd->bhgqk", qblk, kt) * scale
        p = jax.nn.softmax(s, axis=-1)
        return jnp.einsum("bhgqk,bhkd->bhgqd", p, vt)

    o = lax.map(one_block, qb)
    return o.transpose(1, 0, 4, 2, 3, 5).reshape(B, S, Hq * Dh)


def dilated_group_attention(q, k, v, dil, side):
    B, S, H, Dh = q.shape
    L = S // dil
    nb = -(-L // side)
    Lp = nb * side

    def to_classes(t):
        t = t.reshape(B, L, dil, H, Dh).transpose(0, 2, 1, 3, 4)
        return jnp.pad(t, ((0, 0), (0, 0), (0, Lp - L), (0, 0), (0, 0)))

    qc, kc, vc = to_classes(q), to_classes(k), to_classes(v)
    qb = qc.reshape(B, dil, nb, side, H, Dh)

    def band(t):
        tp = jnp.pad(t, ((0, 0), (0, 0), (side, side), (0, 0), (0, 0)))
        return jnp.concatenate(
            [tp[:, :, i * side: i * side + Lp].reshape(B, dil, nb, side, H, Dh) for i in range(3)], axis=3)

    kb, vb = band(kc), band(vc)
    qi = jnp.arange(side)
    kj = jnp.arange(3 * side) - side
    in_window = jnp.abs(kj[None, :] - qi[:, None]) <= side
    kabs = jnp.arange(nb)[:, None] * side + kj[None, :]
    valid = (kabs >= 0) & (kabs < L)
    mask = in_window[None, :, :] & valid[:, None, :]

    s = jnp.einsum("bcnqhd,bcnkhd->bcnhqk", qb, kb) * (Dh ** -0.5)
    s = jnp.where(mask[None, None, :, None, :, :], s, MASK_VALUE)
    lse = jax.nn.logsumexp(s, axis=-1)
    p = jnp.exp(s - lse[..., None])
    o = jnp.einsum("bcnhqk,bcnkhd->bcnqhd", p, vb)
    o = o.reshape(B, dil, Lp, H, Dh)[:, :, :L].transpose(0, 2, 1, 3, 4).reshape(B, S, H, Dh)
    lse = lse.transpose(0, 1, 2, 4, 3).reshape(B, dil, Lp, H)[:, :, :L]
    lse = lse.transpose(0, 2, 1, 3).reshape(B, S, H)
    return o, lse


def memory_attention(qm, mk, mv):
    s = jnp.einsum("bshd,bmhd->bhsm", qm, mk) * (qm.shape[-1] ** -0.5)
    p = jax.nn.softmax(s, axis=-1)
    o = jnp.einsum("bhsm,bmhd->bshd", p, mv)
    return o.reshape(qm.shape[0], qm.shape[1], -1)


def setup_inputs(seed: int = 0) -> dict:
    key = jax.random.key(seed)
    ks = jax.random.split(key, 16)
    f32 = jnp.float32
    w_in_scale = D_MODEL ** -0.5
    return {
        "x": jax.random.normal(ks[0], (BATCH, SEQ, D_MODEL), f32),
        "mem": jax.random.normal(ks[1], (BATCH, N_MEM, D_MODEL), f32),
        "ln_in_g": 1.0 + 0.02 * jax.random.normal(ks[2], (D_MODEL,), f32),
        "ln_in_b": 0.02 * jax.random.normal(ks[3], (D_MODEL,), f32),
        "w_mem_kv": jax.random.normal(ks[4], (D_MODEL, 2 * MEM_WIDTH), f32) * w_in_scale,
        "w_in_a": jax.random.normal(ks[5], (N_LAYERS_A, D_MODEL, COLS_A), f32) * w_in_scale,
        "w_in_b": jax.random.normal(ks[6], (N_LAYERS_B, D_MODEL, COLS_B), f32) * w_in_scale,
        "q_norm_g": 1.0 + 0.02 * jax.random.normal(ks[7], (N_LAYERS_B, HEAD_DIM), f32),
        "k_norm_g": 1.0 + 0.02 * jax.random.normal(ks[8], (N_LAYERS_B, HEAD_DIM), f32),
        "w_in_c": jax.random.normal(ks[9], (N_LAYERS_C, D_MODEL, COLS_C), f32) * w_in_scale,
        "w_out": jax.random.normal(ks[10], (DEPTH, INNER, D_MODEL), f32) * (INNER ** -0.5) * DEEPNORM_BETA,
        "ln_g": 1.0 + 0.02 * jax.random.normal(ks[11], (DEPTH, D_MODEL), f32),
        "ln_b": 0.02 * jax.random.normal(ks[12], (DEPTH, D_MODEL), f32),
    }


def reference(x, mem, ln_in_g, ln_in_b, w_mem_kv, w_in_a, w_in_b, q_norm_g, k_norm_g, w_in_c, w_out, ln_g, ln_b):
    B, S, D = x.shape
    ROWS = S // GRID_W
    t = jnp.arange(S)
    row = jnp.repeat(jnp.arange(ROWS), GRID_W, total_repeat_length=S)
    col = jnp.tile(jnp.arange(GRID_W), ROWS)
    ang_1d = rope_angles(t, HEAD_DIM)
    ang_row = rope_angles(row, HEAD_DIM // 2)
    ang_col = rope_angles(col, HEAD_DIM // 2)

    mkv = jnp.matmul(mem, w_mem_kv).astype(jnp.float32).reshape(B, N_MEM, 2, MEM_HEADS, HEAD_DIM)
    mk, mv = mkv[:, :, 0], mkv[:, :, 1]

    h = layer_norm(x, ln_in_g, ln_in_b)
    qw = GQA_Q_HEADS * HEAD_DIM
    kvw = GQA_KV_HEADS * HEAD_DIM
    for i in range(DEPTH):
        kind = i % N_MIXERS
        j = i // N_MIXERS
        if kind == 0:
            proj = jnp.matmul(h, w_in_a[j]).astype(jnp.float32)
            branch = fourier_mix(h)
        elif kind == 1:
            proj = jnp.matmul(h, w_in_b[j]).astype(jnp.float32)
            q = proj[..., :qw].reshape(B, S, GQA_Q_HEADS, HEAD_DIM)
            k = proj[..., qw:qw + kvw].reshape(B, S, GQA_KV_HEADS, HEAD_DIM)
            v = proj[..., qw + kvw:qw + 2 * kvw].reshape(B, S, GQA_KV_HEADS, HEAD_DIM)
            q = apply_axial_rope(rms_norm(q, q_norm_g[j]), ang_row, ang_col)
            k = apply_axial_rope(rms_norm(k, k_norm_g[j]), ang_row, ang_col)
            branch = gqa_block_attention(q, k, v)
        else:
            proj = jnp.matmul(h, w_in_c[j]).astype(jnp.float32)
            qkv = proj[..., :3 * DIL_WIDTH].reshape(B, S, 3, DIL_GROUPS, DIL_HEADS, HEAD_DIM)
            outs = []
            lses = []
            for g, (window, dil) in enumerate(DIL_PAIRS):
                qg = apply_rope(qkv[:, :, 0, g], ang_1d)
                kg = apply_rope(qkv[:, :, 1, g], ang_1d)
                og, lg = dilated_group_attention(qg, kg, qkv[:, :, 2, g], dil, window // (2 * dil))
                outs.append(og)
                lses.append(lg)
            wts = jax.nn.softmax(jnp.stack(lses, axis=0), axis=0)
            branch = jnp.sum(wts[..., None] * jnp.stack(outs, axis=0), axis=0).reshape(B, S, BRANCH_WIDTH)
        tail = proj[..., proj.shape[-1] - TAIL:]
        gate = tail[..., :INNER]
        qm = tail[..., INNER:].reshape(B, S, MEM_HEADS, HEAD_DIM)
        mem_out = memory_attention(qm, mk, mv)
        y = jnp.concatenate([branch, mem_out], axis=-1) * jax.nn.silu(gate)
        y = jnp.matmul(y.astype(h.dtype), w_out[i])
        h = layer_norm(DEEPNORM_ALPHA * h + y.astype(h.dtype), ln_g[i], ln_b[i])
    return h
```

```cpp
#include <hip/hip_runtime.h>
#include <hip/hip_cooperative_groups.h>
#include <cstdio>
#include <cstdint>
namespace cg = cooperative_groups;

#define DEV __device__ __forceinline__
typedef unsigned short bf16_t;
typedef short bf16x8 __attribute__((ext_vector_type(8)));
typedef float f32x4 __attribute__((ext_vector_type(4)));
typedef unsigned u32x4 __attribute__((ext_vector_type(4)));
typedef unsigned u32x2 __attribute__((ext_vector_type(2)));

constexpr int S_ = 16384, DM = 1024;
constexpr float ALPHA = 1.681792830507429f;
constexpr float C2 = 0.125f * 1.4426950408889634f;
constexpr float LN_EPS = 1e-5f;
constexpr size_t MiB = 1u << 20;
constexpr size_t WS_WA = 2 * MiB, WS_WB = 8 * MiB, WS_WC = 14 * MiB, WS_WO = 35 * MiB, WS_WDFT = 45 * MiB, WS_MKV = 45 * MiB + 512 * 1024;
constexpr size_t WS_XN = 48 * MiB, WS_AR = 80 * MiB;
constexpr int NTHREADS = 512;
constexpr int NSTEPS = 32;

struct Params {
    const float *x, *mem, *ln_in_g, *ln_in_b, *w_mem_kv, *w_in_a, *w_in_b, *q_norm_g, *k_norm_g, *w_in_c, *w_out, *ln_g, *ln_b;
    float* out; unsigned char* ws;
    int s0, s1;
};

DEV float bf2f(bf16_t b) { return __uint_as_float(((unsigned)b) << 16); }
DEV bf16_t f2bf(float f) { unsigned u = __float_as_uint(f); return (bf16_t)((u + 0x7fffu + ((u >> 16) & 1u)) >> 16); }
DEV unsigned pk2(float lo, float hi) { return (unsigned)f2bf(lo) | ((unsigned)f2bf(hi) << 16); }
DEV float wave_sum(float v) {
#pragma unroll
    for (int o = 1; o < 64; o <<= 1) v += __shfl_xor(v, o);
    return v;
}
DEV float silu(float x) { return x / (1.f + __expf(-x)); }
DEV void load8(const bf16_t* p, float* o) {
    u32x4 v = *(const u32x4*)p;
    o[0] = __uint_as_float(v.x << 16); o[1] = __uint_as_float(v.x & 0xffff0000u);
    o[2] = __uint_as_float(v.y << 16); o[3] = __uint_as_float(v.y & 0xffff0000u);
    o[4] = __uint_as_float(v.z << 16); o[5] = __uint_as_float(v.z & 0xffff0000u);
    o[6] = __uint_as_float(v.w << 16); o[7] = __uint_as_float(v.w & 0xffff0000u);
}
DEV void store8(bf16_t* p, const float* o) {
    u32x4 v; v.x = pk2(o[0], o[1]); v.y = pk2(o[2], o[3]); v.z = pk2(o[4], o[5]); v.w = pk2(o[6], o[7]);
    *(u32x4*)p = v;
}
#define GTID ((size_t)blockIdx.x * blockDim.x + threadIdx.x)
#define GSZ ((size_t)gridDim.x * blockDim.x)

DEV void tconv(const float* src, int K, int Ntot, int ncols, bf16_t* dst, int mode) {
    const size_t total = (size_t)ncols * (K / 8);
    for (size_t idx = GTID; idx < total; idx += GSZ) {
        const int n = (int)(idx % ncols), kc = (int)(idx / ncols);
        int sc = n;
        if (mode == 1 && n < 9216) { const int g = n / 3072, rem = n % 3072, which = rem / 1024, r = rem % 1024; sc = which * 3072 + g * 1024 + r; }
        float v[8];
#pragma unroll
        for (int j = 0; j < 8; ++j) v[j] = src[(size_t)(kc * 8 + j) * Ntot + sc];
        store8(dst + (size_t)n * K + kc * 8, v);
    }
}
DEV void make_wdft(bf16_t* w) {
    for (size_t idx = GTID; idx < 512 * 256; idx += GSZ) {
        const int n = (int)(idx >> 8), c = (int)(idx & 255), which = n >> 8, l = n & 255;
        float s, co; sincospif((float)((l * c) & 255) / 128.f, &s, &co);
        w[idx] = f2bf(which == 0 ? co : -s);
    }
}
DEV void make_mkv(const float* mem, const float* w, float* mkv) {
    for (size_t idx = GTID; idx < 256 * 512; idx += GSZ) {
        const int m = (int)(idx >> 9), n = (int)(idx & 511);
        float a = 0.f;
        for (int k = 0; k < 1024; ++k) a += mem[m * 1024 + k] * w[(size_t)k * 512 + n];
        mkv[idx] = a;
    }
}
DEV void make_rope1d(float* tab) {
    for (size_t idx = GTID; idx < (size_t)S_ * 32; idx += GSZ) {
        const int t = (int)(idx >> 5), i = (int)(idx & 31);
        const float inv = powf(10000.f, -((float)(2 * i) / 64.f));
        const float a = (float)t * inv;
        tab[idx * 2] = cosf(a); tab[idx * 2 + 1] = sinf(a);
    }
}
DEV void ln_rows(const float* a, const float* y, float alpha, const float* g, const float* b, float* outH, bf16_t* outXN) {
    const int lane = threadIdx.x & 63, wpb = blockDim.x >> 6;
    const int gw = blockIdx.x * wpb + (threadIdx.x >> 6), nw = gridDim.x * wpb;
    for (int row = gw; row < S_; row += nw) {
        f32x4 v[4]; float s = 0.f;
#pragma unroll
        for (int j = 0; j < 4; ++j) {
            v[j] = *(const f32x4*)(a + (size_t)row * DM + j * 256 + lane * 4);
            if (y) { const f32x4 u = *(const f32x4*)(y + (size_t)row * DM + j * 256 + lane * 4); v[j] = v[j] * alpha + u; }
            s += (v[j].x + v[j].y) + (v[j].z + v[j].w);
        }
        const float mean = wave_sum(s) * (1.f / DM); float s2 = 0.f;
#pragma unroll
        for (int j = 0; j < 4; ++j) { v[j] = v[j] - mean; s2 += (v[j].x * v[j].x + v[j].y * v[j].y) + (v[j].z * v[j].z + v[j].w * v[j].w); }
        const float rstd = 1.f / sqrtf(wave_sum(s2) * (1.f / DM) + LN_EPS);
#pragma unroll
        for (int j = 0; j < 4; ++j) {
            const f32x4 gg = *(const f32x4*)(g + j * 256 + lane * 4), bb = *(const f32x4*)(b + j * 256 + lane * 4);
            const f32x4 o = v[j] * rstd * gg + bb;
            *(f32x4*)(outH + (size_t)row * DM + j * 256 + lane * 4) = o;
            u32x2 w; w.x = pk2(o.x, o.y); w.y = pk2(o.z, o.w);
            *(u32x2*)(outXN + (size_t)row * DM + j * 256 + lane * 4) = w;
        }
    }
}
DEV void gemm_simple(const bf16_t* A, int lda, const bf16_t* Bt, int ldb, int M, int N, int K, void* C, int ldc, int f32out) {
    const int lane = threadIdx.x & 63, wpb = blockDim.x >> 6;
    const int gw = blockIdx.x * wpb + (threadIdx.x >> 6), nw = gridDim.x * wpb;
    const int tn = N / 64, tiles = (M / 64) * tn, fr = lane & 15, fq = lane >> 4;
    for (int t = gw; t < tiles; t += nw) {
        const int tm = t / tn, tc = t % tn;
        f32x4 acc[4][4];
#pragma unroll
        for (int i = 0; i < 4; ++i)
#pragma unroll
            for (int j = 0; j < 4; ++j) acc[i][j] = (f32x4){0.f, 0.f, 0.f, 0.f};
        const bf16_t* ap = A + (size_t)(tm * 64 + fr) * lda + fq * 8;
        const bf16_t* bp = Bt + (size_t)(tc * 64 + fr) * ldb + fq * 8;
        for (int k0 = 0; k0 < K; k0 += 32) {
            bf16x8 a[4], b[4];
#pragma unroll
            for (int i = 0; i < 4; ++i) { a[i] = *(const bf16x8*)(ap + (size_t)i * 16 * lda + k0); b[i] = *(const bf16x8*)(bp + (size_t)i * 16 * ldb + k0); }
#pragma unroll
            for (int i = 0; i < 4; ++i)
#pragma unroll
                for (int j = 0; j < 4; ++j) acc[i][j] = __builtin_amdgcn_mfma_f32_16x16x32_bf16(a[i], b[j], acc[i][j], 0, 0, 0);
        }
#pragma unroll
        for (int i = 0; i < 4; ++i)
#pragma unroll
            for (int j = 0; j < 4; ++j)
#pragma unroll
                for (int r = 0; r < 4; ++r) {
                    const size_t off = (size_t)(tm * 64 + i * 16 + fq * 4 + r) * ldc + tc * 64 + j * 16 + fr;
                    if (f32out) ((float*)C)[off] = acc[i][j][r]; else ((bf16_t*)C)[off] = f2bf(acc[i][j][r]);
                }
    }
}
DEV int zc(int j) { return ((j >> 8) << 9) + (j & 255); }
DEV void fft_tab(float* tab) {
    __syncthreads();
    for (int i = threadIdx.x; i < 128; i += blockDim.x) { float s, c; sincospif((float)i / 64.f, &s, &c); tab[i] = c; tab[128 + i] = s; }
    __syncthreads();
}
DEV void fft_s1(const bf16_t* Z, bf16_t* T, float* tab) {
    fft_tab(tab);
    const size_t total = (size_t)S_ * 1024;
    for (size_t idx = GTID; idx < total; idx += GSZ) {
        const int j = (int)(idx & 1023), r = (int)(idx >> 10), k1 = r >> 7, s2 = r & 127, cj = zc(j);
        float ar = 0.f, ai = 0.f;
        for (int s1 = 0; s1 < 128; ++s1) {
            const int n = (s1 * k1) & 127; const float c = tab[n], s = tab[128 + n];
            const bf16_t* zp = Z + (size_t)(128 * s1 + s2) * 2048 + cj;
            const float zr = bf2f(zp[0]), zi = bf2f(zp[256]);
            ar += zr * c + zi * s; ai += zi * c - zr * s;
        }
        float ts, tc; sincospif((float)(s2 * k1) / 8192.f, &ts, &tc);
        const float tr = ar * tc + ai * ts, ti = ai * tc - ar * ts;
        T[(size_t)r * 2048 + cj] = f2bf(tr); T[(size_t)r * 2048 + cj + 256] = f2bf(ti);
    }
}
DEV void fft_s2(const bf16_t* T, bf16_t* BR, float* tab) {
    fft_tab(tab);
    const size_t total = (size_t)S_ * 1024;
    for (size_t idx = GTID; idx < total; idx += GSZ) {
        const int j = (int)(idx & 1023), k = (int)(idx >> 10), k1 = k & 127, k2 = k >> 7, cj = zc(j);
        float acc = 0.f;
        for (int s2 = 0; s2 < 128; ++s2) {
            const int n = (s2 * k2) & 127; const float c = tab[n], s = tab[128 + n];
            const bf16_t* tp = T + (size_t)(k1 * 128 + s2) * 2048 + cj;
            acc += bf2f(tp[0]) * c + bf2f(tp[256]) * s;
        }
        BR[(size_t)k * 1024 + j] = f2bf(acc * (1.f / 2048.f));
    }
}
DEV void qk_post(bf16_t* PROJ, const float* qg, const float* kg) {
    const size_t total = (size_t)S_ * 20 * 16;
    for (size_t idx = GTID; idx < total; idx += GSZ) {
        const int i = (int)(idx & 15), head = (int)((idx >> 4) % 20), t = (int)((idx >> 4) / 20);
        bf16_t* p = PROJ + (size_t)t * 3072 + head * 64;
        float a1 = bf2f(p[i]), a2 = bf2f(p[16 + i]), b1 = bf2f(p[32 + i]), b2 = bf2f(p[48 + i]);
        float ss = a1 * a1 + a2 * a2 + b1 * b1 + b2 * b2;
        ss += __shfl_xor(ss, 1); ss += __shfl_xor(ss, 2); ss += __shfl_xor(ss, 4); ss += __shfl_xor(ss, 8);
        const float r = 1.f / sqrtf(ss * (1.f / 64.f) + 1e-6f);
        const float* g = head < 16 ? qg : kg;
        a1 *= r * g[i]; a2 *= r * g[16 + i]; b1 *= r * g[32 + i]; b2 *= r * g[48 + i];
        const float frow = (float)(t >> 6), fcol = (float)(t & 63);
        const float sc = head < 16 ? C2 : 1.f;
        const float inv = powf(10000.f, -((float)(2 * i) / 32.f));
        const float ar = frow * inv, ac = fcol * inv;
        const float cr = cosf(ar), sr = sinf(ar), cc = cosf(ac), scn = sinf(ac);
        p[i] = f2bf((a1 * cr - a2 * sr) * sc); p[16 + i] = f2bf((a2 * cr + a1 * sr) * sc);
        p[32 + i] = f2bf((b1 * cc - b2 * scn) * sc); p[48 + i] = f2bf((b2 * cc + b1 * scn) * sc);
    }
}
DEV void attn_naive(const bf16_t* PROJ, bf16_t* BR, float* lds) {
    const int nth = blockDim.x, qblocks = S_ / nth, items = 16 * qblocks;
    float* Ks = lds; float* Vs = lds + 64 * 64;
    for (int it = blockIdx.x; it < items; it += gridDim.x) {
        const int hq = it / qblocks, qb = it % qblocks, kvh = hq >> 2, t = qb * nth + threadIdx.x;
        float q[64], o[64]; float m = -1e30f, l = 0.f;
#pragma unroll
        for (int c = 0; c < 8; ++c) load8(PROJ + (size_t)t * 3072 + hq * 64 + c * 8, q + c * 8);
#pragma unroll
        for (int d = 0; d < 64; ++d) o[d] = 0.f;
        for (int k0 = 0; k0 < S_; k0 += 64) {
            __syncthreads();
            for (int e = threadIdx.x; e < 64 * 8; e += nth) {
                const int r = e >> 3, c8 = e & 7; float tmp[8];
                load8(PROJ + (size_t)(k0 + r) * 3072 + 1024 + kvh * 64 + c8 * 8, tmp);
#pragma unroll
                for (int j = 0; j < 8; ++j) Ks[r * 64 + c8 * 8 + j] = tmp[j];
                load8(PROJ + (size_t)(k0 + r) * 3072 + 1280 + kvh * 64 + c8 * 8, tmp);
#pragma unroll
                for (int j = 0; j < 8; ++j) Vs[r * 64 + c8 * 8 + j] = tmp[j];
            }
            __syncthreads();
            for (int r = 0; r < 64; ++r) {
                float s = 0.f;
#pragma unroll
                for (int d = 0; d < 64; d += 4) { const f32x4 kk = *(const f32x4*)(Ks + r * 64 + d); s += q[d] * kk.x + q[d + 1] * kk.y + q[d + 2] * kk.z + q[d + 3] * kk.w; }
                if (s > m) { const float f = exp2f(m - s); l *= f;
#pragma unroll
                    for (int d = 0; d < 64; ++d) o[d] *= f;
                    m = s; }
                const float p = exp2f(s - m); l += p;
#pragma unroll
                for (int d = 0; d < 64; d += 4) { const f32x4 vv = *(const f32x4*)(Vs + r * 64 + d); o[d] += p * vv.x; o[d + 1] += p * vv.y; o[d + 2] += p * vv.z; o[d + 3] += p * vv.w; }
            }
        }
        const float rl = 1.f / l;
#pragma unroll
        for (int d = 0; d < 64; ++d) o[d] *= rl;
#pragma unroll
        for (int c = 0; c < 8; ++c) store8(BR + (size_t)t * 1024 + hq * 64 + c * 8, o + c * 8);
    }
    __syncthreads();
}
DEV void rope_c(bf16_t* QKV, const float* tab) {
    const size_t total = (size_t)S_ * 32;
    for (size_t idx = GTID; idx < total; idx += GSZ) {
        const int hh = (int)(idx & 31), t = (int)(idx >> 5);
        bf16_t* p = QKV + (size_t)t * 3072 + hh * 64;
        float x[64];
#pragma unroll
        for (int c = 0; c < 8; ++c) load8(p + c * 8, x + c * 8);
        const float sc = hh < 16 ? C2 : 1.f;
        const float* tb = tab + (size_t)t * 64;
#pragma unroll
        for (int i = 0; i < 32; ++i) {
            const float c = tb[2 * i], s = tb[2 * i + 1];
            const float a1 = x[i], a2 = x[32 + i];
            x[i] = (a1 * c - a2 * s) * sc; x[32 + i] = (a2 * c + a1 * s) * sc;
        }
#pragma unroll
        for (int c = 0; c < 8; ++c) store8(p + c * 8, x + c * 8);
    }
}
DEV void dil_naive(const bf16_t* QKV, float* OACC, float* ML, int g) {
    const int dil = g == 0 ? 1 : (g == 1 ? 4 : 16);
    const size_t total = (size_t)16 * S_;
    for (size_t idx = GTID; idx < total; idx += GSZ) {
        const int head = (int)(idx >> 14), t = (int)(idx & 16383);
        float q[64], o[64]; float m, l;
#pragma unroll
        for (int c = 0; c < 8; ++c) load8(QKV + (size_t)t * 3072 + head * 64 + c * 8, q + c * 8);
        if (g == 0) { m = -1e30f; l = 0.f;
#pragma unroll
            for (int d = 0; d < 64; ++d) o[d] = 0.f;
        } else {
            m = ML[((size_t)t * 16 + head) * 2]; l = ML[((size_t)t * 16 + head) * 2 + 1];
#pragma unroll
            for (int d = 0; d < 64; d += 4) { const f32x4 v = *(const f32x4*)(OACC + (size_t)t * 1024 + head * 64 + d); o[d] = v.x; o[d + 1] = v.y; o[d + 2] = v.z; o[d + 3] = v.w; }
        }
        for (int mm = -64; mm <= 64; ++mm) {
            const int tk = t + mm * dil;
            if (tk < 0 || tk >= S_) continue;
            const bf16_t* kp = QKV + (size_t)tk * 3072 + 1024 + head * 64;
            float s = 0.f;
#pragma unroll
            for (int c = 0; c < 8; ++c) { float kk[8]; load8(kp + c * 8, kk);
#pragma unroll
                for (int j = 0; j < 8; ++j) s += q[c * 8 + j] * kk[j]; }
            if (s > m) { const float f = exp2f(m - s); l *= f;
#pragma unroll
                for (int d = 0; d < 64; ++d) o[d] *= f;
                m = s; }
            const float p = exp2f(s - m); l += p;
#pragma unroll
            for (int c = 0; c < 8; ++c) { float vv[8]; load8(kp + 1024 + c * 8, vv);
#pragma unroll
                for (int j = 0; j < 8; ++j) o[c * 8 + j] += p * vv[j]; }
        }
        ML[((size_t)t * 16 + head) * 2] = m; ML[((size_t)t * 16 + head) * 2 + 1] = l;
#pragma unroll
        for (int d = 0; d < 64; d += 4) *(f32x4*)(OACC + (size_t)t * 1024 + head * 64 + d) = (f32x4){o[d], o[d + 1], o[d + 2], o[d + 3]};
    }
}
DEV void gate_naive(const bf16_t* BR, const float* OACC, const float* ML, const bf16_t* TAIL, int ldt, const float* MKV, bf16_t* YIN) {
    const size_t total = (size_t)S_ * 1024;
    for (size_t idx = GTID; idx < total; idx += GSZ) {
        const int c = (int)(idx & 1023), t = (int)(idx >> 10);
        const float br = OACC ? OACC[idx] / ML[((size_t)t * 16 + (c >> 6)) * 2 + 1] : bf2f(BR[idx]);
        const float gt = bf2f(TAIL[(size_t)t * ldt + c]);
        YIN[(size_t)t * 1280 + c] = f2bf(br * silu(gt));
    }
    const size_t total2 = (size_t)4 * S_;
    for (size_t idx = GTID; idx < total2; idx += GSZ) {
        const int mh = (int)(idx >> 14), t = (int)(idx & 16383);
        float q[64], o[64]; float m = -1e30f, l = 0.f;
#pragma unroll
        for (int c = 0; c < 8; ++c) load8(TAIL + (size_t)t * ldt + 1280 + mh * 64 + c * 8, q + c * 8);
#pragma unroll
        for (int d = 0; d < 64; ++d) { q[d] *= C2; o[d] = 0.f; }
        for (int mm = 0; mm < 256; ++mm) {
            const float* kp = MKV + (size_t)mm * 512 + mh * 64;
            float s = 0.f;
#pragma unroll
            for (int d = 0; d < 64; ++d) s += q[d] * kp[d];
            if (s > m) { const float f = exp2f(m - s); l *= f;
#pragma unroll
                for (int d = 0; d < 64; ++d) o[d] *= f;
                m = s; }
            const float p = exp2f(s - m); l += p;
#pragma unroll
            for (int d = 0; d < 64; ++d) o[d] += p * kp[256 + d];
        }
        const float rl = 1.f / l;
#pragma unroll
        for (int c = 0; c < 8; ++c) { float gt[8]; load8(TAIL + (size_t)t * ldt + 1024 + mh * 64 + c * 8, gt);
#pragma unroll
            for (int j = 0; j < 8; ++j) o[c * 8 + j] = o[c * 8 + j] * rl * silu(gt[j]); }
#pragma unroll
        for (int c = 0; c < 8; ++c) store8(YIN + (size_t)t * 1280 + 1024 + mh * 64 + c * 8, o + c * 8);
    }
}

__global__ void __launch_bounds__(NTHREADS) mk(Params p) {
    __shared__ __attribute__((aligned(16))) float lds[64 * 64 * 2];
    cg::grid_group grid = cg::this_grid();
    unsigned char* ws = p.ws;
    bf16_t* WtA = (bf16_t*)(ws + WS_WA); bf16_t* WtB = (bf16_t*)(ws + WS_WB); bf16_t* WtC = (bf16_t*)(ws + WS_WC); bf16_t* WtO = (bf16_t*)(ws + WS_WO);
    bf16_t* Wdft = (bf16_t*)(ws + WS_WDFT); float* MKV = (float*)(ws + WS_MKV); bf16_t* XN = (bf16_t*)(ws + WS_XN);
    float* H = p.out;
    int step = 0;
#define STEP_BEGIN if (p.s0 <= step && step < p.s1) {
#define STEP_END   if (step + 1 < p.s1) grid.sync(); } ++step;
#define AR(off) (ws + WS_AR + (size_t)(off) * MiB)

    STEP_BEGIN
        tconv(p.w_in_a, 1024, 1536, 1536, WtA, 0);
        tconv(p.w_in_a + (size_t)1024 * 1536, 1024, 1536, 1536, WtA + (size_t)1536 * 1024, 0);
        tconv(p.w_in_b, 1024, 3072, 3072, WtB, 0);
        tconv(p.w_in_c, 1024, 10752, 10752, WtC, 1);
        for (int i = 0; i < 4; ++i) tconv(p.w_out + (size_t)i * 1280 * 1024, 1280, 1024, 1024, WtO + (size_t)i * 1024 * 1280, 0);
        make_wdft(Wdft);
        make_mkv(p.mem, p.w_mem_kv, MKV);
        ln_rows(p.x, nullptr, 1.f, p.ln_in_g, p.ln_in_b, H, XN);
    STEP_END

    for (int layer = 0; layer < 4; ++layer) {
        const int kind = layer % 3;
        const float* lng = p.ln_g + layer * 1024; const float* lnb = p.ln_b + layer * 1024;
        const bf16_t* wo = WtO + (size_t)layer * 1024 * 1280;
        if (kind == 0) {
            const bf16_t* wa = WtA + (size_t)(layer / 3) * 1536 * 1024;
            bf16_t* PROJ = (bf16_t*)AR(0); bf16_t* Z = (bf16_t*)AR(48); bf16_t* T = (bf16_t*)AR(112); bf16_t* BR = (bf16_t*)AR(48); bf16_t* YIN = (bf16_t*)AR(80); float* Y = (float*)AR(0);
            STEP_BEGIN
                gemm_simple(XN, 1024, wa, 1024, S_, 1536, 1024, PROJ, 1536, 0);
                for (int g = 0; g < 4; ++g) gemm_simple(XN + g * 256, 1024, Wdft, 256, S_, 512, 256, Z + g * 512, 2048, 0);
            STEP_END
            STEP_BEGIN fft_s1(Z, T, lds); STEP_END
            STEP_BEGIN fft_s2(T, BR, lds); STEP_END
            STEP_BEGIN gate_naive(BR, nullptr, nullptr, PROJ, 1536, MKV, YIN); STEP_END
            STEP_BEGIN gemm_simple(YIN, 1280, wo, 1280, S_, 1024, 1280, Y, 1024, 1); STEP_END
            STEP_BEGIN ln_rows(H, Y, ALPHA, lng, lnb, H, XN); STEP_END
        } else if (kind == 1) {
            bf16_t* PROJ = (bf16_t*)AR(0); bf16_t* BR = (bf16_t*)AR(96); bf16_t* YIN = (bf16_t*)AR(128); float* Y = (float*)AR(0);
            STEP_BEGIN gemm_simple(XN, 1024, WtB, 1024, S_, 3072, 1024, PROJ, 3072, 0); STEP_END
            STEP_BEGIN qk_post(PROJ, p.q_norm_g, p.k_norm_g); STEP_END
            STEP_BEGIN attn_naive(PROJ, BR, lds); STEP_END
            STEP_BEGIN gate_naive(BR, nullptr, nullptr, PROJ + 1536, 3072, MKV, YIN); STEP_END
            STEP_BEGIN gemm_simple(YIN, 1280, wo, 1280, S_, 1024, 1280, Y, 1024, 1); STEP_END
            STEP_BEGIN ln_rows(H, Y, ALPHA, lng, lnb, H, XN); STEP_END
        } else {
            bf16_t* QKV = (bf16_t*)AR(0); float* OACC = (float*)AR(96); float* ML = (float*)AR(160); float* ROPE = (float*)AR(164);
            bf16_t* TAIL = (bf16_t*)AR(0); bf16_t* YIN = (bf16_t*)AR(48); float* Y = (float*)AR(96);
            for (int g = 0; g < 3; ++g) {
                STEP_BEGIN
                    gemm_simple(XN, 1024, WtC + (size_t)g * 3072 * 1024, 1024, S_, 3072, 1024, QKV, 3072, 0);
                    if (g == 0) make_rope1d(ROPE);
                STEP_END
                STEP_BEGIN rope_c(QKV, ROPE); STEP_END
                STEP_BEGIN dil_naive(QKV, OACC, ML, g); STEP_END
            }
            STEP_BEGIN gemm_simple(XN, 1024, WtC + (size_t)9216 * 1024, 1024, S_, 1536, 1024, TAIL, 1536, 0); STEP_END
            STEP_BEGIN gate_naive(nullptr, OACC, ML, TAIL, 1536, MKV, YIN); STEP_END
            STEP_BEGIN gemm_simple(YIN, 1280, wo, 1280, S_, 1024, 1280, Y, 1024, 1); STEP_END
            STEP_BEGIN ln_rows(H, Y, ALPHA, lng, lnb, H, XN); STEP_END
        }
    }
}

extern "C" void kernel_launch(void* const* d_in, const int* in_sizes, int n_in, void* d_out, int out_size, void* d_ws, size_t ws_size, hipStream_t stream) {
    if (n_in != 13 || ws_size < 256 * MiB) { fprintf(stderr, "kernel_launch: unexpected inputs (n_in %d, ws %zu)\n", n_in, ws_size); return; }
    Params p{};
    p.x = (const float*)d_in[0]; p.mem = (const float*)d_in[1]; p.ln_in_g = (const float*)d_in[2]; p.ln_in_b = (const float*)d_in[3];
    p.w_mem_kv = (const float*)d_in[4]; p.w_in_a = (const float*)d_in[5]; p.w_in_b = (const float*)d_in[6]; p.q_norm_g = (const float*)d_in[7];
    p.k_norm_g = (const float*)d_in[8]; p.w_in_c = (const float*)d_in[9]; p.w_out = (const float*)d_in[10]; p.ln_g = (const float*)d_in[11]; p.ln_b = (const float*)d_in[12];
    p.out = (float*)d_out; p.ws = (unsigned char*)d_ws;
    static int grid_blocks = 0;
    if (!grid_blocks) {
        int dev = 0, cus = 0, per_cu = 0;
        hipGetDevice(&dev);
        hipDeviceGetAttribute(&cus, hipDeviceAttributeMultiprocessorCount, dev);
        hipOccupancyMaxActiveBlocksPerMultiprocessor(&per_cu, (const void*)mk, NTHREADS, 0);
        if (per_cu < 1) per_cu = 1;
        grid_blocks = cus * per_cu;
    }
    p.s0 = 0; p.s1 = NSTEPS;
    void* args[] = {&p};
    hipError_t e = hipLaunchCooperativeKernel((const void*)mk, dim3(grid_blocks), dim3(NTHREADS), args, 0, stream);
    if (e != hipSuccess) fprintf(stderr, "cooperative launch failed: %s (grid %d)\n", hipGetErrorString(e), grid_blocks);
}
```

```cpp
#include <hip/hip_runtime.h>
#include <hip/hip_cooperative_groups.h>
#include <cstdio>
#include <cstdint>
namespace cg = cooperative_groups;

#define DEV __device__ __forceinline__
typedef unsigned short bf16_t;
typedef short bf16x8 __attribute__((ext_vector_type(8)));
typedef float f32x4 __attribute__((ext_vector_type(4)));
typedef unsigned u32x4 __attribute__((ext_vector_type(4)));
typedef unsigned u32x2 __attribute__((ext_vector_type(2)));

constexpr int S_ = 16384, DM = 1024;
constexpr float ALPHA = 1.681792830507429f;
constexpr float C2 = 0.125f * 1.4426950408889634f;
constexpr float LN_EPS = 1e-5f;
constexpr size_t MiB = 1u << 20;
constexpr size_t WS_WA = 2 * MiB, WS_WB = 8 * MiB, WS_WC = 14 * MiB, WS_WO = 35 * MiB, WS_WDFT = 45 * MiB, WS_MKV = 45 * MiB + 512 * 1024;
constexpr size_t WS_XN = 48 * MiB, WS_AR = 80 * MiB;
constexpr int NTHREADS = 512;
constexpr int NSTEPS = 32;
constexpr int LDS_BYTES = 147456;


namespace pg8 {
#define PG8_LAS __attribute__((address_space(3)))
typedef unsigned short bf16_t;
typedef short bf16x8 __attribute__((ext_vector_type(8)));
typedef float f32x4 __attribute__((ext_vector_type(4)));
typedef unsigned u32x4 __attribute__((ext_vector_type(4)));
constexpr int BM = 256, BK = 64, HALF = 128, HTB = HALF * BK * 2  , STAGE_BYTES = 8 * HTB, NXCD = 8, WGM = 8;

__host__ __device__ __forceinline__ int lds_byte(int r, int c) { const int st = (r >> 4) * 2 + (c >> 5), rr = r & 15, cc = c & 31, ob = rr * 64 + cc * 2; return st * 1024 + (ob ^ (((ob >> 9) & 1) << 5)); }
__host__ __device__ __forceinline__ void stage_rc(int b, int& R, int& C) { const int st = b / 1024, sb = b % 1024, swz = sb ^ (((sb >> 9) & 1) << 5); R = (st >> 1) * 16 + swz / 64; C = (st & 1) * 32 + (swz % 64) / 2; }
__host__ __device__ __forceinline__ int perm32(int rho) { const int n = rho >> 4, i = rho & 15; return 8 * (i >> 2) + 4 * n + (i & 3); }

struct Unit { int pm, pn; };
struct Gemm { const bf16_t* A; const bf16_t* Bt; int M, N, K, lda; };

struct StaticOrder {
    int nM, nN, nwg, G, c;
    __host__ __device__ void init(int M, int N, int G_, int c_) { nM = M / BM; nN = N / BM; nwg = nM * nN; G = G_; c = c_; }
    __host__ __device__ bool next(int i, Unit& u) const {
        const long L = (long)i * G + c; if (L >= nwg) return false;
        int wgid = (int)L; { const int q = nwg / NXCD, r = nwg % NXCD, xcd = wgid % NXCD, off = wgid / NXCD; wgid = (xcd < r ? xcd * (q + 1) : r * (q + 1) + (xcd - r) * q) + off; }
        const int nig = WGM * nN, gid = wgid / nig, fm = gid * WGM, gsz = (nM - fm) < WGM ? (nM - fm) : WGM;
        u.pm = fm + ((wgid % nig) % gsz); u.pn = (wgid % nig) / gsz; return true;
    }
    __device__ __forceinline__ void a_ready(const Unit&) const {}
    __device__ __forceinline__ void done(const Unit&) const {}
};

__device__ __forceinline__ unsigned cvt_pk_bf16(float lo, float hi) { unsigned r; asm volatile("v_cvt_pk_bf16_f32 %0, %1, %2" : "=v"(r) : "v"(lo), "v"(hi)); return r; }
typedef float f32x2 __attribute__((ext_vector_type(2)));
__device__ __forceinline__ f32x2 gelu_pk(f32x2 v) {
    const f32x2 av = __builtin_elementwise_abs(v), d = av * 0.2316418882f + 1.0f;
    f32x2 t; t.x = __builtin_amdgcn_rcpf(d.x); t.y = __builtin_amdgcn_rcpf(d.y);
    f32x2 q = t * 0.5307027145f + (-0.7265760135f); q = q * t + 0.7107068705f; q = q * t + (-0.142248368f); q = q * t + 0.127414796f; q = q * t;
    const f32x2 s = (v * v) * (-0.72134752044f);
    f32x2 e; e.x = __builtin_amdgcn_exp2f(s.x); e.y = __builtin_amdgcn_exp2f(s.y);
    const f32x2 m = v * (q * e), r = v - m;
    f32x2 o; o.x = v.x < 0.f ? m.x : r.x; o.y = v.y < 0.f ? m.y : r.y; return o;
}

template <int ACT  > struct EpiBf16 {
    static constexpr bool PERM = true, AFTER_DRAIN = false; static_assert(ACT == 0 || ACT == 1, "EpiBf16: ACT is 0 (none) or 1 (gelu_pk)");
    bf16_t* O; int ldc; const float* bias; int split_cols; size_t split_stride; float scale0;
    __device__ __forceinline__ void operator()(const f32x4 (&acc)[2][2][4][2], const Unit& u, int wr, int wc, int fr, int fq) const {
        const int row0 = u.pm * BM + wr * 64 + fr; int colt = u.pn * BM; bf16_t* base = O;
        float sc = 1.f; if (split_cols) { const int t = colt / split_cols; base += (size_t)t * split_stride; colt -= t * split_cols; if (t == 0) sc = scale0; }
        const int col0 = colt + wc * 32 + 8 * fq, bcol0 = u.pn * BM + wc * 32 + 8 * fq;
        f32x4 bv[2][2];
#pragma unroll
        for (int bj = 0; bj < 2; ++bj)
#pragma unroll
            for (int n = 0; n < 2; ++n) bv[bj][n] = bias ? *(const f32x4*)(bias + bcol0 + bj * HALF + 4 * n) : (f32x4){0.f, 0.f, 0.f, 0.f};
#pragma unroll
        for (int ai = 0; ai < 2; ++ai)
#pragma unroll
            for (int m = 0; m < 4; ++m) { bf16_t* rowp = base + (size_t)(row0 + ai * HALF + m * 16) * ldc + col0;
#pragma unroll
                for (int bj = 0; bj < 2; ++bj) { f32x4 v0 = acc[ai][bj][m][0] + bv[bj][0], v1 = acc[ai][bj][m][1] + bv[bj][1];
                    if (ACT == 1) { f32x2 a = gelu_pk((f32x2){v0[0], v0[1]}), b = gelu_pk((f32x2){v0[2], v0[3]}), c = gelu_pk((f32x2){v1[0], v1[1]}), d = gelu_pk((f32x2){v1[2], v1[3]});
                        v0 = (f32x4){a.x, a.y, b.x, b.y}; v1 = (f32x4){c.x, c.y, d.x, d.y}; }
                    v0 = v0 * sc; v1 = v1 * sc; u32x4 w; w.x = cvt_pk_bf16(v0[0], v0[1]); w.y = cvt_pk_bf16(v0[2], v0[3]); w.z = cvt_pk_bf16(v1[0], v1[1]); w.w = cvt_pk_bf16(v1[2], v1[3]);
                    *(u32x4*)(rowp + bj * HALF) = w; } }
    }
};

struct EpiF32 {
    static constexpr bool PERM = false, AFTER_DRAIN = false;
    float* O; int ldc;
    __device__ __forceinline__ void operator()(const f32x4 (&acc)[2][2][4][2], const Unit& u, int wr, int wc, int fr, int fq) const {
        const int row0 = u.pm * BM + wr * 64 + fr, col0 = u.pn * BM + wc * 32 + 4 * fq;
#pragma unroll
        for (int ai = 0; ai < 2; ++ai)
#pragma unroll
            for (int m = 0; m < 4; ++m) { float* rowp = O + (size_t)(row0 + ai * HALF + m * 16) * ldc + col0;
#pragma unroll
                for (int bj = 0; bj < 2; ++bj)
#pragma unroll
                    for (int n = 0; n < 2; ++n) *(f32x4*)(rowp + bj * HALF + n * 16) = acc[ai][bj][m][n]; }
    }
};
template <class Epi, class Sched, bool ALIGN_EPI = false, bool SP2 = false>
__device__ __forceinline__ void gemm_phase(PG8_LAS unsigned char* lds, const Gemm g, const Sched& S, const Epi& E) {
    int tid_ = threadIdx.x; asm volatile("" : "+v"(tid_)); const int tid = tid_, wid = __builtin_amdgcn_readfirstlane(tid >> 6), lane = tid & 63, wr = wid >> 2, wc = wid & 3, fr = lane & 15, fq = lane >> 4;
    const int K = g.K, nt = K / BK;
    unsigned voffA[2], voffB[2];
#pragma unroll
    for (int i = 0; i < 2; ++i) { int R, C; stage_rc(tid * 16 + i * 8192, R, C); const int Rb = Epi::PERM ? ((R & ~31) + perm32(R & 31)) : R;
        voffA[i] = (unsigned)(R * g.lda + C) * 2u; voffB[i] = (unsigned)(Rb * K + C) * 2u; }
    const size_t kstep = (size_t)(BK * 2);
    const size_t hstepB = (size_t)HALF * K * 2, hstepA = (size_t)HALF * g.lda * 2;
    const size_t tstepA = 2 * hstepA, tstepB = 2 * hstepB;
    const unsigned ldsw = (unsigned)wid * 1024u;
    const int aoff = lds_byte(wr * 64 + fr, fq * 8), boff = lds_byte(wc * 32 + fr, fq * 8);
#define PG8_SA(b, h) (((b) * 2 + (h)) * HTB)
#define PG8_SB(b, h) ((4 + (b) * 2 + (h)) * HTB)
#define PG8_STAGE(bufoff, gbase, voff) do { _Pragma("unroll") for (int _i = 0; _i < 2; ++_i) \
        __builtin_amdgcn_global_load_lds((const unsigned*)((const char*)(gbase) + (voff)[_i]), (PG8_LAS unsigned*)(lds + (bufoff) + ldsw + _i * 8192), 16, 0, 0); } while (0)
#define PG8_LDA(dst, b, h) do { _Pragma("unroll") for (int m = 0; m < 4; ++m) _Pragma("unroll") for (int k = 0; k < 2; ++k) dst[m][k] = *(const PG8_LAS bf16x8*)(lds + PG8_SA(b, h) + aoff + m * 2048 + k * 1024); } while (0)
#define PG8_LDB(dst, b, h) do { _Pragma("unroll") for (int n = 0; n < 2; ++n) _Pragma("unroll") for (int k = 0; k < 2; ++k) dst[n][k] = *(const PG8_LAS bf16x8*)(lds + PG8_SB(b, h) + boff + n * 2048 + k * 1024); } while (0)
#define PG8_MMA(ai, bj, At, Bt) do { __builtin_amdgcn_s_setprio(1); _Pragma("unroll") for (int m = 0; m < 4; ++m) _Pragma("unroll") for (int n = 0; n < 2; ++n) _Pragma("unroll") for (int k = 0; k < 2; ++k) \
        acc[ai][bj][m][n] = __builtin_amdgcn_mfma_f32_16x16x32_bf16(Bt[n][k], At[m][k], acc[ai][bj][m][n], 0, 0, 0); __builtin_amdgcn_s_setprio(0); } while (0)
#define PG8_WAIT_V(n) asm volatile("s_waitcnt vmcnt(" #n ")" ::: "memory")
#define PG8_WAIT_L(n) asm volatile("s_waitcnt lgkmcnt(" #n ")" ::: "memory")
#define PG8_BAR __builtin_amdgcn_s_barrier()
#define PG8_SCHED __builtin_amdgcn_sched_barrier(0)
    Unit cur, nxt; int ui = 0;
    if (!S.next(0, cur)) return;
    f32x4 acc[2][2][4][2];
#pragma unroll
    for (int a = 0; a < 2; ++a)
#pragma unroll
        for (int b = 0; b < 2; ++b)
#pragma unroll
            for (int m = 0; m < 4; ++m)
#pragma unroll
                for (int n = 0; n < 2; ++n) acc[a][b][m][n] = (f32x4){0.f, 0.f, 0.f, 0.f};
    bf16x8 At[4][2], B0[2][2], B1[2][2];
    const char* cA = (const char*)g.A + (size_t)cur.pm * tstepA; const char* cB = (const char*)g.Bt + (size_t)cur.pn * tstepB;
    S.a_ready(cur);
    if constexpr (SP2) {
        PG8_STAGE(PG8_SB(0, 0), cB, voffB); PG8_STAGE(PG8_SB(0, 1), cB + hstepB, voffB); PG8_STAGE(PG8_SA(0, 0), cA, voffA); PG8_STAGE(PG8_SA(0, 1), cA + hstepA, voffA);
        if (wr == 1) PG8_BAR;
        PG8_WAIT_V(2); PG8_BAR;
        PG8_STAGE(PG8_SB(1, 0), cB + kstep, voffB); PG8_STAGE(PG8_SA(1, 0), cA + kstep, voffA); PG8_STAGE(PG8_SB(1, 1), cB + hstepB + kstep, voffB);
        PG8_WAIT_V(6); PG8_BAR;
    } else {
        PG8_STAGE(PG8_SB(0, 0), cB, voffB); PG8_STAGE(PG8_SA(0, 0), cA, voffA); PG8_STAGE(PG8_SB(0, 1), cB + hstepB, voffB); PG8_STAGE(PG8_SA(0, 1), cA + hstepA, voffA);
        if (wr == 1) PG8_BAR;
        PG8_WAIT_V(4); PG8_BAR;
        PG8_STAGE(PG8_SB(1, 0), cB + kstep, voffB); PG8_STAGE(PG8_SA(1, 0), cA + kstep, voffA); PG8_STAGE(PG8_SB(1, 1), cB + hstepB + kstep, voffB);
        PG8_WAIT_V(6); PG8_BAR;
    }
    for (;;) {
        const bool has_next = S.next(ui + 1, nxt);
        const char* nA = has_next ? (const char*)g.A + (size_t)nxt.pm * tstepA : cA; const char* nB = has_next ? (const char*)g.Bt + (size_t)nxt.pn * tstepB : cB;
        for (int t = 0; t < nt; t += 2) {
            const bool last = (t == nt - 2);
            const char* a1 = cA + (size_t)(t + 1) * kstep;
            const char* a2 = last ? nA : cA + (size_t)(t + 2) * kstep; const char* b2 = last ? nB : cB + (size_t)(t + 2) * kstep;
            const char* a3 = a2 + kstep; const char* b3 = b2 + kstep;
            if (last && has_next) S.a_ready(nxt);
            if constexpr (SP2) {
            PG8_LDB(B0, 0, 0); PG8_LDB(B1, 0, 1); PG8_SCHED; PG8_LDA(At, 0, 0); PG8_STAGE(PG8_SA(1, 1), a1 + hstepA, voffA);
            PG8_WAIT_V(8); PG8_WAIT_L(0); PG8_BAR; PG8_MMA(0, 0, At, B0); PG8_MMA(0, 1, At, B1); PG8_BAR; PG8_SCHED;
            PG8_LDA(At, 0, 1); PG8_STAGE(PG8_SB(0, 0), b2, voffB); PG8_STAGE(PG8_SB(0, 1), b2 + hstepB, voffB); PG8_STAGE(PG8_SA(0, 0), a2, voffA);
            PG8_WAIT_V(8); PG8_WAIT_L(0); PG8_BAR; PG8_MMA(1, 0, At, B0); PG8_MMA(1, 1, At, B1); PG8_BAR; PG8_SCHED;
            PG8_LDB(B0, 1, 0); PG8_LDB(B1, 1, 1); PG8_SCHED; PG8_LDA(At, 1, 0); PG8_STAGE(PG8_SA(0, 1), a2 + hstepA, voffA);
            PG8_WAIT_V(8); PG8_WAIT_L(0); PG8_BAR; PG8_MMA(0, 0, At, B0); PG8_MMA(0, 1, At, B1); PG8_BAR; PG8_SCHED;
            PG8_LDA(At, 1, 1); PG8_STAGE(PG8_SB(1, 0), b3, voffB); PG8_STAGE(PG8_SB(1, 1), b3 + hstepB, voffB); PG8_STAGE(PG8_SA(1, 0), a3, voffA);
            PG8_WAIT_V(8); PG8_WAIT_L(0); PG8_BAR; PG8_MMA(1, 0, At, B0); PG8_MMA(1, 1, At, B1); PG8_BAR; PG8_SCHED;
            } else {
            PG8_LDB(B0, 0, 0); PG8_SCHED; PG8_LDA(At, 0, 0); PG8_STAGE(PG8_SA(1, 1), a1 + hstepA, voffA);
            PG8_WAIT_L(8); PG8_BAR; PG8_WAIT_L(0); PG8_MMA(0, 0, At, B0); PG8_BAR; PG8_SCHED;
            PG8_LDB(B1, 0, 1); PG8_STAGE(PG8_SB(0, 0), b2, voffB);
            PG8_BAR; PG8_WAIT_L(0); PG8_MMA(0, 1, At, B1); PG8_BAR;
            PG8_LDA(At, 0, 1); PG8_STAGE(PG8_SA(0, 0), a2, voffA);
            PG8_BAR; PG8_WAIT_L(0); PG8_MMA(1, 0, At, B0); PG8_BAR; PG8_SCHED;
            PG8_STAGE(PG8_SB(0, 1), b2 + hstepB, voffB);
            PG8_WAIT_V(6); PG8_BAR; PG8_MMA(1, 1, At, B1); PG8_BAR;
            PG8_LDB(B0, 1, 0); PG8_SCHED; PG8_LDA(At, 1, 0); PG8_STAGE(PG8_SA(0, 1), a2 + hstepA, voffA);
            PG8_WAIT_L(8); PG8_BAR; PG8_WAIT_L(0); PG8_MMA(0, 0, At, B0); PG8_BAR; PG8_SCHED;
            PG8_LDB(B1, 1, 1); PG8_STAGE(PG8_SB(1, 0), b3, voffB);
            PG8_BAR; PG8_WAIT_L(0); PG8_MMA(0, 1, At, B1); PG8_BAR;
            PG8_LDA(At, 1, 1); PG8_STAGE(PG8_SA(1, 0), a3, voffA);
            PG8_BAR; PG8_WAIT_L(0); PG8_MMA(1, 0, At, B0); PG8_BAR; PG8_SCHED;
            PG8_STAGE(PG8_SB(1, 1), b3 + hstepB, voffB);
            PG8_WAIT_V(6); PG8_BAR; PG8_MMA(1, 1, At, B1); PG8_BAR;
            }
        }
        if constexpr (ALIGN_EPI) { if (wr == 0) PG8_BAR; }
        if constexpr (!Epi::AFTER_DRAIN) { E(acc, cur, wr, wc, fr, fq); S.done(cur); }
        if (!has_next) break;
#pragma unroll
        for (int a = 0; a < 2; ++a)
#pragma unroll
            for (int b = 0; b < 2; ++b)
#pragma unroll
                for (int m = 0; m < 4; ++m)
#pragma unroll
                    for (int n = 0; n < 2; ++n) acc[a][b][m][n] = (f32x4){0.f, 0.f, 0.f, 0.f};
        cur = nxt; cA = nA; cB = nB; ++ui;
        if constexpr (ALIGN_EPI) { if (wr == 1) PG8_BAR; }
    }
    PG8_WAIT_V(0);
    if constexpr (!ALIGN_EPI) { if (wr == 0) PG8_BAR; }
    PG8_BAR;
    if constexpr (Epi::AFTER_DRAIN) { E.fused(acc, cur, wr, wc, fr, fq, lds, wid, lane); S.done(cur); }
#undef PG8_SA
#undef PG8_SB
#undef PG8_STAGE
#undef PG8_LDA
#undef PG8_LDB
#undef PG8_MMA
#undef PG8_WAIT_V
#undef PG8_WAIT_L
#undef PG8_BAR
#undef PG8_SCHED
}
}

#define PG8_SP2 true
#define PG8_ALIGN true
#include <hip/hip_bf16.h>
#include <cmath>
namespace attn_body {
using bf16=__hip_bfloat16;
using bf16x8=__attribute__((ext_vector_type(8)))short;
using s16x4=__attribute__((ext_vector_type(4)))short;
using f32x16=__attribute__((ext_vector_type(16)))float;
using u32x4=__attribute__((ext_vector_type(4)))unsigned;
constexpr int BATCH=1,NHEAD=16,SEQ=16384,D=64,DM=NHEAD*D,QP=3072,KP=3072,OP=1024;
constexpr int NW=8,QBLK=32,QB=QBLK*NW,KVBLK=64,NQB=SEQ/QB;
constexpr int ATTN_PITCH=DM, ATTN_UNIT_ROWS=QB;
__device__ __forceinline__ int crow(int r,int hi){return (r&3)+8*(r>>2)+4*hi;}
#define SBAR() __builtin_amdgcn_sched_barrier(0)
__device__ __forceinline__ void cmask(f32x16&p0,f32x16&p1,int jb,int qrel,int hi){
  const float NEG=-INFINITY; int kb=64*jb+4*hi;
  #pragma unroll
  for(int r=0;r<16;++r){int kv=kb+(r&3)+8*(r>>2); if(kv>qrel)p0[r]=NEG; if(kv+32>qrel)p1[r]=NEG;}
}

constexpr int NSLOT=3, SLOTB=8192;
constexpr int LDS_K=0, LDS_V=NSLOT*SLOTB, LDS_WS=2*NSLOT*SLOTB, LDS_OST=LDS_WS+NW*64*4, LDS_BYTES=LDS_OST+NW*4096;
constexpr float C2=0.125f*1.4426950408889634f;
__device__ __forceinline__ void glds16(const void*gsrc,unsigned lds_dst){unsigned keep;
  asm volatile("s_mov_b32 %0, m0\n\ts_mov_b32 m0, %2\n\ts_nop 0\n\tglobal_load_lds_dwordx4 %1, off\n\ts_mov_b32 m0, %0":"=&s"(keep):"v"(gsrc),"s"(lds_dst):"memory");}
__device__ __forceinline__ float max3f(float a,float b,float c){float r;asm("v_max3_f32 %0, %1, %2, %3":"=v"(r):"v"(a),"v"(b),"v"(c));return r;}
__device__ __forceinline__ float max2f(float a,float b){float r;asm("v_max_f32_e32 %0, %1, %2":"=v"(r):"v"(a),"v"(b));return r;}
__device__ __forceinline__ float fadd_s(float a,float b){float r;asm("v_add_f32_e32 %0, %1, %2":"=v"(r):"v"(a),"v"(b));return r;}
__device__ __forceinline__ float fsub_s(float a,float b){float r;asm("v_sub_f32_e32 %0, %1, %2":"=v"(r):"v"(a),"v"(b));return r;}
typedef float f32x2_t __attribute__((ext_vector_type(2))); typedef __bf16 bf16x2_t __attribute__((ext_vector_type(2)));
__device__ __forceinline__ unsigned cvtpk_s(float lo,float hi){f32x2_t v={lo,hi};bf16x2_t b=__builtin_convertvector(v,bf16x2_t);return __builtin_bit_cast(unsigned,b);}
#define WAIT_BAR(N) asm volatile("s_waitcnt vmcnt(" #N ") lgkmcnt(0)\n\ts_barrier":::"memory")

__device__ __forceinline__ void qkt(f32x16&p0,f32x16&p1,const char*Kslot,const bf16x8*qr,const f32x16&negm,int r32,int hi){
  const char*kb=Kslot+hi*1024+r32*16;
  #pragma unroll
  for(int d0=0;d0<4;++d0){
    const bf16x8 b0=*reinterpret_cast<const bf16x8*>(kb+d0*2048);
    const bf16x8 b1=*reinterpret_cast<const bf16x8*>(kb+d0*2048+512);
    if(d0==0){p0=__builtin_amdgcn_mfma_f32_32x32x16_bf16(b0,qr[0],negm,0,0,0);p1=__builtin_amdgcn_mfma_f32_32x32x16_bf16(b1,qr[0],negm,0,0,0);}
    else{p0=__builtin_amdgcn_mfma_f32_32x32x16_bf16(b0,qr[d0],p0,0,0,0);p1=__builtin_amdgcn_mfma_f32_32x32x16_bf16(b1,qr[d0],p1,0,0,0);}}
}
typedef __attribute__((address_space(3))) const char* lds_cptr;
typedef short v4i16_t __attribute__((ext_vector_type(4)));
__device__ __forceinline__ void kload8(bf16x8*kf,lds_cptr kp){
  kf[0]=*(const __attribute__((address_space(3))) bf16x8*)(kp);      kf[1]=*(const __attribute__((address_space(3))) bf16x8*)(kp+512);
  kf[2]=*(const __attribute__((address_space(3))) bf16x8*)(kp+2048); kf[3]=*(const __attribute__((address_space(3))) bf16x8*)(kp+2560);
  kf[4]=*(const __attribute__((address_space(3))) bf16x8*)(kp+4096); kf[5]=*(const __attribute__((address_space(3))) bf16x8*)(kp+4608);
  kf[6]=*(const __attribute__((address_space(3))) bf16x8*)(kp+6144); kf[7]=*(const __attribute__((address_space(3))) bf16x8*)(kp+6656);
}
__device__ __forceinline__ void kload2(bf16x8*kf,lds_cptr kp,int j){ kf[2*j]=*(const __attribute__((address_space(3))) bf16x8*)(kp+j*2048); kf[2*j+1]=*(const __attribute__((address_space(3))) bf16x8*)(kp+j*2048+512); }
__device__ __forceinline__ s16x4 vtr(lds_cptr p){ return __builtin_bit_cast(s16x4,__builtin_amdgcn_ds_read_tr16_b64_v4i16((__attribute__((address_space(3))) v4i16_t*)p)); }
__device__ __forceinline__ float rowmax(const f32x16&p0,const f32x16&p1){
  float a=max3f(p0[0],p0[1],p1[0]),b=max3f(p0[2],p0[3],p1[1]);a=max3f(a,p1[2],p1[3]);
  #pragma unroll
  for(int r=4;r<16;r+=4){a=max3f(a,p0[r],p0[r+1]);b=max3f(b,p0[r+2],p0[r+3]);a=max3f(a,p1[r],p1[r+1]);b=max3f(b,p1[r+2],p1[r+3]);}
  const float m=max2f(a,b);
  auto rr=__builtin_amdgcn_permlane32_swap(__float_as_uint(m),__float_as_uint(m),false,false);
  return max2f(__uint_as_float(rr[0]),__uint_as_float(rr[1]));
}
__device__ __forceinline__ void pv(f32x16*o,int vb,bf16x8 pa0,bf16x8 pa1,bf16x8 pa2,bf16x8 pa3){
  #pragma unroll
  for(int d0=0;d0<2;++d0){s16x4 lo[4],hi[4];
    #pragma unroll
    for(int ks=0;ks<4;++ks){
      asm volatile("ds_read_b64_tr_b16 %0,%1 offset:%c2":"=&v"(lo[ks]):"v"(vb),"i"(d0*4096+ks*1024):"memory");
      asm volatile("ds_read_b64_tr_b16 %0,%1 offset:%c2":"=&v"(hi[ks]):"v"(vb),"i"(d0*4096+ks*1024+512):"memory");}
    asm volatile("s_waitcnt lgkmcnt(0)":::"memory");SBAR();
    #define PK(k) (bf16x8){lo[k][0],lo[k][1],lo[k][2],lo[k][3],hi[k][0],hi[k][1],hi[k][2],hi[k][3]}
    o[d0]=__builtin_amdgcn_mfma_f32_32x32x16_bf16(pa0,PK(0),o[d0],0,0,0);
    o[d0]=__builtin_amdgcn_mfma_f32_32x32x16_bf16(pa1,PK(1),o[d0],0,0,0);
    o[d0]=__builtin_amdgcn_mfma_f32_32x32x16_bf16(pa2,PK(2),o[d0],0,0,0);
    o[d0]=__builtin_amdgcn_mfma_f32_32x32x16_bf16(pa3,PK(3),o[d0],0,0,0);
    #undef PK
  }
}

#ifndef ATTN_STORE16
#define ATTN_STORE16(p,v) (*(u32x4*)(p)=(v))
#endif
template<int THRL> __device__ __forceinline__ void attn_unit(int b,int h,int qb,const bf16*Q,const bf16*__restrict__ K,const bf16*__restrict__ V,bf16*O,char*shm){
  int tid_=threadIdx.x; asm volatile("":"+v"(tid_)); const int tid=tid_,lane=tid&63,r32=lane&31,hi=lane>>5; const int wid=__builtin_amdgcn_readfirstlane(tid>>6);
  const long rowbase=(long)b*SEQ; const int q0=qb*QB;
  const bf16*Qw=Q+(rowbase+q0+wid*QBLK)*QP+h*D;
  const int kvh=h>>2; const bf16*Kh=K+rowbase*KP+kvh*D,*Vh=V+rowbase*KP+kvh*D;
  const unsigned lds0=(unsigned)(uintptr_t)shm;
  float*wsf=(float*)(shm+LDS_WS)+wid*64;
  const bf16*ksrc=Kh+(long)lane*KP+wid*8;
  const bf16*vsrc=Vh+(long)(16*(wid&3)+(lane>>2))*KP+(wid>>2)*32+(lane&3)*8;
  const unsigned kdst=lds0+LDS_K+wid*1024, vdst=lds0+LDS_V+wid*1024;
  #define DMA_K(t,slot) glds16(ksrc+(long)(t)*KVBLK*KP,(unsigned)__builtin_amdgcn_readfirstlane(kdst+(slot)))
  #define DMA_V(t,slot) glds16(vsrc+(long)(t)*KVBLK*KP,(unsigned)__builtin_amdgcn_readfirstlane(vdst+(slot)))
  const int vb0=(int)(lds0+LDS_V)+((lane>>4)&1)*32+(lane&3)*8+(4*hi+((lane&15)>>2))*64;
  const char*Kbase=shm+LDS_K; bf16x8 kf[8];
  const lds_cptr shm3=(lds_cptr)shm; const lds_cptr kp0=shm3+LDS_K+hi*1024+r32*16; const lds_cptr vp0=shm3+LDS_V+((lane>>4)&1)*32+(lane&3)*8+(4*hi+((lane&15)>>2))*64;
  const int NT=SEQ/KVBLK;
  DMA_K(0,0);DMA_V(0,0);DMA_K(1,SLOTB);
  bf16x8 qr[4];
  #pragma unroll
  for(int d0=0;d0<4;++d0)qr[d0]=*reinterpret_cast<const bf16x8*>(&Qw[(long)r32*QP+d0*16+hi*8]);
  float mhat=0.f,l_reg=0.f;f32x16 o[2];o[0]=f32x16{};o[1]=f32x16{};f32x16 negm=f32x16{};asm volatile("":"+v"(negm));
  const int qrel=wid*QBLK+r32;
  #define CMASK(P0,P1,t) do{}while(0)
  bool resc=false;
  #define START(P0,P1) do{ const float rm=rowmax(P0,P1); resc=false; \
    { const float dl=rm; mhat=fadd_s(mhat,dl); \
      _Pragma("unroll") for(int r=0;r<16;++r){P0[r]=fsub_s(P0[r],dl);P1[r]=fsub_s(P1[r],dl);} \
      _Pragma("unroll") for(int r=0;r<16;++r)negm[r]=-mhat; asm volatile("":"+v"(negm)); } \
    _Pragma("unroll") for(int r=0;r<16;++r)P0[r]=__builtin_amdgcn_exp2f(P0[r]); }while(0)
  #define RESC() do{ if(resc){ asm volatile("s_waitcnt lgkmcnt(0)":::"memory"); \
      _Pragma("unroll") for(int d_=0;d_<2;++d_) _Pragma("unroll") for(int r=0;r<16;++r)o[d_][r]*=wsf[crow(r,hi)]; } }while(0)
  f32x16 pA0,pA1,pB0,pB1;
  int sl_prev=0,sl_cur=0,sl_next=SLOTB;
  #define ROT() do{sl_prev=sl_cur;sl_cur=sl_next;sl_next=(sl_next==(NSLOT-1)*SLOTB)?0:sl_next+SLOTB;}while(0)
  DMA_K(2,2*SLOTB);
  WAIT_BAR(3);
  qkt(pA0,pA1,Kbase,qr,negm,r32,hi);asm volatile("s_nop 15\n\ts_nop 7":"+v"(pA0),"+v"(pA1));CMASK(pA0,pA1,0);
  START(pA0,pA1);
  _Pragma("unroll") for(int r=0;r<16;++r)pA1[r]=__builtin_amdgcn_exp2f(pA1[r]);
  WAIT_BAR(0);
  DMA_K(3,0);DMA_V(1,SLOTB);
  ROT();
  kload8(kf,kp0+sl_cur);
  WAIT_BAR(2);
  s16x4 vlo[8],vhi[8]; u32x4 pw0,pw1,pw2,pw3;
  #define PKW(P,B) cvtpk_s(P[B],P[B+1])
  #define PAF(k) __builtin_bit_cast(bf16x8,pw##k)
  #define VFR(i) (bf16x8){vlo[i][0],vlo[i][1],vlo[i][2],vlo[i][3],vhi[i][0],vhi[i][1],vhi[i][2],vhi[i][3]}
  #define PIN(x) asm volatile("":"+v"(x))
  #define MX3(a,b,c) __builtin_fmaxf(__builtin_fmaxf((a),(b)),(c))
  #define GAPA(MF,A0,A1,A2,A3,W0,W1,PW) do{ MF; sacc+=A0; sacc+=A1; sacc+=A2; sacc+=A3; PIN(sacc); W0; W1; PIN(PW); SBAR(); }while(0)
  #define EX(v) __builtin_amdgcn_exp2f(v)
  #define GAPB(MF,X,B) do{ MF; X[B]=EX(X[B]); X[B+1]=EX(X[B+1]); X[B+2]=EX(X[B+2]); X[B+3]=EX(X[B+3]); PIN(X); SBAR(); }while(0)
  #define VRD(i) do{ vlo[i]=vtr(vp_+(((i)>>2)*4096+((i)&3)*1024)); vhi[i]=vtr(vp_+(((i)>>2)*4096+((i)&3)*1024+512)); }while(0)
  #define KRD(G,j) do{ if(G){ kload2(kf,kp0+sl_next,j); SBAR(); } }while(0)
  #define STEP(C0,C1,P0,P1,t,GK,GV,GL) do{ SBAR(); \
    const lds_cptr vp_=vp0+sl_prev; \
    VRD(0); SBAR(); float sacc=(P0[0]+P0[1]); \
    GAPA(C0=__builtin_amdgcn_mfma_f32_32x32x16_bf16(kf[0],qr[0],negm,0,0,0), P0[2],P0[3],P0[4],P0[5],     pw0[0]=PKW(P0,0), pw0[1]=PKW(P0,2), pw0); \
    VRD(4); SBAR(); GAPA(C1=__builtin_amdgcn_mfma_f32_32x32x16_bf16(kf[1],qr[0],negm,0,0,0), P0[6],P0[7],P0[8],P0[9],     pw0[2]=PKW(P0,4), pw0[3]=PKW(P0,6), pw0); \
    VRD(1); SBAR(); GAPA(C0=__builtin_amdgcn_mfma_f32_32x32x16_bf16(kf[2],qr[1],C0,0,0,0),   P0[10],P0[11],P0[12],P0[13], pw1[0]=PKW(P0,8), pw1[1]=PKW(P0,10), pw1); \
    VRD(5); SBAR(); GAPA(C1=__builtin_amdgcn_mfma_f32_32x32x16_bf16(kf[3],qr[1],C1,0,0,0),   P0[14],P0[15],P1[0],P1[1],   pw1[2]=PKW(P0,12),pw1[3]=PKW(P0,14), pw1); \
    VRD(2); SBAR(); GAPA(C0=__builtin_amdgcn_mfma_f32_32x32x16_bf16(kf[4],qr[2],C0,0,0,0),   P1[2],P1[3],P1[4],P1[5],     pw2[0]=PKW(P1,0), pw2[1]=PKW(P1,2), pw2); \
    VRD(6); SBAR(); GAPA(C1=__builtin_amdgcn_mfma_f32_32x32x16_bf16(kf[5],qr[2],C1,0,0,0),   P1[6],P1[7],P1[8],P1[9],     pw2[2]=PKW(P1,4), pw2[3]=PKW(P1,6), pw2); \
    VRD(3); SBAR(); GAPA(C0=__builtin_amdgcn_mfma_f32_32x32x16_bf16(kf[6],qr[3],C0,0,0,0),   P1[10],P1[11],P1[12],P1[13], pw3[0]=PKW(P1,8), pw3[1]=PKW(P1,10), pw3); \
    VRD(7); SBAR(); GAPA(C1=__builtin_amdgcn_mfma_f32_32x32x16_bf16(kf[7],qr[3],C1,0,0,0),   P1[14],P1[15],0.f,0.f,       pw3[2]=PKW(P1,12),pw3[3]=PKW(P1,14), pw3); \
    l_reg+=sacc; \
    if(GK){DMA_K((t)+3,sl_cur);} if(GV){DMA_V((t)+1,sl_next);} \
    CMASK(C0,C1,t); \
    { float a=MX3(C0[0],C0[1],C1[0]),b=MX3(C0[2],C0[3],C1[1]); a=MX3(a,C1[2],C1[3]); \
      _Pragma("unroll") for(int r=4;r<16;r+=4){a=MX3(a,C0[r],C0[r+1]);b=MX3(b,C0[r+2],C0[r+3]);a=MX3(a,C1[r],C1[r+1]);b=MX3(b,C1[r+2],C1[r+3]);} \
      float rm=__builtin_fmaxf(a,b); { auto rr=__builtin_amdgcn_permlane32_swap(__float_as_uint(rm),__float_as_uint(rm),false,false); rm=__builtin_fmaxf(__uint_as_float(rr[0]),__uint_as_float(rr[1])); } \
      resc=false; \
      if(__builtin_expect(__any(rm>(float)THRL),0)){ const float dl=__builtin_fmaxf(rm,0.f); mhat+=dl; \
        _Pragma("unroll") for(int r=0;r<16;++r){C0[r]-=dl;C1[r]-=dl;} \
        _Pragma("unroll") for(int r=0;r<16;++r)negm[r]=-mhat; asm volatile("":"+v"(negm)); \
        const float f=__builtin_amdgcn_exp2f(-dl); l_reg*=f; if(hi==0)wsf[r32]=f; resc=true; } } \
    SBAR(); \
    GAPB(o[0]=__builtin_amdgcn_mfma_f32_32x32x16_bf16(PAF(0),VFR(0),o[0],0,0,0), C0,0); \
    GAPB(o[1]=__builtin_amdgcn_mfma_f32_32x32x16_bf16(PAF(0),VFR(4),o[1],0,0,0), C0,4); \
    KRD(GL,0); GAPB(o[0]=__builtin_amdgcn_mfma_f32_32x32x16_bf16(PAF(1),VFR(1),o[0],0,0,0), C0,8); \
    KRD(GL,1); GAPB(o[1]=__builtin_amdgcn_mfma_f32_32x32x16_bf16(PAF(1),VFR(5),o[1],0,0,0), C0,12); \
    KRD(GL,2); GAPB(o[0]=__builtin_amdgcn_mfma_f32_32x32x16_bf16(PAF(2),VFR(2),o[0],0,0,0), C1,0); \
    KRD(GL,3); GAPB(o[1]=__builtin_amdgcn_mfma_f32_32x32x16_bf16(PAF(2),VFR(6),o[1],0,0,0), C1,4); \
    GAPB(o[0]=__builtin_amdgcn_mfma_f32_32x32x16_bf16(PAF(3),VFR(3),o[0],0,0,0), C1,8); \
    GAPB(o[1]=__builtin_amdgcn_mfma_f32_32x32x16_bf16(PAF(3),VFR(7),o[1],0,0,0), C1,12); \
    }while(0)
  int t=1;
  #undef CMASK
  #define CMASK(P0,P1,t) do{}while(0)
  for(;t+5<NT;t+=2){
    STEP(pB0,pB1,pA0,pA1,t,true,true,true);     WAIT_BAR(2); RESC(); ROT();
    STEP(pA0,pA1,pB0,pB1,t+1,true,true,true);   WAIT_BAR(2); RESC(); ROT();
  }
  #undef CMASK
  #define CMASK(P0,P1,t) do{}while(0)
  #define ENDW(tt) do{ if((tt)+3<NT){WAIT_BAR(2);} else if((tt)+2<NT){WAIT_BAR(1);} else {WAIT_BAR(0);} }while(0)
  for(;t+1<NT;t+=2){
    STEP(pB0,pB1,pA0,pA1,t,(t+3<NT),(t+1<NT),(t+1<NT));       ENDW(t);   RESC(); ROT();
    STEP(pA0,pA1,pB0,pB1,t+1,(t+4<NT),(t+2<NT),(t+2<NT));     ENDW(t+1); RESC(); ROT();
  }
  STEP(pB0,pB1,pA0,pA1,NT-1,false,false,false); RESC();
  { float sacc=pB0[0]+pB0[1]; _Pragma("unroll") for(int r=2;r<16;++r)sacc+=pB0[r]; _Pragma("unroll") for(int r=0;r<16;++r)sacc+=pB1[r]; l_reg+=sacc;
    pw0=(u32x4){PKW(pB0,0),PKW(pB0,2),PKW(pB0,4),PKW(pB0,6)};pw1=(u32x4){PKW(pB0,8),PKW(pB0,10),PKW(pB0,12),PKW(pB0,14)};pw2=(u32x4){PKW(pB1,0),PKW(pB1,2),PKW(pB1,4),PKW(pB1,6)};pw3=(u32x4){PKW(pB1,8),PKW(pB1,10),PKW(pB1,12),PKW(pB1,14)};
    SBAR(); pv(o,vb0+sl_cur,PAF(0),PAF(1),PAF(2),PAF(3)); }
  #undef PKW
  #undef PAF
  #undef VFR
  #undef PIN
  #undef MX3
  #undef GAPA
  #undef GAPB
  #undef EX
  #undef VRD
  #undef KRD
  #undef STEP
  #undef ENDW
  {auto rr=__builtin_amdgcn_permlane32_swap(__float_as_uint(l_reg),__float_as_uint(l_reg),false,false);l_reg=__uint_as_float(rr[0])+__uint_as_float(rr[1]);}
  if(hi==0)wsf[32+r32]=l_reg;asm volatile("s_waitcnt lgkmcnt(0)":::"memory");
  float rli[16];
  #pragma unroll
  for(int r=0;r<16;++r)rli[r]=__builtin_amdgcn_rcpf(wsf[32+crow(r,hi)]);
  bf16*Ow=O+(rowbase+q0+wid*QBLK)*OP+h*D;
  { bf16*stg=(bf16*)(shm+LDS_OST)+wid*2048;
    #pragma unroll
    for(int r=0;r<16;++r){const int orow=crow(r,hi);
      #pragma unroll
      for(int d0=0;d0<2;++d0)stg[orow*64+d0*32+r32]=__float2bfloat16(o[d0][r]*rli[r]);}
    asm volatile("s_waitcnt lgkmcnt(0)":::"memory");
    #pragma unroll
    for(int i=0;i<4;++i){const int row=i*8+(lane>>3),ch=lane&7; const u32x4 v=*(const u32x4*)(stg+row*64+ch*8); ATTN_STORE16(Ow+(long)row*OP+ch*8,v);} }
  asm volatile("s_waitcnt lgkmcnt(0)\n\ts_barrier":::"memory");
  #undef DMA_K
  #undef DMA_V
  #undef CMASK
  #undef START
  #undef RESC
  #undef ROT
}
constexpr int ATTN_LDS_BYTES=LDS_BYTES;
struct AttnTensors { const bf16* Q; const bf16* K; const bf16* V; bf16* O; };
struct AttnUnit { int bh; int qb; };
struct StaticOrder {
  int vcu;
  __device__ __forceinline__ explicit StaticOrder(int grid,int block):vcu((block%8)*(grid/8)+block/8){}
  __device__ __forceinline__ bool next(int i,AttnUnit&u)const{ if(i>=4)return false; u.bh=vcu>>4; u.qb=(vcu&15)*4+i; return true; }
  __device__ __forceinline__ void a_ready(const AttnUnit&)const{}
  __device__ __forceinline__ void done(const AttnUnit&)const{}
};
template<class Sched,int THRL=8> __device__ __forceinline__ void attn_phase(char*lds,const AttnTensors&T,const Sched&S){
  AttnUnit u;
  for(int i=0;S.next(i,u);++i){ S.a_ready(u); attn_unit<THRL>(u.bh/NHEAD,u.bh%NHEAD,u.qb,T.Q,T.K,T.V,T.O,lds); S.done(u); }
}
#undef SBAR
#undef WAIT_BAR
}

struct Params {
    const float *x, *mem, *ln_in_g, *ln_in_b, *w_mem_kv, *w_in_a, *w_in_b, *q_norm_g, *k_norm_g, *w_in_c, *w_out, *ln_g, *ln_b;
    float* out; unsigned char* ws;
    int s0, s1;
};

DEV float bf2f(bf16_t b) { return __uint_as_float(((unsigned)b) << 16); }
DEV bf16_t f2bf(float f) { unsigned u = __float_as_uint(f); return (bf16_t)((u + 0x7fffu + ((u >> 16) & 1u)) >> 16); }
DEV unsigned pk2(float lo, float hi) { return (unsigned)f2bf(lo) | ((unsigned)f2bf(hi) << 16); }
DEV float wave_sum(float v) {
#pragma unroll
    for (int o = 1; o < 64; o <<= 1) v += __shfl_xor(v, o);
    return v;
}
DEV float silu(float x) { return x / (1.f + __expf(-x)); }
DEV void load8(const bf16_t* p, float* o) {
    u32x4 v = *(const u32x4*)p;
    o[0] = __uint_as_float(v.x << 16); o[1] = __uint_as_float(v.x & 0xffff0000u);
    o[2] = __uint_as_float(v.y << 16); o[3] = __uint_as_float(v.y & 0xffff0000u);
    o[4] = __uint_as_float(v.z << 16); o[5] = __uint_as_float(v.z & 0xffff0000u);
    o[6] = __uint_as_float(v.w << 16); o[7] = __uint_as_float(v.w & 0xffff0000u);
}
DEV void store8(bf16_t* p, const float* o) {
    u32x4 v; v.x = pk2(o[0], o[1]); v.y = pk2(o[2], o[3]); v.z = pk2(o[4], o[5]); v.w = pk2(o[6], o[7]);
    *(u32x4*)p = v;
}
DEV int ltid() { int t = threadIdx.x; asm volatile("" : "+v"(t)); return t; }
#define GTID ((size_t)blockIdx.x * blockDim.x + ltid())
#define GSZ ((size_t)gridDim.x * blockDim.x)

DEV void tconv(const float* src, int K, int Ntot, int ncols, bf16_t* dst, int mode) {
    const size_t total = (size_t)ncols * (K / 8);
    for (size_t idx = GTID; idx < total; idx += GSZ) {
        const int n = (int)(idx % ncols), kc = (int)(idx / ncols);
        int sc = n;
        if (mode == 1 && n < 9216) { const int g = n / 3072, rem = n % 3072, which = rem / 1024, r = rem % 1024; sc = which * 3072 + g * 1024 + r; }
        float v[8];
#pragma unroll
        for (int j = 0; j < 8; ++j) v[j] = src[(size_t)(kc * 8 + j) * Ntot + sc];
        store8(dst + (size_t)n * K + kc * 8, v);
    }
}
DEV void make_wdft(bf16_t* w) {
    for (size_t idx = GTID; idx < 512 * 256; idx += GSZ) {
        const int n = (int)(idx >> 8), c = (int)(idx & 255), which = n >> 8, l = n & 255;
        float s, co; sincospif((float)((l * c) & 255) / 128.f, &s, &co);
        w[idx] = f2bf(which == 0 ? co : -s);
    }
}
DEV void make_mkv(const float* mem, const float* w, float* mkv) {
    for (size_t idx = GTID; idx < 256 * 512; idx += GSZ) {
        const int m = (int)(idx >> 9), n = (int)(idx & 511);
        float a = 0.f;
        for (int k = 0; k < 1024; ++k) a += mem[m * 1024 + k] * w[(size_t)k * 512 + n];
        mkv[idx] = a;
    }
}
DEV void make_rope1d(float* tab) {
    for (size_t idx = GTID; idx < (size_t)S_ * 32; idx += GSZ) {
        const int t = (int)(idx >> 5), i = (int)(idx & 31);
        const float inv = powf(10000.f, -((float)(2 * i) / 64.f));
        const float a = (float)t * inv;
        tab[idx * 2] = cosf(a); tab[idx * 2 + 1] = sinf(a);
    }
}
DEV void ln_rows(const float* a, const float* y, float alpha, const float* g, const float* b, float* outH, bf16_t* outXN) {
    const int lane = ltid() & 63, wpb = blockDim.x >> 6;
    const int gw = blockIdx.x * wpb + (ltid() >> 6), nw = gridDim.x * wpb;
    for (int row = gw; row < S_; row += nw) {
        f32x4 v[4]; float s = 0.f;
#pragma unroll
        for (int j = 0; j < 4; ++j) {
            v[j] = *(const f32x4*)(a + (size_t)row * DM + j * 256 + lane * 4);
            if (y) { const f32x4 u = *(const f32x4*)(y + (size_t)row * DM + j * 256 + lane * 4); v[j] = v[j] * alpha + u; }
            s += (v[j].x + v[j].y) + (v[j].z + v[j].w);
        }
        const float mean = wave_sum(s) * (1.f / DM); float s2 = 0.f;
#pragma unroll
        for (int j = 0; j < 4; ++j) { v[j] = v[j] - mean; s2 += (v[j].x * v[j].x + v[j].y * v[j].y) + (v[j].z * v[j].z + v[j].w * v[j].w); }
        const float rstd = 1.f / sqrtf(wave_sum(s2) * (1.f / DM) + LN_EPS);
#pragma unroll
        for (int j = 0; j < 4; ++j) {
            const f32x4 gg = *(const f32x4*)(g + j * 256 + lane * 4), bb = *(const f32x4*)(b + j * 256 + lane * 4);
            const f32x4 o = v[j] * rstd * gg + bb;
            *(f32x4*)(outH + (size_t)row * DM + j * 256 + lane * 4) = o;
            u32x2 w; w.x = pk2(o.x, o.y); w.y = pk2(o.z, o.w);
            *(u32x2*)(outXN + (size_t)row * DM + j * 256 + lane * 4) = w;
        }
    }
}
DEV void gemm_simple(const bf16_t* A, int lda, const bf16_t* Bt, int ldb, int M, int N, int K, void* C, int ldc, int f32out) {
    const int lane = ltid() & 63, wpb = blockDim.x >> 6;
    const int gw = blockIdx.x * wpb + (ltid() >> 6), nw = gridDim.x * wpb;
    const int tn = N / 64, tiles = (M / 64) * tn, fr = lane & 15, fq = lane >> 4;
    for (int t = gw; t < tiles; t += nw) {
        const int tm = t / tn, tc = t % tn;
        f32x4 acc[4][4];
#pragma unroll
        for (int i = 0; i < 4; ++i)
#pragma unroll
            for (int j = 0; j < 4; ++j) acc[i][j] = (f32x4){0.f, 0.f, 0.f, 0.f};
        const bf16_t* ap = A + (size_t)(tm * 64 + fr) * lda + fq * 8;
        const bf16_t* bp = Bt + (size_t)(tc * 64 + fr) * ldb + fq * 8;
        for (int k0 = 0; k0 < K; k0 += 32) {
            bf16x8 a[4], b[4];
#pragma unroll
            for (int i = 0; i < 4; ++i) { a[i] = *(const bf16x8*)(ap + (size_t)i * 16 * lda + k0); b[i] = *(const bf16x8*)(bp + (size_t)i * 16 * ldb + k0); }
#pragma unroll
            for (int i = 0; i < 4; ++i)
#pragma unroll
                for (int j = 0; j < 4; ++j) acc[i][j] = __builtin_amdgcn_mfma_f32_16x16x32_bf16(a[i], b[j], acc[i][j], 0, 0, 0);
        }
#pragma unroll
        for (int i = 0; i < 4; ++i)
#pragma unroll
            for (int j = 0; j < 4; ++j)
#pragma unroll
                for (int r = 0; r < 4; ++r) {
                    const size_t off = (size_t)(tm * 64 + i * 16 + fq * 4 + r) * ldc + tc * 64 + j * 16 + fr;
                    if (f32out) ((float*)C)[off] = acc[i][j][r]; else ((bf16_t*)C)[off] = f2bf(acc[i][j][r]);
                }
    }
}
DEV int zc(int j) { return ((j >> 8) << 9) + (j & 255); }
DEV void fft_tab(float* tab) {
    __syncthreads();
    for (int i = ltid(); i < 128; i += blockDim.x) { float s, c; sincospif((float)i / 64.f, &s, &c); tab[i] = c; tab[128 + i] = s; }
    __syncthreads();
}
DEV void fft_s1(const bf16_t* Z, bf16_t* T, float* tab) {
    fft_tab(tab);
    const size_t total = (size_t)S_ * 1024;
    for (size_t idx = GTID; idx < total; idx += GSZ) {
        const int j = (int)(idx & 1023), r = (int)(idx >> 10), k1 = r >> 7, s2 = r & 127, cj = zc(j);
        float ar = 0.f, ai = 0.f;
        for (int s1 = 0; s1 < 128; ++s1) {
            const int n = (s1 * k1) & 127; const float c = tab[n], s = tab[128 + n];
            const bf16_t* zp = Z + (size_t)(128 * s1 + s2) * 2048 + cj;
            const float zr = bf2f(zp[0]), zi = bf2f(zp[256]);
            ar += zr * c + zi * s; ai += zi * c - zr * s;
        }
        float ts, tc; sincospif((float)(s2 * k1) / 8192.f, &ts, &tc);
        const float tr = ar * tc + ai * ts, ti = ai * tc - ar * ts;
        T[(size_t)r * 2048 + cj] = f2bf(tr); T[(size_t)r * 2048 + cj + 256] = f2bf(ti);
    }
}
DEV void fft_s2(const bf16_t* T, bf16_t* BR, float* tab) {
    fft_tab(tab);
    const size_t total = (size_t)S_ * 1024;
    for (size_t idx = GTID; idx < total; idx += GSZ) {
        const int j = (int)(idx & 1023), k = (int)(idx >> 10), k1 = k & 127, k2 = k >> 7, cj = zc(j);
        float acc = 0.f;
        for (int s2 = 0; s2 < 128; ++s2) {
            const int n = (s2 * k2) & 127; const float c = tab[n], s = tab[128 + n];
            const bf16_t* tp = T + (size_t)(k1 * 128 + s2) * 2048 + cj;
            acc += bf2f(tp[0]) * c + bf2f(tp[256]) * s;
        }
        BR[(size_t)k * 1024 + j] = f2bf(acc * (1.f / 2048.f));
    }
}
DEV void qk_post(bf16_t* PROJ, const float* qg, const float* kg) {
    const size_t total = (size_t)S_ * 20 * 16;
    for (size_t idx = GTID; idx < total; idx += GSZ) {
        const int i = (int)(idx & 15), head = (int)((idx >> 4) % 20), t = (int)((idx >> 4) / 20);
        bf16_t* p = PROJ + (size_t)t * 3072 + head * 64;
        float a1 = bf2f(p[i]), a2 = bf2f(p[16 + i]), b1 = bf2f(p[32 + i]), b2 = bf2f(p[48 + i]);
        float ss = a1 * a1 + a2 * a2 + b1 * b1 + b2 * b2;
        ss += __shfl_xor(ss, 1); ss += __shfl_xor(ss, 2); ss += __shfl_xor(ss, 4); ss += __shfl_xor(ss, 8);
        const float r = 1.f / sqrtf(ss * (1.f / 64.f) + 1e-6f);
        const float* g = head < 16 ? qg : kg;
        a1 *= r * g[i]; a2 *= r * g[16 + i]; b1 *= r * g[32 + i]; b2 *= r * g[48 + i];
        const float frow = (float)(t >> 6), fcol = (float)(t & 63);
        const float sc = head < 16 ? C2 : 1.f;
        const float inv = powf(10000.f, -((float)(2 * i) / 32.f));
        const float ar = frow * inv, ac = fcol * inv;
        const float cr = cosf(ar), sr = sinf(ar), cc = cosf(ac), scn = sinf(ac);
        p[i] = f2bf((a1 * cr - a2 * sr) * sc); p[16 + i] = f2bf((a2 * cr + a1 * sr) * sc);
        p[32 + i] = f2bf((b1 * cc - b2 * scn) * sc); p[48 + i] = f2bf((b2 * cc + b1 * scn) * sc);
    }
}
DEV void attn_naive(const bf16_t* PROJ, bf16_t* BR, float* lds) {
    const int nth = blockDim.x, qblocks = S_ / nth, items = 16 * qblocks;
    float* Ks = lds; float* Vs = lds + 64 * 64;
    for (int it = blockIdx.x; it < items; it += gridDim.x) {
        const int hq = it / qblocks, qb = it % qblocks, kvh = hq >> 2, t = qb * nth + ltid();
        float q[64], o[64]; float m = -1e30f, l = 0.f;
#pragma unroll
        for (int c = 0; c < 8; ++c) load8(PROJ + (size_t)t * 3072 + hq * 64 + c * 8, q + c * 8);
#pragma unroll
        for (int d = 0; d < 64; ++d) o[d] = 0.f;
        for (int k0 = 0; k0 < S_; k0 += 64) {
            __syncthreads();
            for (int e = ltid(); e < 64 * 8; e += nth) {
                const int r = e >> 3, c8 = e & 7; float tmp[8];
                load8(PROJ + (size_t)(k0 + r) * 3072 + 1024 + kvh * 64 + c8 * 8, tmp);
#pragma unroll
                for (int j = 0; j < 8; ++j) Ks[r * 64 + c8 * 8 + j] = tmp[j];
                load8(PROJ + (size_t)(k0 + r) * 3072 + 1280 + kvh * 64 + c8 * 8, tmp);
#pragma unroll
                for (int j = 0; j < 8; ++j) Vs[r * 64 + c8 * 8 + j] = tmp[j];
            }
            __syncthreads();
            for (int r = 0; r < 64; ++r) {
                float s = 0.f;
#pragma unroll
                for (int d = 0; d < 64; d += 4) { const f32x4 kk = *(const f32x4*)(Ks + r * 64 + d); s += q[d] * kk.x + q[d + 1] * kk.y + q[d + 2] * kk.z + q[d + 3] * kk.w; }
                if (s > m) { const float f = exp2f(m - s); l *= f;
#pragma unroll
                    for (int d = 0; d < 64; ++d) o[d] *= f;
                    m = s; }
                const float p = exp2f(s - m); l += p;
#pragma unroll
                for (int d = 0; d < 64; d += 4) { const f32x4 vv = *(const f32x4*)(Vs + r * 64 + d); o[d] += p * vv.x; o[d + 1] += p * vv.y; o[d + 2] += p * vv.z; o[d + 3] += p * vv.w; }
            }
        }
        const float rl = 1.f / l;
#pragma unroll
        for (int d = 0; d < 64; ++d) o[d] *= rl;
#pragma unroll
        for (int c = 0; c < 8; ++c) store8(BR + (size_t)t * 1024 + hq * 64 + c * 8, o + c * 8);
    }
    __syncthreads();
}
DEV void rope_c(bf16_t* QKV, const float* tab) {
    const size_t total = (size_t)S_ * 32;
    for (size_t idx = GTID; idx < total; idx += GSZ) {
        const int hh = (int)(idx & 31), t = (int)(idx >> 5);
        bf16_t* p = QKV + (size_t)t * 3072 + hh * 64;
        float x[64];
#pragma unroll
        for (int c = 0; c < 8; ++c) load8(p + c * 8, x + c * 8);
        const float sc = hh < 16 ? C2 : 1.f;
        const float* tb = tab + (size_t)t * 64;
#pragma unroll
        for (int i = 0; i < 32; ++i) {
            const float c = tb[2 * i], s = tb[2 * i + 1];
            const float a1 = x[i], a2 = x[32 + i];
            x[i] = (a1 * c - a2 * s) * sc; x[32 + i] = (a2 * c + a1 * s) * sc;
        }
#pragma unroll
        for (int c = 0; c < 8; ++c) store8(p + c * 8, x + c * 8);
    }
}
DEV void dil_naive(const bf16_t* QKV, float* OACC, float* ML, int g) {
    const int dil = g == 0 ? 1 : (g == 1 ? 4 : 16);
    const size_t total = (size_t)16 * S_;
    for (size_t idx = GTID; idx < total; idx += GSZ) {
        const int head = (int)(idx >> 14), t = (int)(idx & 16383);
        float q[64], o[64]; float m, l;
#pragma unroll
        for (int c = 0; c < 8; ++c) load8(QKV + (size_t)t * 3072 + head * 64 + c * 8, q + c * 8);
        if (g == 0) { m = -1e30f; l = 0.f;
#pragma unroll
            for (int d = 0; d < 64; ++d) o[d] = 0.f;
        } else {
            m = ML[((size_t)t * 16 + head) * 2]; l = ML[((size_t)t * 16 + head) * 2 + 1];
#pragma unroll
            for (int d = 0; d < 64; d += 4) { const f32x4 v = *(const f32x4*)(OACC + (size_t)t * 1024 + head * 64 + d); o[d] = v.x; o[d + 1] = v.y; o[d + 2] = v.z; o[d + 3] = v.w; }
        }
        for (int mm = -64; mm <= 64; ++mm) {
            const int tk = t + mm * dil;
            if (tk < 0 || tk >= S_) continue;
            const bf16_t* kp = QKV + (size_t)tk * 3072 + 1024 + head * 64;
            float s = 0.f;
#pragma unroll
            for (int c = 0; c < 8; ++c) { float kk[8]; load8(kp + c * 8, kk);
#pragma unroll
                for (int j = 0; j < 8; ++j) s += q[c * 8 + j] * kk[j]; }
            if (s > m) { const float f = exp2f(m - s); l *= f;
#pragma unroll
                for (int d = 0; d < 64; ++d) o[d] *= f;
                m = s; }
            const float p = exp2f(s - m); l += p;
#pragma unroll
            for (int c = 0; c < 8; ++c) { float vv[8]; load8(kp + 1024 + c * 8, vv);
#pragma unroll
                for (int j = 0; j < 8; ++j) o[c * 8 + j] += p * vv[j]; }
        }
        ML[((size_t)t * 16 + head) * 2] = m; ML[((size_t)t * 16 + head) * 2 + 1] = l;
#pragma unroll
        for (int d = 0; d < 64; d += 4) *(f32x4*)(OACC + (size_t)t * 1024 + head * 64 + d) = (f32x4){o[d], o[d + 1], o[d + 2], o[d + 3]};
    }
}
DEV void gate_naive(const bf16_t* BR, const float* OACC, const float* ML, const bf16_t* TAIL, int ldt, const float* MKV, bf16_t* YIN) {
    const size_t total = (size_t)S_ * 1024;
    for (size_t idx = GTID; idx < total; idx += GSZ) {
        const int c = (int)(idx & 1023), t = (int)(idx >> 10);
        const float br = OACC ? OACC[idx] / ML[((size_t)t * 16 + (c >> 6)) * 2 + 1] : bf2f(BR[idx]);
        const float gt = bf2f(TAIL[(size_t)t * ldt + c]);
        YIN[(size_t)t * 1280 + c] = f2bf(br * silu(gt));
    }
    const size_t total2 = (size_t)4 * S_;
    for (size_t idx = GTID; idx < total2; idx += GSZ) {
        const int mh = (int)(idx >> 14), t = (int)(idx & 16383);
        float q[64], o[64]; float m = -1e30f, l = 0.f;
#pragma unroll
        for (int c = 0; c < 8; ++c) load8(TAIL + (size_t)t * ldt + 1280 + mh * 64 + c * 8, q + c * 8);
#pragma unroll
        for (int d = 0; d < 64; ++d) { q[d] *= C2; o[d] = 0.f; }
        for (int mm = 0; mm < 256; ++mm) {
            const float* kp = MKV + (size_t)mm * 512 + mh * 64;
            float s = 0.f;
#pragma unroll
            for (int d = 0; d < 64; ++d) s += q[d] * kp[d];
            if (s > m) { const float f = exp2f(m - s); l *= f;
#pragma unroll
                for (int d = 0; d < 64; ++d) o[d] *= f;
                m = s; }
            const float p = exp2f(s - m); l += p;
#pragma unroll
            for (int d = 0; d < 64; ++d) o[d] += p * kp[256 + d];
        }
        const float rl = 1.f / l;
#pragma unroll
        for (int c = 0; c < 8; ++c) { float gt[8]; load8(TAIL + (size_t)t * ldt + 1024 + mh * 64 + c * 8, gt);
#pragma unroll
            for (int j = 0; j < 8; ++j) o[c * 8 + j] = o[c * 8 + j] * rl * silu(gt[j]); }
#pragma unroll
        for (int c = 0; c < 8; ++c) store8(YIN + (size_t)t * 1280 + 1024 + mh * 64 + c * 8, o + c * 8);
    }
}


#define LAS3 __attribute__((address_space(3)))
DEV void gemm_bf16(unsigned char* lds_raw, const bf16_t* A, int lda, const bf16_t* Bt, int M, int N, int K, bf16_t* C, int ldc, int G, int c) {
    pg8::Gemm g{A, Bt, M, N, K, lda}; pg8::StaticOrder So; So.init(M, N, G, c);
    pg8::EpiBf16<0> E{C, ldc, nullptr, 0, 0, 1.f};
    pg8::gemm_phase<pg8::EpiBf16<0>, pg8::StaticOrder, PG8_ALIGN, PG8_SP2>((LAS3 unsigned char*)lds_raw, g, So, E);
}
DEV void gemm_f32(unsigned char* lds_raw, const bf16_t* A, int lda, const bf16_t* Bt, int M, int N, int K, float* C, int ldc, int G, int c) {
    pg8::Gemm g{A, Bt, M, N, K, lda}; pg8::StaticOrder So; So.init(M, N, G, c);
    pg8::EpiF32 E{C, ldc};
    pg8::gemm_phase<pg8::EpiF32, pg8::StaticOrder, PG8_ALIGN, PG8_SP2>((LAS3 unsigned char*)lds_raw, g, So, E);
}
#define STEP_BEGIN { unsigned char* ws = p.ws; asm volatile("" : "+s"(ws)); float* H = p.out; float* lds = (float*)lds_raw;
#define STEP_END   } grid.sync();
#define AR(off) (ws + WS_AR + (size_t)(off) * MiB)
#define P_WtA ((bf16_t*)(ws + WS_WA))
#define P_WtB ((bf16_t*)(ws + WS_WB))
#define P_WtC ((bf16_t*)(ws + WS_WC))
#define P_WtO ((bf16_t*)(ws + WS_WO))
#define P_Wdft ((bf16_t*)(ws + WS_WDFT))
#define P_MKV ((float*)(ws + WS_MKV))
#define P_XN ((bf16_t*)(ws + WS_XN))
#define GC (int)gridDim.x, (int)blockIdx.x
#define LNG (p.ln_g + LAYER * 1024)
#define LNB (p.ln_b + LAYER * 1024)
#define WO (P_WtO + (size_t)LAYER * 1024 * 1280)

template <int LAYER> DEV void layer_A(const Params& p, cg::grid_group& grid, unsigned char* lds_raw) {
    STEP_BEGIN
        gemm_bf16(lds_raw, P_XN, 1024, P_WtA + (size_t)(LAYER / 3) * 1536 * 1024, S_, 1536, 1024, (bf16_t*)AR(0), 1536, GC);
        if ((gridDim.x & 3) == 0) { const int g = blockIdx.x & 3; gemm_bf16(lds_raw, P_XN + g * 256, 1024, P_Wdft, S_, 512, 256, (bf16_t*)AR(48) + g * 512, 2048, (int)gridDim.x >> 2, (int)blockIdx.x >> 2); }
        else for (int g = 0; g < 4; ++g) gemm_bf16(lds_raw, P_XN + g * 256, 1024, P_Wdft, S_, 512, 256, (bf16_t*)AR(48) + g * 512, 2048, GC);
    STEP_END
    STEP_BEGIN fft_s1((bf16_t*)AR(48), (bf16_t*)AR(112), lds); STEP_END
    STEP_BEGIN fft_s2((bf16_t*)AR(112), (bf16_t*)AR(48), lds); STEP_END
    STEP_BEGIN gate_naive((bf16_t*)AR(48), nullptr, nullptr, (bf16_t*)AR(0), 1536, P_MKV, (bf16_t*)AR(80)); STEP_END
    STEP_BEGIN gemm_f32(lds_raw, (bf16_t*)AR(80), 1280, WO, S_, 1024, 1280, (float*)AR(0), 1024, GC); STEP_END
    STEP_BEGIN ln_rows(H, (float*)AR(0), ALPHA, LNG, LNB, H, P_XN); STEP_END
}
template <int LAYER> DEV void layer_B(const Params& p, cg::grid_group& grid, unsigned char* lds_raw) {
    STEP_BEGIN gemm_bf16(lds_raw, P_XN, 1024, P_WtB, S_, 3072, 1024, (bf16_t*)AR(0), 3072, GC); STEP_END
    STEP_BEGIN qk_post((bf16_t*)AR(0), p.q_norm_g, p.k_norm_g); STEP_END
    STEP_BEGIN
        bf16_t* PROJ = (bf16_t*)AR(0); bf16_t* BR = (bf16_t*)AR(96);
        if (gridDim.x == 256) {
            const attn_body::AttnTensors AT{(const attn_body::bf16*)PROJ, (const attn_body::bf16*)(PROJ + 1024), (const attn_body::bf16*)(PROJ + 1280), (attn_body::bf16*)BR};
            const attn_body::StaticOrder SA((int)gridDim.x, (int)blockIdx.x);
            attn_body::attn_phase<attn_body::StaticOrder>((char*)lds_raw, AT, SA);
        } else attn_naive(PROJ, BR, lds);
    STEP_END
    STEP_BEGIN gate_naive((bf16_t*)AR(96), nullptr, nullptr, (bf16_t*)AR(0) + 1536, 3072, P_MKV, (bf16_t*)AR(128)); STEP_END
    STEP_BEGIN gemm_f32(lds_raw, (bf16_t*)AR(128), 1280, WO, S_, 1024, 1280, (float*)AR(0), 1024, GC); STEP_END
    STEP_BEGIN ln_rows(H, (float*)AR(0), ALPHA, LNG, LNB, H, P_XN); STEP_END
}
template <int LAYER> DEV void layer_C(const Params& p, cg::grid_group& grid, unsigned char* lds_raw) {
    for (int g = 0; g < 3; ++g) {
        STEP_BEGIN
            gemm_bf16(lds_raw, P_XN, 1024, P_WtC + (size_t)g * 3072 * 1024, S_, 3072, 1024, (bf16_t*)AR(0), 3072, GC);
            if (g == 0) make_rope1d((float*)AR(164));
        STEP_END
        STEP_BEGIN rope_c((bf16_t*)AR(0), (float*)AR(164)); STEP_END
        STEP_BEGIN dil_naive((bf16_t*)AR(0), (float*)AR(96), (float*)AR(160), g); STEP_END
    }
    STEP_BEGIN gemm_bf16(lds_raw, P_XN, 1024, P_WtC + (size_t)9216 * 1024, S_, 1536, 1024, (bf16_t*)AR(0), 1536, GC); STEP_END
    STEP_BEGIN gate_naive(nullptr, (float*)AR(96), (float*)AR(160), (bf16_t*)AR(0), 1536, P_MKV, (bf16_t*)AR(48)); STEP_END
    STEP_BEGIN gemm_f32(lds_raw, (bf16_t*)AR(48), 1280, WO, S_, 1024, 1280, (float*)AR(96), 1024, GC); STEP_END
    STEP_BEGIN ln_rows(H, (float*)AR(96), ALPHA, LNG, LNB, H, P_XN); STEP_END
}

__global__ void __launch_bounds__(NTHREADS, 2) mk(Params p) {
    extern __shared__ __attribute__((aligned(16))) unsigned char lds_raw[];
    cg::grid_group grid = cg::this_grid();
    STEP_BEGIN
        tconv(p.w_in_a, 1024, 1536, 1536, P_WtA, 0);
        tconv(p.w_in_a + (size_t)1024 * 1536, 1024, 1536, 1536, P_WtA + (size_t)1536 * 1024, 0);
        tconv(p.w_in_b, 1024, 3072, 3072, P_WtB, 0);
        tconv(p.w_in_c, 1024, 10752, 10752, P_WtC, 1);
        for (int i = 0; i < 4; ++i) tconv(p.w_out + (size_t)i * 1280 * 1024, 1280, 1024, 1024, P_WtO + (size_t)i * 1024 * 1280, 0);
        make_wdft(P_Wdft);
        make_mkv(p.mem, p.w_mem_kv, P_MKV);
        ln_rows(p.x, nullptr, 1.f, p.ln_in_g, p.ln_in_b, H, P_XN);
    STEP_END
    layer_A<0>(p, grid, lds_raw);
    layer_B<1>(p, grid, lds_raw);
    layer_C<2>(p, grid, lds_raw);
    layer_A<3>(p, grid, lds_raw);
}

extern "C" void kernel_launch(void* const* d_in, const int* in_sizes, int n_in, void* d_out, int out_size, void* d_ws, size_t ws_size, hipStream_t stream) {
    if (n_in != 13 || ws_size < 256 * MiB) { fprintf(stderr, "kernel_launch: unexpected inputs (n_in %d, ws %zu)\n", n_in, ws_size); return; }
    Params p{};
    p.x = (const float*)d_in[0]; p.mem = (const float*)d_in[1]; p.ln_in_g = (const float*)d_in[2]; p.ln_in_b = (const float*)d_in[3];
    p.w_mem_kv = (const float*)d_in[4]; p.w_in_a = (const float*)d_in[5]; p.w_in_b = (const float*)d_in[6]; p.q_norm_g = (const float*)d_in[7];
    p.k_norm_g = (const float*)d_in[8]; p.w_in_c = (const float*)d_in[9]; p.w_out = (const float*)d_in[10]; p.ln_g = (const float*)d_in[11]; p.ln_b = (const float*)d_in[12];
    p.out = (float*)d_out; p.ws = (unsigned char*)d_ws;
    static int grid_blocks = 0;
    if (!grid_blocks) {
        int dev = 0, cus = 0, per_cu = 0;
        hipGetDevice(&dev);
        hipDeviceGetAttribute(&cus, hipDeviceAttributeMultiprocessorCount, dev);
        hipFuncSetAttribute((const void*)mk, hipFuncAttributeMaxDynamicSharedMemorySize, LDS_BYTES);
        hipOccupancyMaxActiveBlocksPerMultiprocessor(&per_cu, (const void*)mk, NTHREADS, LDS_BYTES);
        if (per_cu < 1) per_cu = 1;
        grid_blocks = cus * per_cu;
    }
    p.s0 = 0; p.s1 = NSTEPS;
    void* args[] = {&p};
    hipError_t e = hipLaunchCooperativeKernel((const void*)mk, dim3(grid_blocks), dim3(NTHREADS), args, LDS_BYTES, stream);
    if (e != hipSuccess) fprintf(stderr, "cooperative launch failed: %s (grid %d)\n", hipGetErrorString(e), grid_blocks);
}
```

```cpp
#include <hip/hip_runtime.h>
#include <hip/hip_cooperative_groups.h>
#include <cstdio>
#include <cstdint>
namespace cg = cooperative_groups;

#define DEV __device__ __forceinline__
typedef unsigned short bf16_t;
typedef short bf16x8 __attribute__((ext_vector_type(8)));
typedef float f32x4 __attribute__((ext_vector_type(4)));
typedef unsigned u32x4 __attribute__((ext_vector_type(4)));
typedef unsigned u32x2 __attribute__((ext_vector_type(2)));

constexpr int S_ = 16384, DM = 1024;
constexpr float ALPHA = 1.681792830507429f;
constexpr float C2 = 0.125f * 1.4426950408889634f;
constexpr float LN_EPS = 1e-5f;
constexpr size_t MiB = 1u << 20;
constexpr size_t WS_WA = 2 * MiB, WS_WB = 8 * MiB, WS_WC = 14 * MiB, WS_WO = 35 * MiB, WS_WDFT = 45 * MiB, WS_MKV = 45 * MiB + 512 * 1024;
constexpr size_t WS_XN = 48 * MiB, WS_AR = 80 * MiB;
constexpr int NTHREADS = 512;
constexpr int NSTEPS = 32;
constexpr int LDS_BYTES = 147456;


namespace pg8 {
#define PG8_LAS __attribute__((address_space(3)))
typedef unsigned short bf16_t;
typedef short bf16x8 __attribute__((ext_vector_type(8)));
typedef float f32x4 __attribute__((ext_vector_type(4)));
typedef unsigned u32x4 __attribute__((ext_vector_type(4)));
constexpr int BM = 256, BK = 64, HALF = 128, HTB = HALF * BK * 2  , STAGE_BYTES = 8 * HTB, NXCD = 8, WGM = 8;

__host__ __device__ __forceinline__ int lds_byte(int r, int c) { const int st = (r >> 4) * 2 + (c >> 5), rr = r & 15, cc = c & 31, ob = rr * 64 + cc * 2; return st * 1024 + (ob ^ (((ob >> 9) & 1) << 5)); }
__host__ __device__ __forceinline__ void stage_rc(int b, int& R, int& C) { const int st = b / 1024, sb = b % 1024, swz = sb ^ (((sb >> 9) & 1) << 5); R = (st >> 1) * 16 + swz / 64; C = (st & 1) * 32 + (swz % 64) / 2; }
__host__ __device__ __forceinline__ int perm32(int rho) { const int n = rho >> 4, i = rho & 15; return 8 * (i >> 2) + 4 * n + (i & 3); }

struct Unit { int pm, pn; };
struct Gemm { const bf16_t* A; const bf16_t* Bt; int M, N, K, lda; };

struct StaticOrder {
    int nM, nN, nwg, G, c;
    __host__ __device__ void init(int M, int N, int G_, int c_) { nM = M / BM; nN = N / BM; nwg = nM * nN; G = G_; c = c_; }
    __host__ __device__ bool next(int i, Unit& u) const {
        const long L = (long)i * G + c; if (L >= nwg) return false;
        int wgid = (int)L; { const int q = nwg / NXCD, r = nwg % NXCD, xcd = wgid % NXCD, off = wgid / NXCD; wgid = (xcd < r ? xcd * (q + 1) : r * (q + 1) + (xcd - r) * q) + off; }
        const int nig = WGM * nN, gid = wgid / nig, fm = gid * WGM, gsz = (nM - fm) < WGM ? (nM - fm) : WGM;
        u.pm = fm + ((wgid % nig) % gsz); u.pn = (wgid % nig) / gsz; return true;
    }
    __device__ __forceinline__ void a_ready(const Unit&) const {}
    __device__ __forceinline__ void done(const Unit&) const {}
};

__device__ __forceinline__ unsigned cvt_pk_bf16(float lo, float hi) { unsigned r; asm volatile("v_cvt_pk_bf16_f32 %0, %1, %2" : "=v"(r) : "v"(lo), "v"(hi)); return r; }
typedef float f32x2 __attribute__((ext_vector_type(2)));
__device__ __forceinline__ f32x2 gelu_pk(f32x2 v) {
    const f32x2 av = __builtin_elementwise_abs(v), d = av * 0.2316418882f + 1.0f;
    f32x2 t; t.x = __builtin_amdgcn_rcpf(d.x); t.y = __builtin_amdgcn_rcpf(d.y);
    f32x2 q = t * 0.5307027145f + (-0.7265760135f); q = q * t + 0.7107068705f; q = q * t + (-0.142248368f); q = q * t + 0.127414796f; q = q * t;
    const f32x2 s = (v * v) * (-0.72134752044f);
    f32x2 e; e.x = __builtin_amdgcn_exp2f(s.x); e.y = __builtin_amdgcn_exp2f(s.y);
    const f32x2 m = v * (q * e), r = v - m;
    f32x2 o; o.x = v.x < 0.f ? m.x : r.x; o.y = v.y < 0.f ? m.y : r.y; return o;
}

template <int ACT  > struct EpiBf16 {
    static constexpr bool PERM = true, AFTER_DRAIN = false; static_assert(ACT == 0 || ACT == 1, "EpiBf16: ACT is 0 (none) or 1 (gelu_pk)");
    bf16_t* O; int ldc; const float* bias; int split_cols; size_t split_stride; float scale0;
    __device__ __forceinline__ void operator()(const f32x4 (&acc)[2][2][4][2], const Unit& u, int wr, int wc, int fr, int fq) const {
        const int row0 = u.pm * BM + wr * 64 + fr; int colt = u.pn * BM; bf16_t* base = O;
        float sc = 1.f; if (split_cols) { const int t = colt / split_cols; base += (size_t)t * split_stride; colt -= t * split_cols; if (t == 0) sc = scale0; }
        const int col0 = colt + wc * 32 + 8 * fq, bcol0 = u.pn * BM + wc * 32 + 8 * fq;
        f32x4 bv[2][2];
#pragma unroll
        for (int bj = 0; bj < 2; ++bj)
#pragma unroll
            for (int n = 0; n < 2; ++n) bv[bj][n] = bias ? *(const f32x4*)(bias + bcol0 + bj * HALF + 4 * n) : (f32x4){0.f, 0.f, 0.f, 0.f};
#pragma unroll
        for (int ai = 0; ai < 2; ++ai)
#pragma unroll
            for (int m = 0; m < 4; ++m) { bf16_t* rowp = base + (size_t)(row0 + ai * HALF + m * 16) * ldc + col0;
#pragma unroll
                for (int bj = 0; bj < 2; ++bj) { f32x4 v0 = acc[ai][bj][m][0] + bv[bj][0], v1 = acc[ai][bj][m][1] + bv[bj][1];
                    if (ACT == 1) { f32x2 a = gelu_pk((f32x2){v0[0], v0[1]}), b = gelu_pk((f32x2){v0[2], v0[3]}), c = gelu_pk((f32x2){v1[0], v1[1]}), d = gelu_pk((f32x2){v1[2], v1[3]});
                        v0 = (f32x4){a.x, a.y, b.x, b.y}; v1 = (f32x4){c.x, c.y, d.x, d.y}; }
                    v0 = v0 * sc; v1 = v1 * sc; u32x4 w; w.x = cvt_pk_bf16(v0[0], v0[1]); w.y = cvt_pk_bf16(v0[2], v0[3]); w.z = cvt_pk_bf16(v1[0], v1[1]); w.w = cvt_pk_bf16(v1[2], v1[3]);
                    *(u32x4*)(rowp + bj * HALF) = w; } }
    }
};

struct EpiF32 {
    static constexpr bool PERM = false, AFTER_DRAIN = false;
    float* O; int ldc;
    __device__ __forceinline__ void operator()(const f32x4 (&acc)[2][2][4][2], const Unit& u, int wr, int wc, int fr, int fq) const {
        const int row0 = u.pm * BM + wr * 64 + fr, col0 = u.pn * BM + wc * 32 + 4 * fq;
#pragma unroll
        for (int ai = 0; ai < 2; ++ai)
#pragma unroll
            for (int m = 0; m < 4; ++m) { float* rowp = O + (size_t)(row0 + ai * HALF + m * 16) * ldc + col0;
#pragma unroll
                for (int bj = 0; bj < 2; ++bj)
#pragma unroll
                    for (int n = 0; n < 2; ++n) *(f32x4*)(rowp + bj * HALF + n * 16) = acc[ai][bj][m][n]; }
    }
};
template <class Epi, class Sched, bool ALIGN_EPI = false, bool SP2 = false>
__device__ __forceinline__ void gemm_phase(PG8_LAS unsigned char* lds, const Gemm g, const Sched& S, const Epi& E) {
    int tid_ = threadIdx.x; asm volatile("" : "+v"(tid_)); const int tid = tid_, wid = __builtin_amdgcn_readfirstlane(tid >> 6), lane = tid & 63, wr = wid >> 2, wc = wid & 3, fr = lane & 15, fq = lane >> 4;
    const int K = g.K, nt = K / BK;
    unsigned voffA[2], voffB[2];
#pragma unroll
    for (int i = 0; i < 2; ++i) { int R, C; stage_rc(tid * 16 + i * 8192, R, C); const int Rb = Epi::PERM ? ((R & ~31) + perm32(R & 31)) : R;
        voffA[i] = (unsigned)(R * g.lda + C) * 2u; voffB[i] = (unsigned)(Rb * K + C) * 2u; }
    const size_t kstep = (size_t)(BK * 2);
    const size_t hstepB = (size_t)HALF * K * 2, hstepA = (size_t)HALF * g.lda * 2;
    const size_t tstepA = 2 * hstepA, tstepB = 2 * hstepB;
    const unsigned ldsw = (unsigned)wid * 1024u;
    const int aoff = lds_byte(wr * 64 + fr, fq * 8), boff = lds_byte(wc * 32 + fr, fq * 8);
#define PG8_SA(b, h) (((b) * 2 + (h)) * HTB)
#define PG8_SB(b, h) ((4 + (b) * 2 + (h)) * HTB)
#define PG8_STAGE(bufoff, gbase, voff) do { _Pragma("unroll") for (int _i = 0; _i < 2; ++_i) \
        __builtin_amdgcn_global_load_lds((const unsigned*)((const char*)(gbase) + (voff)[_i]), (PG8_LAS unsigned*)(lds + (bufoff) + ldsw + _i * 8192), 16, 0, 0); } while (0)
#define PG8_LDA(dst, b, h) do { _Pragma("unroll") for (int m = 0; m < 4; ++m) _Pragma("unroll") for (int k = 0; k < 2; ++k) dst[m][k] = *(const PG8_LAS bf16x8*)(lds + PG8_SA(b, h) + aoff + m * 2048 + k * 1024); } while (0)
#define PG8_LDB(dst, b, h) do { _Pragma("unroll") for (int n = 0; n < 2; ++n) _Pragma("unroll") for (int k = 0; k < 2; ++k) dst[n][k] = *(const PG8_LAS bf16x8*)(lds + PG8_SB(b, h) + boff + n * 2048 + k * 1024); } while (0)
#define PG8_MMA(ai, bj, At, Bt) do { __builtin_amdgcn_s_setprio(1); _Pragma("unroll") for (int m = 0; m < 4; ++m) _Pragma("unroll") for (int n = 0; n < 2; ++n) _Pragma("unroll") for (int k = 0; k < 2; ++k) \
        acc[ai][bj][m][n] = __builtin_amdgcn_mfma_f32_16x16x32_bf16(Bt[n][k], At[m][k], acc[ai][bj][m][n], 0, 0, 0); __builtin_amdgcn_s_setprio(0); } while (0)
#define PG8_WAIT_V(n) asm volatile("s_waitcnt vmcnt(" #n ")" ::: "memory")
#define PG8_WAIT_L(n) asm volatile("s_waitcnt lgkmcnt(" #n ")" ::: "memory")
#define PG8_BAR __builtin_amdgcn_s_barrier()
#define PG8_SCHED __builtin_amdgcn_sched_barrier(0)
    Unit cur, nxt; int ui = 0;
    if (!S.next(0, cur)) return;
    f32x4 acc[2][2][4][2];
#pragma unroll
    for (int a = 0; a < 2; ++a)
#pragma unroll
        for (int b = 0; b < 2; ++b)
#pragma unroll
            for (int m = 0; m < 4; ++m)
#pragma unroll
                for (int n = 0; n < 2; ++n) acc[a][b][m][n] = (f32x4){0.f, 0.f, 0.f, 0.f};
    bf16x8 At[4][2], B0[2][2], B1[2][2];
    const char* cA = (const char*)g.A + (size_t)cur.pm * tstepA; const char* cB = (const char*)g.Bt + (size_t)cur.pn * tstepB;
    S.a_ready(cur);
    if constexpr (SP2) {
        PG8_STAGE(PG8_SB(0, 0), cB, voffB); PG8_STAGE(PG8_SB(0, 1), cB + hstepB, voffB); PG8_STAGE(PG8_SA(0, 0), cA, voffA); PG8_STAGE(PG8_SA(0, 1), cA + hstepA, voffA);
        if (wr == 1) PG8_BAR;
        PG8_WAIT_V(2); PG8_BAR;
        PG8_STAGE(PG8_SB(1, 0), cB + kstep, voffB); PG8_STAGE(PG8_SA(1, 0), cA + kstep, voffA); PG8_STAGE(PG8_SB(1, 1), cB + hstepB + kstep, voffB);
        PG8_WAIT_V(6); PG8_BAR;
    } else {
        PG8_STAGE(PG8_SB(0, 0), cB, voffB); PG8_STAGE(PG8_SA(0, 0), cA, voffA); PG8_STAGE(PG8_SB(0, 1), cB + hstepB, voffB); PG8_STAGE(PG8_SA(0, 1), cA + hstepA, voffA);
        if (wr == 1) PG8_BAR;
        PG8_WAIT_V(4); PG8_BAR;
        PG8_STAGE(PG8_SB(1, 0), cB + kstep, voffB); PG8_STAGE(PG8_SA(1, 0), cA + kstep, voffA); PG8_STAGE(PG8_SB(1, 1), cB + hstepB + kstep, voffB);
        PG8_WAIT_V(6); PG8_BAR;
    }
    for (;;) {
        const bool has_next = S.next(ui + 1, nxt);
        const char* nA = has_next ? (const char*)g.A + (size_t)nxt.pm * tstepA : cA; const char* nB = has_next ? (const char*)g.Bt + (size_t)nxt.pn * tstepB : cB;
        for (int t = 0; t < nt; t += 2) {
            const bool last = (t == nt - 2);
            const char* a1 = cA + (size_t)(t + 1) * kstep;
            const char* a2 = last ? nA : cA + (size_t)(t + 2) * kstep; const char* b2 = last ? nB : cB + (size_t)(t + 2) * kstep;
            const char* a3 = a2 + kstep; const char* b3 = b2 + kstep;
            if (last && has_next) S.a_ready(nxt);
            if constexpr (SP2) {
            PG8_LDB(B0, 0, 0); PG8_LDB(B1, 0, 1); PG8_SCHED; PG8_LDA(At, 0, 0); PG8_STAGE(PG8_SA(1, 1), a1 + hstepA, voffA);
            PG8_WAIT_V(8); PG8_WAIT_L(0); PG8_BAR; PG8_MMA(0, 0, At, B0); PG8_MMA(0, 1, At, B1); PG8_BAR; PG8_SCHED;
            PG8_LDA(At, 0, 1); PG8_STAGE(PG8_SB(0, 0), b2, voffB); PG8_STAGE(PG8_SB(0, 1), b2 + hstepB, voffB); PG8_STAGE(PG8_SA(0, 0), a2, voffA);
            PG8_WAIT_V(8); PG8_WAIT_L(0); PG8_BAR; PG8_MMA(1, 0, At, B0); PG8_MMA(1, 1, At, B1); PG8_BAR; PG8_SCHED;
            PG8_LDB(B0, 1, 0); PG8_LDB(B1, 1, 1); PG8_SCHED; PG8_LDA(At, 1, 0); PG8_STAGE(PG8_SA(0, 1), a2 + hstepA, voffA);
            PG8_WAIT_V(8); PG8_WAIT_L(0); PG8_BAR; PG8_MMA(0, 0, At, B0); PG8_MMA(0, 1, At, B1); PG8_BAR; PG8_SCHED;
            PG8_LDA(At, 1, 1); PG8_STAGE(PG8_SB(1, 0), b3, voffB); PG8_STAGE(PG8_SB(1, 1), b3 + hstepB, voffB); PG8_STAGE(PG8_SA(1, 0), a3, voffA);
            PG8_WAIT_V(8); PG8_WAIT_L(0); PG8_BAR; PG8_MMA(1, 0, At, B0); PG8_MMA(1, 1, At, B1); PG8_BAR; PG8_SCHED;
            } else {
            PG8_LDB(B0, 0, 0); PG8_SCHED; PG8_LDA(At, 0, 0); PG8_STAGE(PG8_SA(1, 1), a1 + hstepA, voffA);
            PG8_WAIT_L(8); PG8_BAR; PG8_WAIT_L(0); PG8_MMA(0, 0, At, B0); PG8_BAR; PG8_SCHED;
            PG8_LDB(B1, 0, 1); PG8_STAGE(PG8_SB(0, 0), b2, voffB);
            PG8_BAR; PG8_WAIT_L(0); PG8_MMA(0, 1, At, B1); PG8_BAR;
            PG8_LDA(At, 0, 1); PG8_STAGE(PG8_SA(0, 0), a2, voffA);
            PG8_BAR; PG8_WAIT_L(0); PG8_MMA(1, 0, At, B0); PG8_BAR; PG8_SCHED;
            PG8_STAGE(PG8_SB(0, 1), b2 + hstepB, voffB);
            PG8_WAIT_V(6); PG8_BAR; PG8_MMA(1, 1, At, B1); PG8_BAR;
            PG8_LDB(B0, 1, 0); PG8_SCHED; PG8_LDA(At, 1, 0); PG8_STAGE(PG8_SA(0, 1), a2 + hstepA, voffA);
            PG8_WAIT_L(8); PG8_BAR; PG8_WAIT_L(0); PG8_MMA(0, 0, At, B0); PG8_BAR; PG8_SCHED;
            PG8_LDB(B1, 1, 1); PG8_STAGE(PG8_SB(1, 0), b3, voffB);
            PG8_BAR; PG8_WAIT_L(0); PG8_MMA(0, 1, At, B1); PG8_BAR;
            PG8_LDA(At, 1, 1); PG8_STAGE(PG8_SA(1, 0), a3, voffA);
            PG8_BAR; PG8_WAIT_L(0); PG8_MMA(1, 0, At, B0); PG8_BAR; PG8_SCHED;
            PG8_STAGE(PG8_SB(1, 1), b3 + hstepB, voffB);
            PG8_WAIT_V(6); PG8_BAR; PG8_MMA(1, 1, At, B1); PG8_BAR;
            }
        }
        if constexpr (ALIGN_EPI) { if (wr == 0) PG8_BAR; }
        if constexpr (!Epi::AFTER_DRAIN) { E(acc, cur, wr, wc, fr, fq); S.done(cur); }
        if (!has_next) break;
#pragma unroll
        for (int a = 0; a < 2; ++a)
#pragma unroll
            for (int b = 0; b < 2; ++b)
#pragma unroll
                for (int m = 0; m < 4; ++m)
#pragma unroll
                    for (int n = 0; n < 2; ++n) acc[a][b][m][n] = (f32x4){0.f, 0.f, 0.f, 0.f};
        cur = nxt; cA = nA; cB = nB; ++ui;
        if constexpr (ALIGN_EPI) { if (wr == 1) PG8_BAR; }
    }
    PG8_WAIT_V(0);
    if constexpr (!ALIGN_EPI) { if (wr == 0) PG8_BAR; }
    PG8_BAR;
    if constexpr (Epi::AFTER_DRAIN) { E.fused(acc, cur, wr, wc, fr, fq, lds, wid, lane); S.done(cur); }
#undef PG8_SA
#undef PG8_SB
#undef PG8_STAGE
#undef PG8_LDA
#undef PG8_LDB
#undef PG8_MMA
#undef PG8_WAIT_V
#undef PG8_WAIT_L
#undef PG8_BAR
#undef PG8_SCHED
}
}

#define PG8_SP2 true
#define PG8_ALIGN true
#include <hip/hip_bf16.h>
#include <cmath>
namespace attn_body {
using bf16=__hip_bfloat16;
using bf16x8=__attribute__((ext_vector_type(8)))short;
using s16x4=__attribute__((ext_vector_type(4)))short;
using f32x16=__attribute__((ext_vector_type(16)))float;
using u32x4=__attribute__((ext_vector_type(4)))unsigned;
constexpr int BATCH=1,NHEAD=16,SEQ=16384,D=64,DM=NHEAD*D,QP=3072,KP=3072,OP=1024;
constexpr int NW=8,QBLK=32,QB=QBLK*NW,KVBLK=64,NQB=SEQ/QB;
constexpr int ATTN_PITCH=DM, ATTN_UNIT_ROWS=QB;
__device__ __forceinline__ int crow(int r,int hi){return (r&3)+8*(r>>2)+4*hi;}
#define SBAR() __builtin_amdgcn_sched_barrier(0)
__device__ __forceinline__ void cmask(f32x16&p0,f32x16&p1,int jb,int qrel,int hi){
  const float NEG=-INFINITY; int kb=64*jb+4*hi;
  #pragma unroll
  for(int r=0;r<16;++r){int kv=kb+(r&3)+8*(r>>2); if(kv>qrel)p0[r]=NEG; if(kv+32>qrel)p1[r]=NEG;}
}

constexpr int NSLOT=3, SLOTB=8192;
constexpr int LDS_K=0, LDS_V=NSLOT*SLOTB, LDS_WS=2*NSLOT*SLOTB, LDS_OST=LDS_WS+NW*64*4, LDS_BYTES=LDS_OST+NW*4096;
constexpr float C2=0.125f*1.4426950408889634f;
__device__ __forceinline__ void glds16(const void*gsrc,unsigned lds_dst){unsigned keep;
  asm volatile("s_mov_b32 %0, m0\n\ts_mov_b32 m0, %2\n\ts_nop 0\n\tglobal_load_lds_dwordx4 %1, off\n\ts_mov_b32 m0, %0":"=&s"(keep):"v"(gsrc),"s"(lds_dst):"memory");}
__device__ __forceinline__ float max3f(float a,float b,float c){float r;asm("v_max3_f32 %0, %1, %2, %3":"=v"(r):"v"(a),"v"(b),"v"(c));return r;}
__device__ __forceinline__ float max2f(float a,float b){float r;asm("v_max_f32_e32 %0, %1, %2":"=v"(r):"v"(a),"v"(b));return r;}
__device__ __forceinline__ float fadd_s(float a,float b){float r;asm("v_add_f32_e32 %0, %1, %2":"=v"(r):"v"(a),"v"(b));return r;}
__device__ __forceinline__ float fsub_s(float a,float b){float r;asm("v_sub_f32_e32 %0, %1, %2":"=v"(r):"v"(a),"v"(b));return r;}
typedef float f32x2_t __attribute__((ext_vector_type(2))); typedef __bf16 bf16x2_t __attribute__((ext_vector_type(2)));
__device__ __forceinline__ unsigned cvtpk_s(float lo,float hi){f32x2_t v={lo,hi};bf16x2_t b=__builtin_convertvector(v,bf16x2_t);return __builtin_bit_cast(unsigned,b);}
#define WAIT_BAR(N) asm volatile("s_waitcnt vmcnt(" #N ") lgkmcnt(0)\n\ts_barrier":::"memory")

__device__ __forceinline__ void qkt(f32x16&p0,f32x16&p1,const char*Kslot,const bf16x8*qr,const f32x16&negm,int r32,int hi){
  const char*kb=Kslot+hi*1024+r32*16;
  #pragma unroll
  for(int d0=0;d0<4;++d0){
    const bf16x8 b0=*reinterpret_cast<const bf16x8*>(kb+d0*2048);
    const bf16x8 b1=*reinterpret_cast<const bf16x8*>(kb+d0*2048+512);
    if(d0==0){p0=__builtin_amdgcn_mfma_f32_32x32x16_bf16(b0,qr[0],negm,0,0,0);p1=__builtin_amdgcn_mfma_f32_32x32x16_bf16(b1,qr[0],negm,0,0,0);}
    else{p0=__builtin_amdgcn_mfma_f32_32x32x16_bf16(b0,qr[d0],p0,0,0,0);p1=__builtin_amdgcn_mfma_f32_32x32x16_bf16(b1,qr[d0],p1,0,0,0);}}
}
typedef __attribute__((address_space(3))) const char* lds_cptr;
typedef short v4i16_t __attribute__((ext_vector_type(4)));
__device__ __forceinline__ void kload8(bf16x8*kf,lds_cptr kp){
  kf[0]=*(const __attribute__((address_space(3))) bf16x8*)(kp);      kf[1]=*(const __attribute__((address_space(3))) bf16x8*)(kp+512);
  kf[2]=*(const __attribute__((address_space(3))) bf16x8*)(kp+2048); kf[3]=*(const __attribute__((address_space(3))) bf16x8*)(kp+2560);
  kf[4]=*(const __attribute__((address_space(3))) bf16x8*)(kp+4096); kf[5]=*(const __attribute__((address_space(3))) bf16x8*)(kp+4608);
  kf[6]=*(const __attribute__((address_space(3))) bf16x8*)(kp+6144); kf[7]=*(const __attribute__((address_space(3))) bf16x8*)(kp+6656);
}
__device__ __forceinline__ void kload2(bf16x8*kf,lds_cptr kp,int j){ kf[2*j]=*(const __attribute__((address_space(3))) bf16x8*)(kp+j*2048); kf[2*j+1]=*(const __attribute__((address_space(3))) bf16x8*)(kp+j*2048+512); }
__device__ __forceinline__ s16x4 vtr(lds_cptr p){ return __builtin_bit_cast(s16x4,__builtin_amdgcn_ds_read_tr16_b64_v4i16((__attribute__((address_space(3))) v4i16_t*)p)); }
__device__ __forceinline__ float rowmax(const f32x16&p0,const f32x16&p1){
  float a=max3f(p0[0],p0[1],p1[0]),b=max3f(p0[2],p0[3],p1[1]);a=max3f(a,p1[2],p1[3]);
  #pragma unroll
  for(int r=4;r<16;r+=4){a=max3f(a,p0[r],p0[r+1]);b=max3f(b,p0[r+2],p0[r+3]);a=max3f(a,p1[r],p1[r+1]);b=max3f(b,p1[r+2],p1[r+3]);}
  const float m=max2f(a,b);
  auto rr=__builtin_amdgcn_permlane32_swap(__float_as_uint(m),__float_as_uint(m),false,false);
  return max2f(__uint_as_float(rr[0]),__uint_as_float(rr[1]));
}
__device__ __forceinline__ void pv(f32x16*o,int vb,bf16x8 pa0,bf16x8 pa1,bf16x8 pa2,bf16x8 pa3){
  #pragma unroll
  for(int d0=0;d0<2;++d0){s16x4 lo[4],hi[4];
    #pragma unroll
    for(int ks=0;ks<4;++ks){
      asm volatile("ds_read_b64_tr_b16 %0,%1 offset:%c2":"=&v"(lo[ks]):"v"(vb),"i"(d0*4096+ks*1024):"memory");
      asm volatile("ds_read_b64_tr_b16 %0,%1 offset:%c2":"=&v"(hi[ks]):"v"(vb),"i"(d0*4096+ks*1024+512):"memory");}
    asm volatile("s_waitcnt lgkmcnt(0)":::"memory");SBAR();
    #define PK(k) (bf16x8){lo[k][0],lo[k][1],lo[k][2],lo[k][3],hi[k][0],hi[k][1],hi[k][2],hi[k][3]}
    o[d0]=__builtin_amdgcn_mfma_f32_32x32x16_bf16(pa0,PK(0),o[d0],0,0,0);
    o[d0]=__builtin_amdgcn_mfma_f32_32x32x16_bf16(pa1,PK(1),o[d0],0,0,0);
    o[d0]=__builtin_amdgcn_mfma_f32_32x32x16_bf16(pa2,PK(2),o[d0],0,0,0);
    o[d0]=__builtin_amdgcn_mfma_f32_32x32x16_bf16(pa3,PK(3),o[d0],0,0,0);
    #undef PK
  }
}

#ifndef ATTN_STORE16
#define ATTN_STORE16(p,v) (*(u32x4*)(p)=(v))
#endif
template<int THRL> __device__ __forceinline__ void attn_unit(int b,int h,int qb,const bf16*Q,const bf16*__restrict__ K,const bf16*__restrict__ V,bf16*O,char*shm){
  int tid_=threadIdx.x; asm volatile("":"+v"(tid_)); const int tid=tid_,lane=tid&63,r32=lane&31,hi=lane>>5; const int wid=__builtin_amdgcn_readfirstlane(tid>>6);
  const long rowbase=(long)b*SEQ; const int q0=qb*QB;
  const bf16*Qw=Q+(rowbase+q0+wid*QBLK)*QP+h*D;
  const int kvh=h>>2; const bf16*Kh=K+rowbase*KP+kvh*D,*Vh=V+rowbase*KP+kvh*D;
  const unsigned lds0=(unsigned)(uintptr_t)shm;
  float*wsf=(float*)(shm+LDS_WS)+wid*64;
  const bf16*ksrc=Kh+(long)lane*KP+wid*8;
  const bf16*vsrc=Vh+(long)(16*(wid&3)+(lane>>2))*KP+(wid>>2)*32+(lane&3)*8;
  const unsigned kdst=lds0+LDS_K+wid*1024, vdst=lds0+LDS_V+wid*1024;
  #define DMA_K(t,slot) glds16(ksrc+(long)(t)*KVBLK*KP,(unsigned)__builtin_amdgcn_readfirstlane(kdst+(slot)))
  #define DMA_V(t,slot) glds16(vsrc+(long)(t)*KVBLK*KP,(unsigned)__builtin_amdgcn_readfirstlane(vdst+(slot)))
  const int vb0=(int)(lds0+LDS_V)+((lane>>4)&1)*32+(lane&3)*8+(4*hi+((lane&15)>>2))*64;
  const char*Kbase=shm+LDS_K; bf16x8 kf[8];
  const lds_cptr shm3=(lds_cptr)shm; const lds_cptr kp0=shm3+LDS_K+hi*1024+r32*16; const lds_cptr vp0=shm3+LDS_V+((lane>>4)&1)*32+(lane&3)*8+(4*hi+((lane&15)>>2))*64;
  const int NT=SEQ/KVBLK;
  DMA_K(0,0);DMA_V(0,0);DMA_K(1,SLOTB);
  bf16x8 qr[4];
  #pragma unroll
  for(int d0=0;d0<4;++d0)qr[d0]=*reinterpret_cast<const bf16x8*>(&Qw[(long)r32*QP+d0*16+hi*8]);
  float mhat=0.f,l_reg=0.f;f32x16 o[2];o[0]=f32x16{};o[1]=f32x16{};f32x16 negm=f32x16{};asm volatile("":"+v"(negm));
  const int qrel=wid*QBLK+r32;
  #define CMASK(P0,P1,t) do{}while(0)
  bool resc=false;
  #define START(P0,P1) do{ const float rm=rowmax(P0,P1); resc=false; \
    { const float dl=rm; mhat=fadd_s(mhat,dl); \
      _Pragma("unroll") for(int r=0;r<16;++r){P0[r]=fsub_s(P0[r],dl);P1[r]=fsub_s(P1[r],dl);} \
      _Pragma("unroll") for(int r=0;r<16;++r)negm[r]=-mhat; asm volatile("":"+v"(negm)); } \
    _Pragma("unroll") for(int r=0;r<16;++r)P0[r]=__builtin_amdgcn_exp2f(P0[r]); }while(0)
  #define RESC() do{ if(resc){ asm volatile("s_waitcnt lgkmcnt(0)":::"memory"); \
      _Pragma("unroll") for(int d_=0;d_<2;++d_) _Pragma("unroll") for(int r=0;r<16;++r)o[d_][r]*=wsf[crow(r,hi)]; } }while(0)
  f32x16 pA0,pA1,pB0,pB1;
  int sl_prev=0,sl_cur=0,sl_next=SLOTB;
  #define ROT() do{sl_prev=sl_cur;sl_cur=sl_next;sl_next=(sl_next==(NSLOT-1)*SLOTB)?0:sl_next+SLOTB;}while(0)
  DMA_K(2,2*SLOTB);
  WAIT_BAR(3);
  qkt(pA0,pA1,Kbase,qr,negm,r32,hi);asm volatile("s_nop 15\n\ts_nop 7":"+v"(pA0),"+v"(pA1));CMASK(pA0,pA1,0);
  START(pA0,pA1);
  _Pragma("unroll") for(int r=0;r<16;++r)pA1[r]=__builtin_amdgcn_exp2f(pA1[r]);
  WAIT_BAR(0);
  DMA_K(3,0);DMA_V(1,SLOTB);
  ROT();
  kload8(kf,kp0+sl_cur);
  WAIT_BAR(2);
  s16x4 vlo[8],vhi[8]; u32x4 pw0,pw1,pw2,pw3;
  #define PKW(P,B) cvtpk_s(P[B],P[B+1])
  #define PAF(k) __builtin_bit_cast(bf16x8,pw##k)
  #define VFR(i) (bf16x8){vlo[i][0],vlo[i][1],vlo[i][2],vlo[i][3],vhi[i][0],vhi[i][1],vhi[i][2],vhi[i][3]}
  #define PIN(x) asm volatile("":"+v"(x))
  #define MX3(a,b,c) __builtin_fmaxf(__builtin_fmaxf((a),(b)),(c))
  #define GAPA(MF,A0,A1,A2,A3,W0,W1,PW) do{ MF; sacc+=A0; sacc+=A1; sacc+=A2; sacc+=A3; PIN(sacc); W0; W1; PIN(PW); SBAR(); }while(0)
  #define EX(v) __builtin_amdgcn_exp2f(v)
  #define GAPB(MF,X,B) do{ MF; X[B]=EX(X[B]); X[B+1]=EX(X[B+1]); X[B+2]=EX(X[B+2]); X[B+3]=EX(X[B+3]); PIN(X); SBAR(); }while(0)
  #define VRD(i) do{ vlo[i]=vtr(vp_+(((i)>>2)*4096+((i)&3)*1024)); vhi[i]=vtr(vp_+(((i)>>2)*4096+((i)&3)*1024+512)); }while(0)
  #define KRD(G,j) do{ if(G){ kload2(kf,kp0+sl_next,j); SBAR(); } }while(0)
  #define STEP(C0,C1,P0,P1,t,GK,GV,GL) do{ SBAR(); \
    const lds_cptr vp_=vp0+sl_prev; \
    VRD(0); SBAR(); float sacc=(P0[0]+P0[1]); \
    GAPA(C0=__builtin_amdgcn_mfma_f32_32x32x16_bf16(kf[0],qr[0],negm,0,0,0), P0[2],P0[3],P0[4],P0[5],     pw0[0]=PKW(P0,0), pw0[1]=PKW(P0,2), pw0); \
    VRD(4); SBAR(); GAPA(C1=__builtin_amdgcn_mfma_f32_32x32x16_bf16(kf[1],qr[0],negm,0,0,0), P0[6],P0[7],P0[8],P0[9],     pw0[2]=PKW(P0,4), pw0[3]=PKW(P0,6), pw0); \
    VRD(1); SBAR(); GAPA(C0=__builtin_amdgcn_mfma_f32_32x32x16_bf16(kf[2],qr[1],C0,0,0,0),   P0[10],P0[11],P0[12],P0[13], pw1[0]=PKW(P0,8), pw1[1]=PKW(P0,10), pw1); \
    VRD(5); SBAR(); GAPA(C1=__builtin_amdgcn_mfma_f32_32x32x16_bf16(kf[3],qr[1],C1,0,0,0),   P0[14],P0[15],P1[0],P1[1],   pw1[2]=PKW(P0,12),pw1[3]=PKW(P0,14), pw1); \
    VRD(2); SBAR(); GAPA(C0=__builtin_amdgcn_mfma_f32_32x32x16_bf16(kf[4],qr[2],C0,0,0,0),   P1[2],P1[3],P1[4],P1[5],     pw2[0]=PKW(P1,0), pw2[1]=PKW(P1,2), pw2); \
    VRD(6); SBAR(); GAPA(C1=__builtin_amdgcn_mfma_f32_32x32x16_bf16(kf[5],qr[2],C1,0,0,0),   P1[6],P1[7],P1[8],P1[9],     pw2[2]=PKW(P1,4), pw2[3]=PKW(P1,6), pw2); \
    VRD(3); SBAR(); GAPA(C0=__builtin_amdgcn_mfma_f32_32x32x16_bf16(kf[6],qr[3],C0,0,0,0),   P1[10],P1[11],P1[12],P1[13], pw3[0]=PKW(P1,8), pw3[1]=PKW(P1,10), pw3); \
    VRD(7); SBAR(); GAPA(C1=__builtin_amdgcn_mfma_f32_32x32x16_bf16(kf[7],qr[3],C1,0,0,0),   P1[14],P1[15],0.f,0.f,       pw3[2]=PKW(P1,12),pw3[3]=PKW(P1,14), pw3); \
    l_reg+=sacc; \
    if(GK){DMA_K((t)+3,sl_cur);} if(GV){DMA_V((t)+1,sl_next);} \
    CMASK(C0,C1,t); \
    { float a=MX3(C0[0],C0[1],C1[0]),b=MX3(C0[2],C0[3],C1[1]); a=MX3(a,C1[2],C1[3]); \
      _Pragma("unroll") for(int r=4;r<16;r+=4){a=MX3(a,C0[r],C0[r+1]);b=MX3(b,C0[r+2],C0[r+3]);a=MX3(a,C1[r],C1[r+1]);b=MX3(b,C1[r+2],C1[r+3]);} \
      float rm=__builtin_fmaxf(a,b); { auto rr=__builtin_amdgcn_permlane32_swap(__float_as_uint(rm),__float_as_uint(rm),false,false); rm=__builtin_fmaxf(__uint_as_float(rr[0]),__uint_as_float(rr[1])); } \
      resc=false; \
      if(__builtin_expect(__any(rm>(float)THRL),0)){ const float dl=__builtin_fmaxf(rm,0.f); mhat+=dl; \
        _Pragma("unroll") for(int r=0;r<16;++r){C0[r]-=dl;C1[r]-=dl;} \
        _Pragma("unroll") for(int r=0;r<16;++r)negm[r]=-mhat; asm volatile("":"+v"(negm)); \
        const float f=__builtin_amdgcn_exp2f(-dl); l_reg*=f; if(hi==0)wsf[r32]=f; resc=true; } } \
    SBAR(); \
    GAPB(o[0]=__builtin_amdgcn_mfma_f32_32x32x16_bf16(PAF(0),VFR(0),o[0],0,0,0), C0,0); \
    GAPB(o[1]=__builtin_amdgcn_mfma_f32_32x32x16_bf16(PAF(0),VFR(4),o[1],0,0,0), C0,4); \
    KRD(GL,0); GAPB(o[0]=__builtin_amdgcn_mfma_f32_32x32x16_bf16(PAF(1),VFR(1),o[0],0,0,0), C0,8); \
    KRD(GL,1); GAPB(o[1]=__builtin_amdgcn_mfma_f32_32x32x16_bf16(PAF(1),VFR(5),o[1],0,0,0), C0,12); \
    KRD(GL,2); GAPB(o[0]=__builtin_amdgcn_mfma_f32_32x32x16_bf16(PAF(2),VFR(2),o[0],0,0,0), C1,0); \
    KRD(GL,3); GAPB(o[1]=__builtin_amdgcn_mfma_f32_32x32x16_bf16(PAF(2),VFR(6),o[1],0,0,0), C1,4); \
    GAPB(o[0]=__builtin_amdgcn_mfma_f32_32x32x16_bf16(PAF(3),VFR(3),o[0],0,0,0), C1,8); \
    GAPB(o[1]=__builtin_amdgcn_mfma_f32_32x32x16_bf16(PAF(3),VFR(7),o[1],0,0,0), C1,12); \
    }while(0)
  int t=1;
  #undef CMASK
  #define CMASK(P0,P1,t) do{}while(0)
  for(;t+5<NT;t+=2){
    STEP(pB0,pB1,pA0,pA1,t,true,true,true);     WAIT_BAR(2); RESC(); ROT();
    STEP(pA0,pA1,pB0,pB1,t+1,true,true,true);   WAIT_BAR(2); RESC(); ROT();
  }
  #undef CMASK
  #define CMASK(P0,P1,t) do{}while(0)
  #define ENDW(tt) do{ if((tt)+3<NT){WAIT_BAR(2);} else if((tt)+2<NT){WAIT_BAR(1);} else {WAIT_BAR(0);} }while(0)
  for(;t+1<NT;t+=2){
    STEP(pB0,pB1,pA0,pA1,t,(t+3<NT),(t+1<NT),(t+1<NT));       ENDW(t);   RESC(); ROT();
    STEP(pA0,pA1,pB0,pB1,t+1,(t+4<NT),(t+2<NT),(t+2<NT));     ENDW(t+1); RESC(); ROT();
  }
  STEP(pB0,pB1,pA0,pA1,NT-1,false,false,false); RESC();
  { float sacc=pB0[0]+pB0[1]; _Pragma("unroll") for(int r=2;r<16;++r)sacc+=pB0[r]; _Pragma("unroll") for(int r=0;r<16;++r)sacc+=pB1[r]; l_reg+=sacc;
    pw0=(u32x4){PKW(pB0,0),PKW(pB0,2),PKW(pB0,4),PKW(pB0,6)};pw1=(u32x4){PKW(pB0,8),PKW(pB0,10),PKW(pB0,12),PKW(pB0,14)};pw2=(u32x4){PKW(pB1,0),PKW(pB1,2),PKW(pB1,4),PKW(pB1,6)};pw3=(u32x4){PKW(pB1,8),PKW(pB1,10),PKW(pB1,12),PKW(pB1,14)};
    SBAR(); pv(o,vb0+sl_cur,PAF(0),PAF(1),PAF(2),PAF(3)); }
  #undef PKW
  #undef PAF
  #undef VFR
  #undef PIN
  #undef MX3
  #undef GAPA
  #undef GAPB
  #undef EX
  #undef VRD
  #undef KRD
  #undef STEP
  #undef ENDW
  {auto rr=__builtin_amdgcn_permlane32_swap(__float_as_uint(l_reg),__float_as_uint(l_reg),false,false);l_reg=__uint_as_float(rr[0])+__uint_as_float(rr[1]);}
  if(hi==0)wsf[32+r32]=l_reg;asm volatile("s_waitcnt lgkmcnt(0)":::"memory");
  float rli[16];
  #pragma unroll
  for(int r=0;r<16;++r)rli[r]=__builtin_amdgcn_rcpf(wsf[32+crow(r,hi)]);
  bf16*Ow=O+(rowbase+q0+wid*QBLK)*OP+h*D;
  { bf16*stg=(bf16*)(shm+LDS_OST)+wid*2048;
    #pragma unroll
    for(int r=0;r<16;++r){const int orow=crow(r,hi);
      #pragma unroll
      for(int d0=0;d0<2;++d0)stg[orow*64+d0*32+r32]=__float2bfloat16(o[d0][r]*rli[r]);}
    asm volatile("s_waitcnt lgkmcnt(0)":::"memory");
    #pragma unroll
    for(int i=0;i<4;++i){const int row=i*8+(lane>>3),ch=lane&7; const u32x4 v=*(const u32x4*)(stg+row*64+ch*8); ATTN_STORE16(Ow+(long)row*OP+ch*8,v);} }
  asm volatile("s_waitcnt lgkmcnt(0)\n\ts_barrier":::"memory");
  #undef DMA_K
  #undef DMA_V
  #undef CMASK
  #undef START
  #undef RESC
  #undef ROT
}
constexpr int ATTN_LDS_BYTES=LDS_BYTES;
struct AttnTensors { const bf16* Q; const bf16* K; const bf16* V; bf16* O; };
struct AttnUnit { int bh; int qb; };
struct StaticOrder {
  int vcu;
  __device__ __forceinline__ explicit StaticOrder(int grid,int block):vcu((block%8)*(grid/8)+block/8){}
  __device__ __forceinline__ bool next(int i,AttnUnit&u)const{ if(i>=4)return false; u.bh=vcu>>4; u.qb=(vcu&15)*4+i; return true; }
  __device__ __forceinline__ void a_ready(const AttnUnit&)const{}
  __device__ __forceinline__ void done(const AttnUnit&)const{}
};
template<class Sched,int THRL=8> __device__ __forceinline__ void attn_phase(char*lds,const AttnTensors&T,const Sched&S){
  AttnUnit u;
  for(int i=0;S.next(i,u);++i){ S.a_ready(u); attn_unit<THRL>(u.bh/NHEAD,u.bh%NHEAD,u.qb,T.Q,T.K,T.V,T.O,lds); S.done(u); }
}
#undef SBAR
#undef WAIT_BAR
}

struct Params {
    const float *x, *mem, *ln_in_g, *ln_in_b, *w_mem_kv, *w_in_a, *w_in_b, *q_norm_g, *k_norm_g, *w_in_c, *w_out, *ln_g, *ln_b;
    float* out; unsigned char* ws;
    int s0, s1;
};

DEV float bf2f(bf16_t b) { return __uint_as_float(((unsigned)b) << 16); }
DEV bf16_t f2bf(float f) { unsigned u = __float_as_uint(f); return (bf16_t)((u + 0x7fffu + ((u >> 16) & 1u)) >> 16); }
DEV unsigned pk2(float lo, float hi) { return (unsigned)f2bf(lo) | ((unsigned)f2bf(hi) << 16); }
DEV float wave_sum(float v) {
#pragma unroll
    for (int o = 1; o < 64; o <<= 1) v += __shfl_xor(v, o);
    return v;
}
DEV float silu(float x) { return x / (1.f + __expf(-x)); }
DEV void load8(const bf16_t* p, float* o) {
    u32x4 v = *(const u32x4*)p;
    o[0] = __uint_as_float(v.x << 16); o[1] = __uint_as_float(v.x & 0xffff0000u);
    o[2] = __uint_as_float(v.y << 16); o[3] = __uint_as_float(v.y & 0xffff0000u);
    o[4] = __uint_as_float(v.z << 16); o[5] = __uint_as_float(v.z & 0xffff0000u);
    o[6] = __uint_as_float(v.w << 16); o[7] = __uint_as_float(v.w & 0xffff0000u);
}
DEV void store8(bf16_t* p, const float* o) {
    u32x4 v; v.x = pk2(o[0], o[1]); v.y = pk2(o[2], o[3]); v.z = pk2(o[4], o[5]); v.w = pk2(o[6], o[7]);
    *(u32x4*)p = v;
}
DEV int ltid() { int t = threadIdx.x; asm volatile("" : "+v"(t)); return t; }
#define GTID ((size_t)blockIdx.x * blockDim.x + ltid())
#define GSZ ((size_t)gridDim.x * blockDim.x)

DEV void tconv(const float* src, int K, int Ntot, int ncols, bf16_t* dst, int mode) {
    const size_t total = (size_t)ncols * (K / 8);
    for (size_t idx = GTID; idx < total; idx += GSZ) {
        const int n = (int)(idx % ncols), kc = (int)(idx / ncols);
        int sc = n;
        if (mode == 1 && n < 9216) { const int g = n / 3072, rem = n % 3072, which = rem / 1024, r = rem % 1024; sc = which * 3072 + g * 1024 + r; }
        float v[8];
#pragma unroll
        for (int j = 0; j < 8; ++j) v[j] = src[(size_t)(kc * 8 + j) * Ntot + sc];
        store8(dst + (size_t)n * K + kc * 8, v);
    }
}
DEV void make_wdft(bf16_t* w) {
    for (size_t idx = GTID; idx < 512 * 256; idx += GSZ) {
        const int n = (int)(idx >> 8), c = (int)(idx & 255), which = n >> 8, l = n & 255;
        float s, co; sincospif((float)((l * c) & 255) / 128.f, &s, &co);
        w[idx] = f2bf(which == 0 ? co : -s);
    }
}
DEV void make_mkv(const float* mem, const float* w, float* mkv) {
    for (size_t idx = GTID; idx < 256 * 512; idx += GSZ) {
        const int m = (int)(idx >> 9), n = (int)(idx & 511);
        float a = 0.f;
        for (int k = 0; k < 1024; ++k) a += mem[m * 1024 + k] * w[(size_t)k * 512 + n];
        mkv[idx] = a;
    }
}
DEV void make_rope1d(float* tab) {
    for (size_t idx = GTID; idx < (size_t)S_ * 32; idx += GSZ) {
        const int t = (int)(idx >> 5), i = (int)(idx & 31);
        const float inv = powf(10000.f, -((float)(2 * i) / 64.f));
        const float a = (float)t * inv;
        tab[idx * 2] = cosf(a); tab[idx * 2 + 1] = sinf(a);
    }
}
DEV void ln_rows(const float* a, const float* y, float alpha, const float* g, const float* b, float* outH, bf16_t* outXN) {
    const int lane = ltid() & 63, wpb = blockDim.x >> 6;
    const int gw = blockIdx.x * wpb + (ltid() >> 6), nw = gridDim.x * wpb;
    for (int row = gw; row < S_; row += nw) {
        f32x4 v[4]; float s = 0.f;
#pragma unroll
        for (int j = 0; j < 4; ++j) {
            v[j] = *(const f32x4*)(a + (size_t)row * DM + j * 256 + lane * 4);
            if (y) { const f32x4 u = *(const f32x4*)(y + (size_t)row * DM + j * 256 + lane * 4); v[j] = v[j] * alpha + u; }
            s += (v[j].x + v[j].y) + (v[j].z + v[j].w);
        }
        const float mean = wave_sum(s) * (1.f / DM); float s2 = 0.f;
#pragma unroll
        for (int j = 0; j < 4; ++j) { v[j] = v[j] - mean; s2 += (v[j].x * v[j].x + v[j].y * v[j].y) + (v[j].z * v[j].z + v[j].w * v[j].w); }
        const float rstd = 1.f / sqrtf(wave_sum(s2) * (1.f / DM) + LN_EPS);
#pragma unroll
        for (int j = 0; j < 4; ++j) {
            const f32x4 gg = *(const f32x4*)(g + j * 256 + lane * 4), bb = *(const f32x4*)(b + j * 256 + lane * 4);
            const f32x4 o = v[j] * rstd * gg + bb;
            *(f32x4*)(outH + (size_t)row * DM + j * 256 + lane * 4) = o;
            u32x2 w; w.x = pk2(o.x, o.y); w.y = pk2(o.z, o.w);
            *(u32x2*)(outXN + (size_t)row * DM + j * 256 + lane * 4) = w;
        }
    }
}
DEV void gemm_simple(const bf16_t* A, int lda, const bf16_t* Bt, int ldb, int M, int N, int K, void* C, int ldc, int f32out) {
    const int lane = ltid() & 63, wpb = blockDim.x >> 6;
    const int gw = blockIdx.x * wpb + (ltid() >> 6), nw = gridDim.x * wpb;
    const int tn = N / 64, tiles = (M / 64) * tn, fr = lane & 15, fq = lane >> 4;
    for (int t = gw; t < tiles; t += nw) {
        const int tm = t / tn, tc = t % tn;
        f32x4 acc[4][4];
#pragma unroll
        for (int i = 0; i < 4; ++i)
#pragma unroll
            for (int j = 0; j < 4; ++j) acc[i][j] = (f32x4){0.f, 0.f, 0.f, 0.f};
        const bf16_t* ap = A + (size_t)(tm * 64 + fr) * lda + fq * 8;
        const bf16_t* bp = Bt + (size_t)(tc * 64 + fr) * ldb + fq * 8;
        for (int k0 = 0; k0 < K; k0 += 32) {
            bf16x8 a[4], b[4];
#pragma unroll
            for (int i = 0; i < 4; ++i) { a[i] = *(const bf16x8*)(ap + (size_t)i * 16 * lda + k0); b[i] = *(const bf16x8*)(bp + (size_t)i * 16 * ldb + k0); }
#pragma unroll
            for (int i = 0; i < 4; ++i)
#pragma unroll
                for (int j = 0; j < 4; ++j) acc[i][j] = __builtin_amdgcn_mfma_f32_16x16x32_bf16(a[i], b[j], acc[i][j], 0, 0, 0);
        }
#pragma unroll
        for (int i = 0; i < 4; ++i)
#pragma unroll
            for (int j = 0; j < 4; ++j)
#pragma unroll
                for (int r = 0; r < 4; ++r) {
                    const size_t off = (size_t)(tm * 64 + i * 16 + fq * 4 + r) * ldc + tc * 64 + j * 16 + fr;
                    if (f32out) ((float*)C)[off] = acc[i][j][r]; else ((bf16_t*)C)[off] = f2bf(acc[i][j][r]);
                }
    }
}
DEV int zc(int j) { return ((j >> 8) << 9) + (j & 255); }
DEV void fft_tab(float* tab) {
    __syncthreads();
    for (int i = ltid(); i < 128; i += blockDim.x) { float s, c; sincospif((float)i / 64.f, &s, &c); tab[i] = c; tab[128 + i] = s; }
    __syncthreads();
}
DEV void fft_s1(const bf16_t* Z, bf16_t* T, float* tab) {
    fft_tab(tab);
    const size_t total = (size_t)S_ * 1024;
    for (size_t idx = GTID; idx < total; idx += GSZ) {
        const int j = (int)(idx & 1023), r = (int)(idx >> 10), k1 = r >> 7, s2 = r & 127, cj = zc(j);
        float ar = 0.f, ai = 0.f;
        for (int s1 = 0; s1 < 128; ++s1) {
            const int n = (s1 * k1) & 127; const float c = tab[n], s = tab[128 + n];
            const bf16_t* zp = Z + (size_t)(128 * s1 + s2) * 2048 + cj;
            const float zr = bf2f(zp[0]), zi = bf2f(zp[256]);
            ar += zr * c + zi * s; ai += zi * c - zr * s;
        }
        float ts, tc; sincospif((float)(s2 * k1) / 8192.f, &ts, &tc);
        const float tr = ar * tc + ai * ts, ti = ai * tc - ar * ts;
        T[(size_t)r * 2048 + cj] = f2bf(tr); T[(size_t)r * 2048 + cj + 256] = f2bf(ti);
    }
}
DEV void fft_s2(const bf16_t* T, bf16_t* BR, float* tab) {
    fft_tab(tab);
    const size_t total = (size_t)S_ * 1024;
    for (size_t idx = GTID; idx < total; idx += GSZ) {
        const int j = (int)(idx & 1023), k = (int)(idx >> 10), k1 = k & 127, k2 = k >> 7, cj = zc(j);
        float acc = 0.f;
        for (int s2 = 0; s2 < 128; ++s2) {
            const int n = (s2 * k2) & 127; const float c = tab[n], s = tab[128 + n];
            const bf16_t* tp = T + (size_t)(k1 * 128 + s2) * 2048 + cj;
            acc += bf2f(tp[0]) * c + bf2f(tp[256]) * s;
        }
        BR[(size_t)k * 1024 + j] = f2bf(acc * (1.f / 2048.f));
    }
}

typedef float f32x16 __attribute__((ext_vector_type(16)));
constexpr int FT_LD = 136;
DEV void fft_tables(bf16_t* Ct, bf16_t* St) {
    __syncthreads();
    for (int e = ltid(); e < 128 * 128; e += blockDim.x) { const int r = e >> 7, c = e & 127; float s, co; sincospif((float)((r * c) & 127) / 64.f, &s, &co); Ct[r * FT_LD + c] = f2bf(co); St[r * FT_LD + c] = f2bf(s); }
    __syncthreads();
}
DEV int crow16(int r, int hi) { return (r & 3) + 8 * (r >> 2) + 4 * hi; }
DEV void fft_s1_mfma(const bf16_t* Z, bf16_t* T, unsigned char* lds_raw) {
    bf16_t* Ct = (bf16_t*)lds_raw; bf16_t* St = Ct + 128 * FT_LD;
    fft_tables(Ct, St);
    const int tid = ltid(), lane = tid & 63, r32 = lane & 31, hi = lane >> 5, wpb = blockDim.x >> 6;
    const int gw = blockIdx.x * wpb + (tid >> 6), nw = gridDim.x * wpb;
    for (int task = gw; task < 128 * 32; task += nw) {
        const int s2 = task >> 5, jt = task & 31, j = jt * 32 + r32, cj = zc(j);
        const bf16_t* zp = Z + (size_t)s2 * 2048 + cj;
        bf16x8 zr[8], zi[8];
#pragma unroll
        for (int s = 0; s < 8; ++s)
#pragma unroll
            for (int e = 0; e < 8; ++e) { const size_t off = (size_t)(16 * s + 8 * hi + e) * (128 * 2048); zr[s][e] = (short)zp[off]; zi[s][e] = (short)zp[off + 256]; }
        f32x16 ore[4], oim[4];
#pragma unroll
        for (int mt = 0; mt < 4; ++mt)
#pragma unroll
            for (int r = 0; r < 16; ++r) { ore[mt][r] = 0.f; oim[mt][r] = 0.f; }
#pragma unroll
        for (int s = 0; s < 8; ++s) {
            bf16x8 nzr;
#pragma unroll
            for (int e = 0; e < 8; ++e) nzr[e] = (short)(zr[s][e] ^ (short)0x8000);
#pragma unroll
            for (int mt = 0; mt < 4; ++mt) {
                const bf16x8 c = *(const bf16x8*)(Ct + (mt * 32 + r32) * FT_LD + 16 * s + 8 * hi);
                const bf16x8 sn = *(const bf16x8*)(St + (mt * 32 + r32) * FT_LD + 16 * s + 8 * hi);
                ore[mt] = __builtin_amdgcn_mfma_f32_32x32x16_bf16(c, zr[s], ore[mt], 0, 0, 0);
                ore[mt] = __builtin_amdgcn_mfma_f32_32x32x16_bf16(sn, zi[s], ore[mt], 0, 0, 0);
                oim[mt] = __builtin_amdgcn_mfma_f32_32x32x16_bf16(c, zi[s], oim[mt], 0, 0, 0);
                oim[mt] = __builtin_amdgcn_mfma_f32_32x32x16_bf16(sn, nzr, oim[mt], 0, 0, 0);
            }
        }
#pragma unroll
        for (int mt = 0; mt < 4; ++mt)
#pragma unroll
            for (int r = 0; r < 16; ++r) {
                const int k1 = mt * 32 + crow16(r, hi);
                const float xr = (float)(s2 * k1) * (1.f / 16384.f);
                const float tc = __builtin_amdgcn_cosf(xr), ts = __builtin_amdgcn_sinf(xr);
                const float ar = ore[mt][r], ai = oim[mt][r];
                bf16_t* tp = T + (size_t)(k1 * 128 + s2) * 2048 + cj;
                tp[0] = f2bf(ar * tc + ai * ts); tp[256] = f2bf(ai * tc - ar * ts);
            }
    }
    __syncthreads();
}
DEV void fft_s2_mfma(const bf16_t* T, bf16_t* BR, unsigned char* lds_raw) {
    bf16_t* Ct = (bf16_t*)lds_raw; bf16_t* St = Ct + 128 * FT_LD;
    fft_tables(Ct, St);
    const int tid = ltid(), lane = tid & 63, r32 = lane & 31, hi = lane >> 5, wpb = blockDim.x >> 6;
    const int gw = blockIdx.x * wpb + (tid >> 6), nw = gridDim.x * wpb;
    for (int task = gw; task < 128 * 32; task += nw) {
        const int k1 = task >> 5, jt = task & 31, j = jt * 32 + r32, cj = zc(j);
        const bf16_t* tp = T + (size_t)(k1 * 128) * 2048 + cj;
        bf16x8 tr[8], ti[8];
#pragma unroll
        for (int s = 0; s < 8; ++s)
#pragma unroll
            for (int e = 0; e < 8; ++e) { const size_t off = (size_t)(16 * s + 8 * hi + e) * 2048; tr[s][e] = (short)tp[off]; ti[s][e] = (short)tp[off + 256]; }
        f32x16 o[4];
#pragma unroll
        for (int mt = 0; mt < 4; ++mt)
#pragma unroll
            for (int r = 0; r < 16; ++r) o[mt][r] = 0.f;
#pragma unroll
        for (int s = 0; s < 8; ++s)
#pragma unroll
            for (int mt = 0; mt < 4; ++mt) {
                const bf16x8 c = *(const bf16x8*)(Ct + (mt * 32 + r32) * FT_LD + 16 * s + 8 * hi);
                const bf16x8 sn = *(const bf16x8*)(St + (mt * 32 + r32) * FT_LD + 16 * s + 8 * hi);
                o[mt] = __builtin_amdgcn_mfma_f32_32x32x16_bf16(c, tr[s], o[mt], 0, 0, 0);
                o[mt] = __builtin_amdgcn_mfma_f32_32x32x16_bf16(sn, ti[s], o[mt], 0, 0, 0);
            }
#pragma unroll
        for (int mt = 0; mt < 4; ++mt)
#pragma unroll
            for (int r = 0; r < 16; ++r) {
                const int k = k1 + 128 * (mt * 32 + crow16(r, hi));
                BR[(size_t)k * 1024 + j] = f2bf(o[mt][r] * (1.f / 2048.f));
            }
    }
    __syncthreads();
}
DEV void qk_post(bf16_t* PROJ, const float* qg, const float* kg) {
    const size_t total = (size_t)S_ * 20 * 16;
    for (size_t idx = GTID; idx < total; idx += GSZ) {
        const int i = (int)(idx & 15), head = (int)((idx >> 4) % 20), t = (int)((idx >> 4) / 20);
        bf16_t* p = PROJ + (size_t)t * 3072 + head * 64;
        float a1 = bf2f(p[i]), a2 = bf2f(p[16 + i]), b1 = bf2f(p[32 + i]), b2 = bf2f(p[48 + i]);
        float ss = a1 * a1 + a2 * a2 + b1 * b1 + b2 * b2;
        ss += __shfl_xor(ss, 1); ss += __shfl_xor(ss, 2); ss += __shfl_xor(ss, 4); ss += __shfl_xor(ss, 8);
        const float r = 1.f / sqrtf(ss * (1.f / 64.f) + 1e-6f);
        const float* g = head < 16 ? qg : kg;
        a1 *= r * g[i]; a2 *= r * g[16 + i]; b1 *= r * g[32 + i]; b2 *= r * g[48 + i];
        const float frow = (float)(t >> 6), fcol = (float)(t & 63);
        const float sc = head < 16 ? C2 : 1.f;
        const float inv = powf(10000.f, -((float)(2 * i) / 32.f));
        const float ar = frow * inv, ac = fcol * inv;
        const float cr = cosf(ar), sr = sinf(ar), cc = cosf(ac), scn = sinf(ac);
        p[i] = f2bf((a1 * cr - a2 * sr) * sc); p[16 + i] = f2bf((a2 * cr + a1 * sr) * sc);
        p[32 + i] = f2bf((b1 * cc - b2 * scn) * sc); p[48 + i] = f2bf((b2 * cc + b1 * scn) * sc);
    }
}
DEV void attn_naive(const bf16_t* PROJ, bf16_t* BR, float* lds) {
    const int nth = blockDim.x, qblocks = S_ / nth, items = 16 * qblocks;
    float* Ks = lds; float* Vs = lds + 64 * 64;
    for (int it = blockIdx.x; it < items; it += gridDim.x) {
        const int hq = it / qblocks, qb = it % qblocks, kvh = hq >> 2, t = qb * nth + ltid();
        float q[64], o[64]; float m = -1e30f, l = 0.f;
#pragma unroll
        for (int c = 0; c < 8; ++c) load8(PROJ + (size_t)t * 3072 + hq * 64 + c * 8, q + c * 8);
#pragma unroll
        for (int d = 0; d < 64; ++d) o[d] = 0.f;
        for (int k0 = 0; k0 < S_; k0 += 64) {
            __syncthreads();
            for (int e = ltid(); e < 64 * 8; e += nth) {
                const int r = e >> 3, c8 = e & 7; float tmp[8];
                load8(PROJ + (size_t)(k0 + r) * 3072 + 1024 + kvh * 64 + c8 * 8, tmp);
#pragma unroll
                for (int j = 0; j < 8; ++j) Ks[r * 64 + c8 * 8 + j] = tmp[j];
                load8(PROJ + (size_t)(k0 + r) * 3072 + 1280 + kvh * 64 + c8 * 8, tmp);
#pragma unroll
                for (int j = 0; j < 8; ++j) Vs[r * 64 + c8 * 8 + j] = tmp[j];
            }
            __syncthreads();
            for (int r = 0; r < 64; ++r) {
                float s = 0.f;
#pragma unroll
                for (int d = 0; d < 64; d += 4) { const f32x4 kk = *(const f32x4*)(Ks + r * 64 + d); s += q[d] * kk.x + q[d + 1] * kk.y + q[d + 2] * kk.z + q[d + 3] * kk.w; }
                if (s > m) { const float f = exp2f(m - s); l *= f;
#pragma unroll
                    for (int d = 0; d < 64; ++d) o[d] *= f;
                    m = s; }
                const float p = exp2f(s - m); l += p;
#pragma unroll
                for (int d = 0; d < 64; d += 4) { const f32x4 vv = *(const f32x4*)(Vs + r * 64 + d); o[d] += p * vv.x; o[d + 1] += p * vv.y; o[d + 2] += p * vv.z; o[d + 3] += p * vv.w; }
            }
        }
        const float rl = 1.f / l;
#pragma unroll
        for (int d = 0; d < 64; ++d) o[d] *= rl;
#pragma unroll
        for (int c = 0; c < 8; ++c) store8(BR + (size_t)t * 1024 + hq * 64 + c * 8, o + c * 8);
    }
    __syncthreads();
}
DEV void rope_c(bf16_t* QKV, const float* tab) {
    const size_t total = (size_t)S_ * 32;
    for (size_t idx = GTID; idx < total; idx += GSZ) {
        const int hh = (int)(idx & 31), t = (int)(idx >> 5);
        bf16_t* p = QKV + (size_t)t * 3072 + hh * 64;
        float x[64];
#pragma unroll
        for (int c = 0; c < 8; ++c) load8(p + c * 8, x + c * 8);
        const float sc = hh < 16 ? C2 : 1.f;
        const float* tb = tab + (size_t)t * 64;
#pragma unroll
        for (int i = 0; i < 32; ++i) {
            const float c = tb[2 * i], s = tb[2 * i + 1];
            const float a1 = x[i], a2 = x[32 + i];
            x[i] = (a1 * c - a2 * s) * sc; x[32 + i] = (a2 * c + a1 * s) * sc;
        }
#pragma unroll
        for (int c = 0; c < 8; ++c) store8(p + c * 8, x + c * 8);
    }
}
DEV void dil_naive(const bf16_t* QKV, float* OACC, float* ML, int g) {
    const int dil = g == 0 ? 1 : (g == 1 ? 4 : 16);
    const size_t total = (size_t)16 * S_;
    for (size_t idx = GTID; idx < total; idx += GSZ) {
        const int head = (int)(idx >> 14), t = (int)(idx & 16383);
        float q[64], o[64]; float m, l;
#pragma unroll
        for (int c = 0; c < 8; ++c) load8(QKV + (size_t)t * 3072 + head * 64 + c * 8, q + c * 8);
        if (g == 0) { m = -1e30f; l = 0.f;
#pragma unroll
            for (int d = 0; d < 64; ++d) o[d] = 0.f;
        } else {
            m = ML[((size_t)t * 16 + head) * 2]; l = ML[((size_t)t * 16 + head) * 2 + 1];
#pragma unroll
            for (int d = 0; d < 64; d += 4) { const f32x4 v = *(const f32x4*)(OACC + (size_t)t * 1024 + head * 64 + d); o[d] = v.x; o[d + 1] = v.y; o[d + 2] = v.z; o[d + 3] = v.w; }
        }
        for (int mm = -64; mm <= 64; ++mm) {
            const int tk = t + mm * dil;
            if (tk < 0 || tk >= S_) continue;
            const bf16_t* kp = QKV + (size_t)tk * 3072 + 1024 + head * 64;
            float s = 0.f;
#pragma unroll
            for (int c = 0; c < 8; ++c) { float kk[8]; load8(kp + c * 8, kk);
#pragma unroll
                for (int j = 0; j < 8; ++j) s += q[c * 8 + j] * kk[j]; }
            if (s > m) { const float f = exp2f(m - s); l *= f;
#pragma unroll
                for (int d = 0; d < 64; ++d) o[d] *= f;
                m = s; }
            const float p = exp2f(s - m); l += p;
#pragma unroll
            for (int c = 0; c < 8; ++c) { float vv[8]; load8(kp + 1024 + c * 8, vv);
#pragma unroll
                for (int j = 0; j < 8; ++j) o[c * 8 + j] += p * vv[j]; }
        }
        ML[((size_t)t * 16 + head) * 2] = m; ML[((size_t)t * 16 + head) * 2 + 1] = l;
#pragma unroll
        for (int d = 0; d < 64; d += 4) *(f32x4*)(OACC + (size_t)t * 1024 + head * 64 + d) = (f32x4){o[d], o[d + 1], o[d + 2], o[d + 3]};
    }
}
DEV void gate_naive(const bf16_t* BR, const float* OACC, const float* ML, const bf16_t* TAIL, int ldt, const float* MKV, bf16_t* YIN) {
    const size_t total = (size_t)S_ * 1024;
    for (size_t idx = GTID; idx < total; idx += GSZ) {
        const int c = (int)(idx & 1023), t = (int)(idx >> 10);
        const float br = OACC ? OACC[idx] / ML[((size_t)t * 16 + (c >> 6)) * 2 + 1] : bf2f(BR[idx]);
        const float gt = bf2f(TAIL[(size_t)t * ldt + c]);
        YIN[(size_t)t * 1280 + c] = f2bf(br * silu(gt));
    }
    const size_t total2 = (size_t)4 * S_;
    for (size_t idx = GTID; idx < total2; idx += GSZ) {
        const int mh = (int)(idx >> 14), t = (int)(idx & 16383);
        float q[64], o[64]; float m = -1e30f, l = 0.f;
#pragma unroll
        for (int c = 0; c < 8; ++c) load8(TAIL + (size_t)t * ldt + 1280 + mh * 64 + c * 8, q + c * 8);
#pragma unroll
        for (int d = 0; d < 64; ++d) { q[d] *= C2; o[d] = 0.f; }
        for (int mm = 0; mm < 256; ++mm) {
            const float* kp = MKV + (size_t)mm * 512 + mh * 64;
            float s = 0.f;
#pragma unroll
            for (int d = 0; d < 64; ++d) s += q[d] * kp[d];
            if (s > m) { const float f = exp2f(m - s); l *= f;
#pragma unroll
                for (int d = 0; d < 64; ++d) o[d] *= f;
                m = s; }
            const float p = exp2f(s - m); l += p;
#pragma unroll
            for (int d = 0; d < 64; ++d) o[d] += p * kp[256 + d];
        }
        const float rl = 1.f / l;
#pragma unroll
        for (int c = 0; c < 8; ++c) { float gt[8]; load8(TAIL + (size_t)t * ldt + 1024 + mh * 64 + c * 8, gt);
#pragma unroll
            for (int j = 0; j < 8; ++j) o[c * 8 + j] = o[c * 8 + j] * rl * silu(gt[j]); }
#pragma unroll
        for (int c = 0; c < 8; ++c) store8(YIN + (size_t)t * 1280 + 1024 + mh * 64 + c * 8, o + c * 8);
    }
}


#define LAS3 __attribute__((address_space(3)))
DEV void gemm_bf16(unsigned char* lds_raw, const bf16_t* A, int lda, const bf16_t* Bt, int M, int N, int K, bf16_t* C, int ldc, int G, int c) {
    pg8::Gemm g{A, Bt, M, N, K, lda}; pg8::StaticOrder So; So.init(M, N, G, c);
    pg8::EpiBf16<0> E{C, ldc, nullptr, 0, 0, 1.f};
    pg8::gemm_phase<pg8::EpiBf16<0>, pg8::StaticOrder, PG8_ALIGN, PG8_SP2>((LAS3 unsigned char*)lds_raw, g, So, E);
}
DEV void gemm_f32(unsigned char* lds_raw, const bf16_t* A, int lda, const bf16_t* Bt, int M, int N, int K, float* C, int ldc, int G, int c) {
    pg8::Gemm g{A, Bt, M, N, K, lda}; pg8::StaticOrder So; So.init(M, N, G, c);
    pg8::EpiF32 E{C, ldc};
    pg8::gemm_phase<pg8::EpiF32, pg8::StaticOrder, PG8_ALIGN, PG8_SP2>((LAS3 unsigned char*)lds_raw, g, So, E);
}
#define STEP_BEGIN { unsigned char* ws = p.ws; asm volatile("" : "+s"(ws)); float* H = p.out; float* lds = (float*)lds_raw;
#define STEP_END   } grid.sync();
#define AR(off) (ws + WS_AR + (size_t)(off) * MiB)
#define P_WtA ((bf16_t*)(ws + WS_WA))
#define P_WtB ((bf16_t*)(ws + WS_WB))
#define P_WtC ((bf16_t*)(ws + WS_WC))
#define P_WtO ((bf16_t*)(ws + WS_WO))
#define P_Wdft ((bf16_t*)(ws + WS_WDFT))
#define P_MKV ((float*)(ws + WS_MKV))
#define P_XN ((bf16_t*)(ws + WS_XN))
#define GC (int)gridDim.x, (int)blockIdx.x
#define LNG (p.ln_g + LAYER * 1024)
#define LNB (p.ln_b + LAYER * 1024)
#define WO (P_WtO + (size_t)LAYER * 1024 * 1280)

template <int LAYER> DEV void layer_A(const Params& p, cg::grid_group& grid, unsigned char* lds_raw) {
    STEP_BEGIN
        gemm_bf16(lds_raw, P_XN, 1024, P_WtA + (size_t)(LAYER / 3) * 1536 * 1024, S_, 1536, 1024, (bf16_t*)AR(0), 1536, GC);
        if ((gridDim.x & 3) == 0) { const int g = blockIdx.x & 3; gemm_bf16(lds_raw, P_XN + g * 256, 1024, P_Wdft, S_, 512, 256, (bf16_t*)AR(48) + g * 512, 2048, (int)gridDim.x >> 2, (int)blockIdx.x >> 2); }
        else for (int g = 0; g < 4; ++g) gemm_bf16(lds_raw, P_XN + g * 256, 1024, P_Wdft, S_, 512, 256, (bf16_t*)AR(48) + g * 512, 2048, GC);
    STEP_END
    STEP_BEGIN fft_s1_mfma((bf16_t*)AR(48), (bf16_t*)AR(112), lds_raw); STEP_END
    STEP_BEGIN fft_s2_mfma((bf16_t*)AR(112), (bf16_t*)AR(48), lds_raw); STEP_END
    STEP_BEGIN gate_naive((bf16_t*)AR(48), nullptr, nullptr, (bf16_t*)AR(0), 1536, P_MKV, (bf16_t*)AR(80)); STEP_END
    STEP_BEGIN gemm_f32(lds_raw, (bf16_t*)AR(80), 1280, WO, S_, 1024, 1280, (float*)AR(0), 1024, GC); STEP_END
    STEP_BEGIN ln_rows(H, (float*)AR(0), ALPHA, LNG, LNB, H, P_XN); STEP_END
}
template <int LAYER> DEV void layer_B(const Params& p, cg::grid_group& grid, unsigned char* lds_raw) {
    STEP_BEGIN gemm_bf16(lds_raw, P_XN, 1024, P_WtB, S_, 3072, 1024, (bf16_t*)AR(0), 3072, GC); STEP_END
    STEP_BEGIN qk_post((bf16_t*)AR(0), p.q_norm_g, p.k_norm_g); STEP_END
    STEP_BEGIN
        bf16_t* PROJ = (bf16_t*)AR(0); bf16_t* BR = (bf16_t*)AR(96);
        if (gridDim.x == 256) {
            const attn_body::AttnTensors AT{(const attn_body::bf16*)PROJ, (const attn_body::bf16*)(PROJ + 1024), (const attn_body::bf16*)(PROJ + 1280), (attn_body::bf16*)BR};
            const attn_body::StaticOrder SA((int)gridDim.x, (int)blockIdx.x);
            attn_body::attn_phase<attn_body::StaticOrder>((char*)lds_raw, AT, SA);
        } else attn_naive(PROJ, BR, lds);
    STEP_END
    STEP_BEGIN gate_naive((bf16_t*)AR(96), nullptr, nullptr, (bf16_t*)AR(0) + 1536, 3072, P_MKV, (bf16_t*)AR(128)); STEP_END
    STEP_BEGIN gemm_f32(lds_raw, (bf16_t*)AR(128), 1280, WO, S_, 1024, 1280, (float*)AR(0), 1024, GC); STEP_END
    STEP_BEGIN ln_rows(H, (float*)AR(0), ALPHA, LNG, LNB, H, P_XN); STEP_END
}
template <int LAYER> DEV void layer_C(const Params& p, cg::grid_group& grid, unsigned char* lds_raw) {
    for (int g = 0; g < 3; ++g) {
        STEP_BEGIN
            gemm_bf16(lds_raw, P_XN, 1024, P_WtC + (size_t)g * 3072 * 1024, S_, 3072, 1024, (bf16_t*)AR(0), 3072, GC);
            if (g == 0) make_rope1d((float*)AR(164));
        STEP_END
        STEP_BEGIN rope_c((bf16_t*)AR(0), (float*)AR(164)); STEP_END
        STEP_BEGIN dil_naive((bf16_t*)AR(0), (float*)AR(96), (float*)AR(160), g); STEP_END
    }
    STEP_BEGIN gemm_bf16(lds_raw, P_XN, 1024, P_WtC + (size_t)9216 * 1024, S_, 1536, 1024, (bf16_t*)AR(0), 1536, GC); STEP_END
    STEP_BEGIN gate_naive(nullptr, (float*)AR(96), (float*)AR(160), (bf16_t*)AR(0), 1536, P_MKV, (bf16_t*)AR(48)); STEP_END
    STEP_BEGIN gemm_f32(lds_raw, (bf16_t*)AR(48), 1280, WO, S_, 1024, 1280, (float*)AR(96), 1024, GC); STEP_END
    STEP_BEGIN ln_rows(H, (float*)AR(96), ALPHA, LNG, LNB, H, P_XN); STEP_END
}

__global__ void __launch_bounds__(NTHREADS, 2) mk(Params p) {
    extern __shared__ __attribute__((aligned(16))) unsigned char lds_raw[];
    cg::grid_group grid = cg::this_grid();
    STEP_BEGIN
        tconv(p.w_in_a, 1024, 1536, 1536, P_WtA, 0);
        tconv(p.w_in_a + (size_t)1024 * 1536, 1024, 1536, 1536, P_WtA + (size_t)1536 * 1024, 0);
        tconv(p.w_in_b, 1024, 3072, 3072, P_WtB, 0);
        tconv(p.w_in_c, 1024, 10752, 10752, P_WtC, 1);
        for (int i = 0; i < 4; ++i) tconv(p.w_out + (size_t)i * 1280 * 1024, 1280, 1024, 1024, P_WtO + (size_t)i * 1024 * 1280, 0);
        make_wdft(P_Wdft);
        make_mkv(p.mem, p.w_mem_kv, P_MKV);
        ln_rows(p.x, nullptr, 1.f, p.ln_in_g, p.ln_in_b, H, P_XN);
    STEP_END
    layer_A<0>(p, grid, lds_raw);
    layer_B<1>(p, grid, lds_raw);
    layer_C<2>(p, grid, lds_raw);
    layer_A<3>(p, grid, lds_raw);
}

extern "C" void kernel_launch(void* const* d_in, const int* in_sizes, int n_in, void* d_out, int out_size, void* d_ws, size_t ws_size, hipStream_t stream) {
    if (n_in != 13 || ws_size < 256 * MiB) { fprintf(stderr, "kernel_launch: unexpected inputs (n_in %d, ws %zu)\n", n_in, ws_size); return; }
    Params p{};
    p.x = (const float*)d_in[0]; p.mem = (const float*)d_in[1]; p.ln_in_g = (const float*)d_in[2]; p.ln_in_b = (const float*)d_in[3];
    p.w_mem_kv = (const float*)d_in[4]; p.w_in_a = (const float*)d_in[5]; p.w_in_b = (const float*)d_in[6]; p.q_norm_g = (const float*)d_in[7];
    p.k_norm_g = (const float*)d_in[8]; p.w_in_c = (const float*)d_in[9]; p.w_out = (const float*)d_in[10]; p.ln_g = (const float*)d_in[11]; p.ln_b = (const float*)d_in[12];
    p.out = (float*)d_out; p.ws = (unsigned char*)d_ws;
    static int grid_blocks = 0;
    if (!grid_blocks) {
        int dev = 0, cus = 0, per_cu = 0;
        hipGetDevice(&dev);
        hipDeviceGetAttribute(&cus, hipDeviceAttributeMultiprocessorCount, dev);
        hipFuncSetAttribute((const void*)mk, hipFuncAttributeMaxDynamicSharedMemorySize, LDS_BYTES);
        hipOccupancyMaxActiveBlocksPerMultiprocessor(&per_cu, (const void*)mk, NTHREADS, LDS_BYTES);
        if (per_cu < 1) per_cu = 1;
        grid_blocks = cus * per_cu;
    }
    p.s0 = 0; p.s1 = NSTEPS;
    void* args[] = {&p};
    hipError_t e = hipLaunchCooperativeKernel((const void*)mk, dim3(grid_blocks), dim3(NTHREADS), args, LDS_BYTES, stream);
    if (e != hipSuccess) fprintf(stderr, "cooperative launch failed: %s (grid %d)\n", hipGetErrorString(e), grid_blocks);
}
```

```cpp
#include <hip/hip_runtime.h>
#include <hip/hip_cooperative_groups.h>
#include <cstdio>
#include <cstdint>
namespace cg = cooperative_groups;

#define DEV __device__ __forceinline__
typedef unsigned short bf16_t;
typedef short bf16x8 __attribute__((ext_vector_type(8)));
typedef float f32x4 __attribute__((ext_vector_type(4)));
typedef unsigned u32x4 __attribute__((ext_vector_type(4)));
typedef unsigned u32x2 __attribute__((ext_vector_type(2)));

constexpr int S_ = 16384, DM = 1024;
constexpr float ALPHA = 1.681792830507429f;
constexpr float C2 = 0.125f * 1.4426950408889634f;
constexpr float LN_EPS = 1e-5f;
constexpr size_t MiB = 1u << 20;
constexpr size_t WS_WA = 2 * MiB, WS_WB = 8 * MiB, WS_WC = 14 * MiB, WS_WO = 35 * MiB, WS_WDFT = 45 * MiB, WS_MKV = 45 * MiB + 512 * 1024;
constexpr size_t WS_XN = 48 * MiB, WS_AR = 80 * MiB;
constexpr int NTHREADS = 512;
constexpr int NSTEPS = 32;
constexpr int LDS_BYTES = 147456;


namespace pg8 {
#define PG8_LAS __attribute__((address_space(3)))
typedef unsigned short bf16_t;
typedef short bf16x8 __attribute__((ext_vector_type(8)));
typedef float f32x4 __attribute__((ext_vector_type(4)));
typedef unsigned u32x4 __attribute__((ext_vector_type(4)));
constexpr int BM = 256, BK = 64, HALF = 128, HTB = HALF * BK * 2  , STAGE_BYTES = 8 * HTB, NXCD = 8, WGM = 8;

__host__ __device__ __forceinline__ int lds_byte(int r, int c) { const int st = (r >> 4) * 2 + (c >> 5), rr = r & 15, cc = c & 31, ob = rr * 64 + cc * 2; return st * 1024 + (ob ^ (((ob >> 9) & 1) << 5)); }
__host__ __device__ __forceinline__ void stage_rc(int b, int& R, int& C) { const int st = b / 1024, sb = b % 1024, swz = sb ^ (((sb >> 9) & 1) << 5); R = (st >> 1) * 16 + swz / 64; C = (st & 1) * 32 + (swz % 64) / 2; }
__host__ __device__ __forceinline__ int perm32(int rho) { const int n = rho >> 4, i = rho & 15; return 8 * (i >> 2) + 4 * n + (i & 3); }

struct Unit { int pm, pn; };
struct Gemm { const bf16_t* A; const bf16_t* Bt; int M, N, K, lda; };

struct StaticOrder {
    int nM, nN, nwg, G, c;
    __host__ __device__ void init(int M, int N, int G_, int c_) { nM = M / BM; nN = N / BM; nwg = nM * nN; G = G_; c = c_; }
    __host__ __device__ bool next(int i, Unit& u) const {
        const long L = (long)i * G + c; if (L >= nwg) return false;
        int wgid = (int)L; { const int q = nwg / NXCD, r = nwg % NXCD, xcd = wgid % NXCD, off = wgid / NXCD; wgid = (xcd < r ? xcd * (q + 1) : r * (q + 1) + (xcd - r) * q) + off; }
        const int nig = WGM * nN, gid = wgid / nig, fm = gid * WGM, gsz = (nM - fm) < WGM ? (nM - fm) : WGM;
        u.pm = fm + ((wgid % nig) % gsz); u.pn = (wgid % nig) / gsz; return true;
    }
    __device__ __forceinline__ void a_ready(const Unit&) const {}
    __device__ __forceinline__ void done(const Unit&) const {}
};

__device__ __forceinline__ unsigned cvt_pk_bf16(float lo, float hi) { unsigned r; asm volatile("v_cvt_pk_bf16_f32 %0, %1, %2" : "=v"(r) : "v"(lo), "v"(hi)); return r; }
typedef float f32x2 __attribute__((ext_vector_type(2)));
__device__ __forceinline__ f32x2 gelu_pk(f32x2 v) {
    const f32x2 av = __builtin_elementwise_abs(v), d = av * 0.2316418882f + 1.0f;
    f32x2 t; t.x = __builtin_amdgcn_rcpf(d.x); t.y = __builtin_amdgcn_rcpf(d.y);
    f32x2 q = t * 0.5307027145f + (-0.7265760135f); q = q * t + 0.7107068705f; q = q * t + (-0.142248368f); q = q * t + 0.127414796f; q = q * t;
    const f32x2 s = (v * v) * (-0.72134752044f);
    f32x2 e; e.x = __builtin_amdgcn_exp2f(s.x); e.y = __builtin_amdgcn_exp2f(s.y);
    const f32x2 m = v * (q * e), r = v - m;
    f32x2 o; o.x = v.x < 0.f ? m.x : r.x; o.y = v.y < 0.f ? m.y : r.y; return o;
}

template <int ACT  > struct EpiBf16 {
    static constexpr bool PERM = true, AFTER_DRAIN = false; static_assert(ACT == 0 || ACT == 1, "EpiBf16: ACT is 0 (none) or 1 (gelu_pk)");
    bf16_t* O; int ldc; const float* bias; int split_cols; size_t split_stride; float scale0;
    __device__ __forceinline__ void operator()(const f32x4 (&acc)[2][2][4][2], const Unit& u, int wr, int wc, int fr, int fq) const {
        const int row0 = u.pm * BM + wr * 64 + fr; int colt = u.pn * BM; bf16_t* base = O;
        float sc = 1.f; if (split_cols) { const int t = colt / split_cols; base += (size_t)t * split_stride; colt -= t * split_cols; if (t == 0) sc = scale0; }
        const int col0 = colt + wc * 32 + 8 * fq, bcol0 = u.pn * BM + wc * 32 + 8 * fq;
        f32x4 bv[2][2];
#pragma unroll
        for (int bj = 0; bj < 2; ++bj)
#pragma unroll
            for (int n = 0; n < 2; ++n) bv[bj][n] = bias ? *(const f32x4*)(bias + bcol0 + bj * HALF + 4 * n) : (f32x4){0.f, 0.f, 0.f, 0.f};
#pragma unroll
        for (int ai = 0; ai < 2; ++ai)
#pragma unroll
            for (int m = 0; m < 4; ++m) { bf16_t* rowp = base + (size_t)(row0 + ai * HALF + m * 16) * ldc + col0;
#pragma unroll
                for (int bj = 0; bj < 2; ++bj) { f32x4 v0 = acc[ai][bj][m][0] + bv[bj][0], v1 = acc[ai][bj][m][1] + bv[bj][1];
                    if (ACT == 1) { f32x2 a = gelu_pk((f32x2){v0[0], v0[1]}), b = gelu_pk((f32x2){v0[2], v0[3]}), c = gelu_pk((f32x2){v1[0], v1[1]}), d = gelu_pk((f32x2){v1[2], v1[3]});
                        v0 = (f32x4){a.x, a.y, b.x, b.y}; v1 = (f32x4){c.x, c.y, d.x, d.y}; }
                    v0 = v0 * sc; v1 = v1 * sc; u32x4 w; w.x = cvt_pk_bf16(v0[0], v0[1]); w.y = cvt_pk_bf16(v0[2], v0[3]); w.z = cvt_pk_bf16(v1[0], v1[1]); w.w = cvt_pk_bf16(v1[2], v1[3]);
                    *(u32x4*)(rowp + bj * HALF) = w; } }
    }
};

struct EpiF32 {
    static constexpr bool PERM = false, AFTER_DRAIN = false;
    float* O; int ldc;
    __device__ __forceinline__ void operator()(const f32x4 (&acc)[2][2][4][2], const Unit& u, int wr, int wc, int fr, int fq) const {
        const int row0 = u.pm * BM + wr * 64 + fr, col0 = u.pn * BM + wc * 32 + 4 * fq;
#pragma unroll
        for (int ai = 0; ai < 2; ++ai)
#pragma unroll
            for (int m = 0; m < 4; ++m) { float* rowp = O + (size_t)(row0 + ai * HALF + m * 16) * ldc + col0;
#pragma unroll
                for (int bj = 0; bj < 2; ++bj)
#pragma unroll
                    for (int n = 0; n < 2; ++n) *(f32x4*)(rowp + bj * HALF + n * 16) = acc[ai][bj][m][n]; }
    }
};
template <class Epi, class Sched, bool ALIGN_EPI = false, bool SP2 = false>
__device__ __forceinline__ void gemm_phase(PG8_LAS unsigned char* lds, const Gemm g, const Sched& S, const Epi& E) {
    int tid_ = threadIdx.x; asm volatile("" : "+v"(tid_)); const int tid = tid_, wid = __builtin_amdgcn_readfirstlane(tid >> 6), lane = tid & 63, wr = wid >> 2, wc = wid & 3, fr = lane & 15, fq = lane >> 4;
    const int K = g.K, nt = K / BK;
    unsigned voffA[2], voffB[2];
#pragma unroll
    for (int i = 0; i < 2; ++i) { int R, C; stage_rc(tid * 16 + i * 8192, R, C); const int Rb = Epi::PERM ? ((R & ~31) + perm32(R & 31)) : R;
        voffA[i] = (unsigned)(R * g.lda + C) * 2u; voffB[i] = (unsigned)(Rb * K + C) * 2u; }
    const size_t kstep = (size_t)(BK * 2);
    const size_t hstepB = (size_t)HALF * K * 2, hstepA = (size_t)HALF * g.lda * 2;
    const size_t tstepA = 2 * hstepA, tstepB = 2 * hstepB;
    const unsigned ldsw = (unsigned)wid * 1024u;
    const int aoff = lds_byte(wr * 64 + fr, fq * 8), boff = lds_byte(wc * 32 + fr, fq * 8);
#define PG8_SA(b, h) (((b) * 2 + (h)) * HTB)
#define PG8_SB(b, h) ((4 + (b) * 2 + (h)) * HTB)
#define PG8_STAGE(bufoff, gbase, voff) do { _Pragma("unroll") for (int _i = 0; _i < 2; ++_i) \
        __builtin_amdgcn_global_load_lds((const unsigned*)((const char*)(gbase) + (voff)[_i]), (PG8_LAS unsigned*)(lds + (bufoff) + ldsw + _i * 8192), 16, 0, 0); } while (0)
#define PG8_LDA(dst, b, h) do { _Pragma("unroll") for (int m = 0; m < 4; ++m) _Pragma("unroll") for (int k = 0; k < 2; ++k) dst[m][k] = *(const PG8_LAS bf16x8*)(lds + PG8_SA(b, h) + aoff + m * 2048 + k * 1024); } while (0)
#define PG8_LDB(dst, b, h) do { _Pragma("unroll") for (int n = 0; n < 2; ++n) _Pragma("unroll") for (int k = 0; k < 2; ++k) dst[n][k] = *(const PG8_LAS bf16x8*)(lds + PG8_SB(b, h) + boff + n * 2048 + k * 1024); } while (0)
#define PG8_MMA(ai, bj, At, Bt) do { __builtin_amdgcn_s_setprio(1); _Pragma("unroll") for (int m = 0; m < 4; ++m) _Pragma("unroll") for (int n = 0; n < 2; ++n) _Pragma("unroll") for (int k = 0; k < 2; ++k) \
        acc[ai][bj][m][n] = __builtin_amdgcn_mfma_f32_16x16x32_bf16(Bt[n][k], At[m][k], acc[ai][bj][m][n], 0, 0, 0); __builtin_amdgcn_s_setprio(0); } while (0)
#define PG8_WAIT_V(n) asm volatile("s_waitcnt vmcnt(" #n ")" ::: "memory")
#define PG8_WAIT_L(n) asm volatile("s_waitcnt lgkmcnt(" #n ")" ::: "memory")
#define PG8_BAR __builtin_amdgcn_s_barrier()
#define PG8_SCHED __builtin_amdgcn_sched_barrier(0)
    Unit cur, nxt; int ui = 0;
    if (!S.next(0, cur)) return;
    f32x4 acc[2][2][4][2];
#pragma unroll
    for (int a = 0; a < 2; ++a)
#pragma unroll
        for (int b = 0; b < 2; ++b)
#pragma unroll
            for (int m = 0; m < 4; ++m)
#pragma unroll
                for (int n = 0; n < 2; ++n) acc[a][b][m][n] = (f32x4){0.f, 0.f, 0.f, 0.f};
    bf16x8 At[4][2], B0[2][2], B1[2][2];
    const char* cA = (const char*)g.A + (size_t)cur.pm * tstepA; const char* cB = (const char*)g.Bt + (size_t)cur.pn * tstepB;
    S.a_ready(cur);
    if constexpr (SP2) {
        PG8_STAGE(PG8_SB(0, 0), cB, voffB); PG8_STAGE(PG8_SB(0, 1), cB + hstepB, voffB); PG8_STAGE(PG8_SA(0, 0), cA, voffA); PG8_STAGE(PG8_SA(0, 1), cA + hstepA, voffA);
        if (wr == 1) PG8_BAR;
        PG8_WAIT_V(2); PG8_BAR;
        PG8_STAGE(PG8_SB(1, 0), cB + kstep, voffB); PG8_STAGE(PG8_SA(1, 0), cA + kstep, voffA); PG8_STAGE(PG8_SB(1, 1), cB + hstepB + kstep, voffB);
        PG8_WAIT_V(6); PG8_BAR;
    } else {
        PG8_STAGE(PG8_SB(0, 0), cB, voffB); PG8_STAGE(PG8_SA(0, 0), cA, voffA); PG8_STAGE(PG8_SB(0, 1), cB + hstepB, voffB); PG8_STAGE(PG8_SA(0, 1), cA + hstepA, voffA);
        if (wr == 1) PG8_BAR;
        PG8_WAIT_V(4); PG8_BAR;
        PG8_STAGE(PG8_SB(1, 0), cB + kstep, voffB); PG8_STAGE(PG8_SA(1, 0), cA + kstep, voffA); PG8_STAGE(PG8_SB(1, 1), cB + hstepB + kstep, voffB);
        PG8_WAIT_V(6); PG8_BAR;
    }
    for (;;) {
        const bool has_next = S.next(ui + 1, nxt);
        const char* nA = has_next ? (const char*)g.A + (size_t)nxt.pm * tstepA : cA; const char* nB = has_next ? (const char*)g.Bt + (size_t)nxt.pn * tstepB : cB;
        for (int t = 0; t < nt; t += 2) {
            const bool last = (t == nt - 2);
            const char* a1 = cA + (size_t)(t + 1) * kstep;
            const char* a2 = last ? nA : cA + (size_t)(t + 2) * kstep; const char* b2 = last ? nB : cB + (size_t)(t + 2) * kstep;
            const char* a3 = a2 + kstep; const char* b3 = b2 + kstep;
            if (last && has_next) S.a_ready(nxt);
            if constexpr (SP2) {
            PG8_LDB(B0, 0, 0); PG8_LDB(B1, 0, 1); PG8_SCHED; PG8_LDA(At, 0, 0); PG8_STAGE(PG8_SA(1, 1), a1 + hstepA, voffA);
            PG8_WAIT_V(8); PG8_WAIT_L(0); PG8_BAR; PG8_MMA(0, 0, At, B0); PG8_MMA(0, 1, At, B1); PG8_BAR; PG8_SCHED;
            PG8_LDA(At, 0, 1); PG8_STAGE(PG8_SB(0, 0), b2, voffB); PG8_STAGE(PG8_SB(0, 1), b2 + hstepB, voffB); PG8_STAGE(PG8_SA(0, 0), a2, voffA);
            PG8_WAIT_V(8); PG8_WAIT_L(0); PG8_BAR; PG8_MMA(1, 0, At, B0); PG8_MMA(1, 1, At, B1); PG8_BAR; PG8_SCHED;
            PG8_LDB(B0, 1, 0); PG8_LDB(B1, 1, 1); PG8_SCHED; PG8_LDA(At, 1, 0); PG8_STAGE(PG8_SA(0, 1), a2 + hstepA, voffA);
            PG8_WAIT_V(8); PG8_WAIT_L(0); PG8_BAR; PG8_MMA(0, 0, At, B0); PG8_MMA(0, 1, At, B1); PG8_BAR; PG8_SCHED;
            PG8_LDA(At, 1, 1); PG8_STAGE(PG8_SB(1, 0), b3, voffB); PG8_STAGE(PG8_SB(1, 1), b3 + hstepB, voffB); PG8_STAGE(PG8_SA(1, 0), a3, voffA);
            PG8_WAIT_V(8); PG8_WAIT_L(0); PG8_BAR; PG8_MMA(1, 0, At, B0); PG8_MMA(1, 1, At, B1); PG8_BAR; PG8_SCHED;
            } else {
            PG8_LDB(B0, 0, 0); PG8_SCHED; PG8_LDA(At, 0, 0); PG8_STAGE(PG8_SA(1, 1), a1 + hstepA, voffA);
            PG8_WAIT_L(8); PG8_BAR; PG8_WAIT_L(0); PG8_MMA(0, 0, At, B0); PG8_BAR; PG8_SCHED;
            PG8_LDB(B1, 0, 1); PG8_STAGE(PG8_SB(0, 0), b2, voffB);
            PG8_BAR; PG8_WAIT_L(0); PG8_MMA(0, 1, At, B1); PG8_BAR;
            PG8_LDA(At, 0, 1); PG8_STAGE(PG8_SA(0, 0), a2, voffA);
            PG8_BAR; PG8_WAIT_L(0); PG8_MMA(1, 0, At, B0); PG8_BAR; PG8_SCHED;
            PG8_STAGE(PG8_SB(0, 1), b2 + hstepB, voffB);
            PG8_WAIT_V(6); PG8_BAR; PG8_MMA(1, 1, At, B1); PG8_BAR;
            PG8_LDB(B0, 1, 0); PG8_SCHED; PG8_LDA(At, 1, 0); PG8_STAGE(PG8_SA(0, 1), a2 + hstepA, voffA);
            PG8_WAIT_L(8); PG8_BAR; PG8_WAIT_L(0); PG8_MMA(0, 0, At, B0); PG8_BAR; PG8_SCHED;
            PG8_LDB(B1, 1, 1); PG8_STAGE(PG8_SB(1, 0), b3, voffB);
            PG8_BAR; PG8_WAIT_L(0); PG8_MMA(0, 1, At, B1); PG8_BAR;
            PG8_LDA(At, 1, 1); PG8_STAGE(PG8_SA(1, 0), a3, voffA);
            PG8_BAR; PG8_WAIT_L(0); PG8_MMA(1, 0, At, B0); PG8_BAR; PG8_SCHED;
            PG8_STAGE(PG8_SB(1, 1), b3 + hstepB, voffB);
            PG8_WAIT_V(6); PG8_BAR; PG8_MMA(1, 1, At, B1); PG8_BAR;
            }
        }
        if constexpr (ALIGN_EPI) { if (wr == 0) PG8_BAR; }
        if constexpr (!Epi::AFTER_DRAIN) { E(acc, cur, wr, wc, fr, fq); S.done(cur); }
        if (!has_next) break;
#pragma unroll
        for (int a = 0; a < 2; ++a)
#pragma unroll
            for (int b = 0; b < 2; ++b)
#pragma unroll
                for (int m = 0; m < 4; ++m)
#pragma unroll
                    for (int n = 0; n < 2; ++n) acc[a][b][m][n] = (f32x4){0.f, 0.f, 0.f, 0.f};
        cur = nxt; cA = nA; cB = nB; ++ui;
        if constexpr (ALIGN_EPI) { if (wr == 1) PG8_BAR; }
    }
    PG8_WAIT_V(0);
    if constexpr (!ALIGN_EPI) { if (wr == 0) PG8_BAR; }
    PG8_BAR;
    if constexpr (Epi::AFTER_DRAIN) { E.fused(acc, cur, wr, wc, fr, fq, lds, wid, lane); S.done(cur); }
#undef PG8_SA
#undef PG8_SB
#undef PG8_STAGE
#undef PG8_LDA
#undef PG8_LDB
#undef PG8_MMA
#undef PG8_WAIT_V
#undef PG8_WAIT_L
#undef PG8_BAR
#undef PG8_SCHED
}
}

#define PG8_SP2 true
#define PG8_ALIGN true
#include <hip/hip_bf16.h>
#include <cmath>
namespace attn_body {
using bf16=__hip_bfloat16;
using bf16x8=__attribute__((ext_vector_type(8)))short;
using s16x4=__attribute__((ext_vector_type(4)))short;
using f32x16=__attribute__((ext_vector_type(16)))float;
using u32x4=__attribute__((ext_vector_type(4)))unsigned;
constexpr int BATCH=1,NHEAD=16,SEQ=16384,D=64,DM=NHEAD*D,QP=3072,KP=3072,OP=1024;
constexpr int NW=8,QBLK=32,QB=QBLK*NW,KVBLK=64,NQB=SEQ/QB;
constexpr int ATTN_PITCH=DM, ATTN_UNIT_ROWS=QB;
__device__ __forceinline__ int crow(int r,int hi){return (r&3)+8*(r>>2)+4*hi;}
#define SBAR() __builtin_amdgcn_sched_barrier(0)
__device__ __forceinline__ void cmask(f32x16&p0,f32x16&p1,int jb,int qrel,int hi){
  const float NEG=-INFINITY; int kb=64*jb+4*hi;
  #pragma unroll
  for(int r=0;r<16;++r){int kv=kb+(r&3)+8*(r>>2); if(kv>qrel)p0[r]=NEG; if(kv+32>qrel)p1[r]=NEG;}
}

constexpr int NSLOT=3, SLOTB=8192;
constexpr int LDS_K=0, LDS_V=NSLOT*SLOTB, LDS_WS=2*NSLOT*SLOTB, LDS_OST=LDS_WS+NW*64*4, LDS_BYTES=LDS_OST+NW*4096;
constexpr float C2=0.125f*1.4426950408889634f;
__device__ __forceinline__ void glds16(const void*gsrc,unsigned lds_dst){unsigned keep;
  asm volatile("s_mov_b32 %0, m0\n\ts_mov_b32 m0, %2\n\ts_nop 0\n\tglobal_load_lds_dwordx4 %1, off\n\ts_mov_b32 m0, %0":"=&s"(keep):"v"(gsrc),"s"(lds_dst):"memory");}
__device__ __forceinline__ float max3f(float a,float b,float c){float r;asm("v_max3_f32 %0, %1, %2, %3":"=v"(r):"v"(a),"v"(b),"v"(c));return r;}
__device__ __forceinline__ float max2f(float a,float b){float r;asm("v_max_f32_e32 %0, %1, %2":"=v"(r):"v"(a),"v"(b));return r;}
__device__ __forceinline__ float fadd_s(float a,float b){float r;asm("v_add_f32_e32 %0, %1, %2":"=v"(r):"v"(a),"v"(b));return r;}
__device__ __forceinline__ float fsub_s(float a,float b){float r;asm("v_sub_f32_e32 %0, %1, %2":"=v"(r):"v"(a),"v"(b));return r;}
typedef float f32x2_t __attribute__((ext_vector_type(2))); typedef __bf16 bf16x2_t __attribute__((ext_vector_type(2)));
__device__ __forceinline__ unsigned cvtpk_s(float lo,float hi){f32x2_t v={lo,hi};bf16x2_t b=__builtin_convertvector(v,bf16x2_t);return __builtin_bit_cast(unsigned,b);}
#define WAIT_BAR(N) asm volatile("s_waitcnt vmcnt(" #N ") lgkmcnt(0)\n\ts_barrier":::"memory")

__device__ __forceinline__ void qkt(f32x16&p0,f32x16&p1,const char*Kslot,const bf16x8*qr,const f32x16&negm,int r32,int hi){
  const char*kb=Kslot+hi*1024+r32*16;
  #pragma unroll
  for(int d0=0;d0<4;++d0){
    const bf16x8 b0=*reinterpret_cast<const bf16x8*>(kb+d0*2048);
    const bf16x8 b1=*reinterpret_cast<const bf16x8*>(kb+d0*2048+512);
    if(d0==0){p0=__builtin_amdgcn_mfma_f32_32x32x16_bf16(b0,qr[0],negm,0,0,0);p1=__builtin_amdgcn_mfma_f32_32x32x16_bf16(b1,qr[0],negm,0,0,0);}
    else{p0=__builtin_amdgcn_mfma_f32_32x32x16_bf16(b0,qr[d0],p0,0,0,0);p1=__builtin_amdgcn_mfma_f32_32x32x16_bf16(b1,qr[d0],p1,0,0,0);}}
}
typedef __attribute__((address_space(3))) const char* lds_cptr;
typedef short v4i16_t __attribute__((ext_vector_type(4)));
__device__ __forceinline__ void kload8(bf16x8*kf,lds_cptr kp){
  kf[0]=*(const __attribute__((address_space(3))) bf16x8*)(kp);      kf[1]=*(const __attribute__((address_space(3))) bf16x8*)(kp+512);
  kf[2]=*(const __attribute__((address_space(3))) bf16x8*)(kp+2048); kf[3]=*(const __attribute__((address_space(3))) bf16x8*)(kp+2560);
  kf[4]=*(const __attribute__((address_space(3))) bf16x8*)(kp+4096); kf[5]=*(const __attribute__((address_space(3))) bf16x8*)(kp+4608);
  kf[6]=*(const __attribute__((address_space(3))) bf16x8*)(kp+6144); kf[7]=*(const __attribute__((address_space(3))) bf16x8*)(kp+6656);
}
__device__ __forceinline__ void kload2(bf16x8*kf,lds_cptr kp,int j){ kf[2*j]=*(const __attribute__((address_space(3))) bf16x8*)(kp+j*2048); kf[2*j+1]=*(const __attribute__((address_space(3))) bf16x8*)(kp+j*2048+512); }
__device__ __forceinline__ s16x4 vtr(lds_cptr p){ return __builtin_bit_cast(s16x4,__builtin_amdgcn_ds_read_tr16_b64_v4i16((__attribute__((address_space(3))) v4i16_t*)p)); }
__device__ __forceinline__ float rowmax(const f32x16&p0,const f32x16&p1){
  float a=max3f(p0[0],p0[1],p1[0]),b=max3f(p0[2],p0[3],p1[1]);a=max3f(a,p1[2],p1[3]);
  #pragma unroll
  for(int r=4;r<16;r+=4){a=max3f(a,p0[r],p0[r+1]);b=max3f(b,p0[r+2],p0[r+3]);a=max3f(a,p1[r],p1[r+1]);b=max3f(b,p1[r+2],p1[r+3]);}
  const float m=max2f(a,b);
  auto rr=__builtin_amdgcn_permlane32_swap(__float_as_uint(m),__float_as_uint(m),false,false);
  return max2f(__uint_as_float(rr[0]),__uint_as_float(rr[1]));
}
__device__ __forceinline__ void pv(f32x16*o,int vb,bf16x8 pa0,bf16x8 pa1,bf16x8 pa2,bf16x8 pa3){
  #pragma unroll
  for(int d0=0;d0<2;++d0){s16x4 lo[4],hi[4];
    #pragma unroll
    for(int ks=0;ks<4;++ks){
      asm volatile("ds_read_b64_tr_b16 %0,%1 offset:%c2":"=&v"(lo[ks]):"v"(vb),"i"(d0*4096+ks*1024):"memory");
      asm volatile("ds_read_b64_tr_b16 %0,%1 offset:%c2":"=&v"(hi[ks]):"v"(vb),"i"(d0*4096+ks*1024+512):"memory");}
    asm volatile("s_waitcnt lgkmcnt(0)":::"memory");SBAR();
    #define PK(k) (bf16x8){lo[k][0],lo[k][1],lo[k][2],lo[k][3],hi[k][0],hi[k][1],hi[k][2],hi[k][3]}
    o[d0]=__builtin_amdgcn_mfma_f32_32x32x16_bf16(pa0,PK(0),o[d0],0,0,0);
    o[d0]=__builtin_amdgcn_mfma_f32_32x32x16_bf16(pa1,PK(1),o[d0],0,0,0);
    o[d0]=__builtin_amdgcn_mfma_f32_32x32x16_bf16(pa2,PK(2),o[d0],0,0,0);
    o[d0]=__builtin_amdgcn_mfma_f32_32x32x16_bf16(pa3,PK(3),o[d0],0,0,0);
    #undef PK
  }
}

#ifndef ATTN_STORE16
#define ATTN_STORE16(p,v) (*(u32x4*)(p)=(v))
#endif
template<int THRL> __device__ __forceinline__ void attn_unit(int b,int h,int qb,const bf16*Q,const bf16*__restrict__ K,const bf16*__restrict__ V,bf16*O,char*shm){
  int tid_=threadIdx.x; asm volatile("":"+v"(tid_)); const int tid=tid_,lane=tid&63,r32=lane&31,hi=lane>>5; const int wid=__builtin_amdgcn_readfirstlane(tid>>6);
  const long rowbase=(long)b*SEQ; const int q0=qb*QB;
  const bf16*Qw=Q+(rowbase+q0+wid*QBLK)*QP+h*D;
  const int kvh=h>>2; const bf16*Kh=K+rowbase*KP+kvh*D,*Vh=V+rowbase*KP+kvh*D;
  const unsigned lds0=(unsigned)(uintptr_t)shm;
  float*wsf=(float*)(shm+LDS_WS)+wid*64;
  const bf16*ksrc=Kh+(long)lane*KP+wid*8;
  const bf16*vsrc=Vh+(long)(16*(wid&3)+(lane>>2))*KP+(wid>>2)*32+(lane&3)*8;
  const unsigned kdst=lds0+LDS_K+wid*1024, vdst=lds0+LDS_V+wid*1024;
  #define DMA_K(t,slot) glds16(ksrc+(long)(t)*KVBLK*KP,(unsigned)__builtin_amdgcn_readfirstlane(kdst+(slot)))
  #define DMA_V(t,slot) glds16(vsrc+(long)(t)*KVBLK*KP,(unsigned)__builtin_amdgcn_readfirstlane(vdst+(slot)))
  const int vb0=(int)(lds0+LDS_V)+((lane>>4)&1)*32+(lane&3)*8+(4*hi+((lane&15)>>2))*64;
  const char*Kbase=shm+LDS_K; bf16x8 kf[8];
  const lds_cptr shm3=(lds_cptr)shm; const lds_cptr kp0=shm3+LDS_K+hi*1024+r32*16; const lds_cptr vp0=shm3+LDS_V+((lane>>4)&1)*32+(lane&3)*8+(4*hi+((lane&15)>>2))*64;
  const int NT=SEQ/KVBLK;
  DMA_K(0,0);DMA_V(0,0);DMA_K(1,SLOTB);
  bf16x8 qr[4];
  #pragma unroll
  for(int d0=0;d0<4;++d0)qr[d0]=*reinterpret_cast<const bf16x8*>(&Qw[(long)r32*QP+d0*16+hi*8]);
  float mhat=0.f,l_reg=0.f;f32x16 o[2];o[0]=f32x16{};o[1]=f32x16{};f32x16 negm=f32x16{};asm volatile("":"+v"(negm));
  const int qrel=wid*QBLK+r32;
  #define CMASK(P0,P1,t) do{}while(0)
  bool resc=false;
  #define START(P0,P1) do{ const float rm=rowmax(P0,P1); resc=false; \
    { const float dl=rm; mhat=fadd_s(mhat,dl); \
      _Pragma("unroll") for(int r=0;r<16;++r){P0[r]=fsub_s(P0[r],dl);P1[r]=fsub_s(P1[r],dl);} \
      _Pragma("unroll") for(int r=0;r<16;++r)negm[r]=-mhat; asm volatile("":"+v"(negm)); } \
    _Pragma("unroll") for(int r=0;r<16;++r)P0[r]=__builtin_amdgcn_exp2f(P0[r]); }while(0)
  #define RESC() do{ if(resc){ asm volatile("s_waitcnt lgkmcnt(0)":::"memory"); \
      _Pragma("unroll") for(int d_=0;d_<2;++d_) _Pragma("unroll") for(int r=0;r<16;++r)o[d_][r]*=wsf[crow(r,hi)]; } }while(0)
  f32x16 pA0,pA1,pB0,pB1;
  int sl_prev=0,sl_cur=0,sl_next=SLOTB;
  #define ROT() do{sl_prev=sl_cur;sl_cur=sl_next;sl_next=(sl_next==(NSLOT-1)*SLOTB)?0:sl_next+SLOTB;}while(0)
  DMA_K(2,2*SLOTB);
  WAIT_BAR(3);
  qkt(pA0,pA1,Kbase,qr,negm,r32,hi);asm volatile("s_nop 15\n\ts_nop 7":"+v"(pA0),"+v"(pA1));CMASK(pA0,pA1,0);
  START(pA0,pA1);
  _Pragma("unroll") for(int r=0;r<16;++r)pA1[r]=__builtin_amdgcn_exp2f(pA1[r]);
  WAIT_BAR(0);
  DMA_K(3,0);DMA_V(1,SLOTB);
  ROT();
  kload8(kf,kp0+sl_cur);
  WAIT_BAR(2);
  s16x4 vlo[8],vhi[8]; u32x4 pw0,pw1,pw2,pw3;
  #define PKW(P,B) cvtpk_s(P[B],P[B+1])
  #define PAF(k) __builtin_bit_cast(bf16x8,pw##k)
  #define VFR(i) (bf16x8){vlo[i][0],vlo[i][1],vlo[i][2],vlo[i][3],vhi[i][0],vhi[i][1],vhi[i][2],vhi[i][3]}
  #define PIN(x) asm volatile("":"+v"(x))
  #define MX3(a,b,c) __builtin_fmaxf(__builtin_fmaxf((a),(b)),(c))
  #define GAPA(MF,A0,A1,A2,A3,W0,W1,PW) do{ MF; sacc+=A0; sacc+=A1; sacc+=A2; sacc+=A3; PIN(sacc); W0; W1; PIN(PW); SBAR(); }while(0)
  #define EX(v) __builtin_amdgcn_exp2f(v)
  #define GAPB(MF,X,B) do{ MF; X[B]=EX(X[B]); X[B+1]=EX(X[B+1]); X[B+2]=EX(X[B+2]); X[B+3]=EX(X[B+3]); PIN(X); SBAR(); }while(0)
  #define VRD(i) do{ vlo[i]=vtr(vp_+(((i)>>2)*4096+((i)&3)*1024)); vhi[i]=vtr(vp_+(((i)>>2)*4096+((i)&3)*1024+512)); }while(0)
  #define KRD(G,j) do{ if(G){ kload2(kf,kp0+sl_next,j); SBAR(); } }while(0)
  #define STEP(C0,C1,P0,P1,t,GK,GV,GL) do{ SBAR(); \
    const lds_cptr vp_=vp0+sl_prev; \
    VRD(0); SBAR(); float sacc=(P0[0]+P0[1]); \
    GAPA(C0=__builtin_amdgcn_mfma_f32_32x32x16_bf16(kf[0],qr[0],negm,0,0,0), P0[2],P0[3],P0[4],P0[5],     pw0[0]=PKW(P0,0), pw0[1]=PKW(P0,2), pw0); \
    VRD(4); SBAR(); GAPA(C1=__builtin_amdgcn_mfma_f32_32x32x16_bf16(kf[1],qr[0],negm,0,0,0), P0[6],P0[7],P0[8],P0[9],     pw0[2]=PKW(P0,4), pw0[3]=PKW(P0,6), pw0); \
    VRD(1); SBAR(); GAPA(C0=__builtin_amdgcn_mfma_f32_32x32x16_bf16(kf[2],qr[1],C0,0,0,0),   P0[10],P0[11],P0[12],P0[13], pw1[0]=PKW(P0,8), pw1[1]=PKW(P0,10), pw1); \
    VRD(5); SBAR(); GAPA(C1=__builtin_amdgcn_mfma_f32_32x32x16_bf16(kf[3],qr[1],C1,0,0,0),   P0[14],P0[15],P1[0],P1[1],   pw1[2]=PKW(P0,12),pw1[3]=PKW(P0,14), pw1); \
    VRD(2); SBAR(); GAPA(C0=__builtin_amdgcn_mfma_f32_32x32x16_bf16(kf[4],qr[2],C0,0,0,0),   P1[2],P1[3],P1[4],P1[5],     pw2[0]=PKW(P1,0), pw2[1]=PKW(P1,2), pw2); \
    VRD(6); SBAR(); GAPA(C1=__builtin_amdgcn_mfma_f32_32x32x16_bf16(kf[5],qr[2],C1,0,0,0),   P1[6],P1[7],P1[8],P1[9],     pw2[2]=PKW(P1,4), pw2[3]=PKW(P1,6), pw2); \
    VRD(3); SBAR(); GAPA(C0=__builtin_amdgcn_mfma_f32_32x32x16_bf16(kf[6],qr[3],C0,0,0,0),   P1[10],P1[11],P1[12],P1[13], pw3[0]=PKW(P1,8), pw3[1]=PKW(P1,10), pw3); \
    VRD(7); SBAR(); GAPA(C1=__builtin_amdgcn_mfma_f32_32x32x16_bf16(kf[7],qr[3],C1,0,0,0),   P1[14],P1[15],0.f,0.f,       pw3[2]=PKW(P1,12),pw3[3]=PKW(P1,14), pw3); \
    l_reg+=sacc; \
    if(GK){DMA_K((t)+3,sl_cur);} if(GV){DMA_V((t)+1,sl_next);} \
    CMASK(C0,C1,t); \
    { float a=MX3(C0[0],C0[1],C1[0]),b=MX3(C0[2],C0[3],C1[1]); a=MX3(a,C1[2],C1[3]); \
      _Pragma("unroll") for(int r=4;r<16;r+=4){a=MX3(a,C0[r],C0[r+1]);b=MX3(b,C0[r+2],C0[r+3]);a=MX3(a,C1[r],C1[r+1]);b=MX3(b,C1[r+2],C1[r+3]);} \
      float rm=__builtin_fmaxf(a,b); { auto rr=__builtin_amdgcn_permlane32_swap(__float_as_uint(rm),__float_as_uint(rm),false,false); rm=__builtin_fmaxf(__uint_as_float(rr[0]),__uint_as_float(rr[1])); } \
      resc=false; \
      if(__builtin_expect(__any(rm>(float)THRL),0)){ const float dl=__builtin_fmaxf(rm,0.f); mhat+=dl; \
        _Pragma("unroll") for(int r=0;r<16;++r){C0[r]-=dl;C1[r]-=dl;} \
        _Pragma("unroll") for(int r=0;r<16;++r)negm[r]=-mhat; asm volatile("":"+v"(negm)); \
        const float f=__builtin_amdgcn_exp2f(-dl); l_reg*=f; if(hi==0)wsf[r32]=f; resc=true; } } \
    SBAR(); \
    GAPB(o[0]=__builtin_amdgcn_mfma_f32_32x32x16_bf16(PAF(0),VFR(0),o[0],0,0,0), C0,0); \
    GAPB(o[1]=__builtin_amdgcn_mfma_f32_32x32x16_bf16(PAF(0),VFR(4),o[1],0,0,0), C0,4); \
    KRD(GL,0); GAPB(o[0]=__builtin_amdgcn_mfma_f32_32x32x16_bf16(PAF(1),VFR(1),o[0],0,0,0), C0,8); \
    KRD(GL,1); GAPB(o[1]=__builtin_amdgcn_mfma_f32_32x32x16_bf16(PAF(1),VFR(5),o[1],0,0,0), C0,12); \
    KRD(GL,2); GAPB(o[0]=__builtin_amdgcn_mfma_f32_32x32x16_bf16(PAF(2),VFR(2),o[0],0,0,0), C1,0); \
    KRD(GL,3); GAPB(o[1]=__builtin_amdgcn_mfma_f32_32x32x16_bf16(PAF(2),VFR(6),o[1],0,0,0), C1,4); \
    GAPB(o[0]=__builtin_amdgcn_mfma_f32_32x32x16_bf16(PAF(3),VFR(3),o[0],0,0,0), C1,8); \
    GAPB(o[1]=__builtin_amdgcn_mfma_f32_32x32x16_bf16(PAF(3),VFR(7),o[1],0,0,0), C1,12); \
    }while(0)
  int t=1;
  #undef CMASK
  #define CMASK(P0,P1,t) do{}while(0)
  for(;t+5<NT;t+=2){
    STEP(pB0,pB1,pA0,pA1,t,true,true,true);     WAIT_BAR(2); RESC(); ROT();
    STEP(pA0,pA1,pB0,pB1,t+1,true,true,true);   WAIT_BAR(2); RESC(); ROT();
  }
  #undef CMASK
  #define CMASK(P0,P1,t) do{}while(0)
  #define ENDW(tt) do{ if((tt)+3<NT){WAIT_BAR(2);} else if((tt)+2<NT){WAIT_BAR(1);} else {WAIT_BAR(0);} }while(0)
  for(;t+1<NT;t+=2){
    STEP(pB0,pB1,pA0,pA1,t,(t+3<NT),(t+1<NT),(t+1<NT));       ENDW(t);   RESC(); ROT();
    STEP(pA0,pA1,pB0,pB1,t+1,(t+4<NT),(t+2<NT),(t+2<NT));     ENDW(t+1); RESC(); ROT();
  }
  STEP(pB0,pB1,pA0,pA1,NT-1,false,false,false); RESC();
  { float sacc=pB0[0]+pB0[1]; _Pragma("unroll") for(int r=2;r<16;++r)sacc+=pB0[r]; _Pragma("unroll") for(int r=0;r<16;++r)sacc+=pB1[r]; l_reg+=sacc;
    pw0=(u32x4){PKW(pB0,0),PKW(pB0,2),PKW(pB0,4),PKW(pB0,6)};pw1=(u32x4){PKW(pB0,8),PKW(pB0,10),PKW(pB0,12),PKW(pB0,14)};pw2=(u32x4){PKW(pB1,0),PKW(pB1,2),PKW(pB1,4),PKW(pB1,6)};pw3=(u32x4){PKW(pB1,8),PKW(pB1,10),PKW(pB1,12),PKW(pB1,14)};
    SBAR(); pv(o,vb0+sl_cur,PAF(0),PAF(1),PAF(2),PAF(3)); }
  #undef PKW
  #undef PAF
  #undef VFR
  #undef PIN
  #undef MX3
  #undef GAPA
  #undef GAPB
  #undef EX
  #undef VRD
  #undef KRD
  #undef STEP
  #undef ENDW
  {auto rr=__builtin_amdgcn_permlane32_swap(__float_as_uint(l_reg),__float_as_uint(l_reg),false,false);l_reg=__uint_as_float(rr[0])+__uint_as_float(rr[1]);}
  if(hi==0)wsf[32+r32]=l_reg;asm volatile("s_waitcnt lgkmcnt(0)":::"memory");
  float rli[16];
  #pragma unroll
  for(int r=0;r<16;++r)rli[r]=__builtin_amdgcn_rcpf(wsf[32+crow(r,hi)]);
  bf16*Ow=O+(rowbase+q0+wid*QBLK)*OP+h*D;
  { bf16*stg=(bf16*)(shm+LDS_OST)+wid*2048;
    #pragma unroll
    for(int r=0;r<16;++r){const int orow=crow(r,hi);
      #pragma unroll
      for(int d0=0;d0<2;++d0)stg[orow*64+d0*32+r32]=__float2bfloat16(o[d0][r]*rli[r]);}
    asm volatile("s_waitcnt lgkmcnt(0)":::"memory");
    #pragma unroll
    for(int i=0;i<4;++i){const int row=i*8+(lane>>3),ch=lane&7; const u32x4 v=*(const u32x4*)(stg+row*64+ch*8); ATTN_STORE16(Ow+(long)row*OP+ch*8,v);} }
  asm volatile("s_waitcnt lgkmcnt(0)\n\ts_barrier":::"memory");
  #undef DMA_K
  #undef DMA_V
  #undef CMASK
  #undef START
  #undef RESC
  #undef ROT
}
constexpr int ATTN_LDS_BYTES=LDS_BYTES;
struct AttnTensors { const bf16* Q; const bf16* K; const bf16* V; bf16* O; };
struct AttnUnit { int bh; int qb; };
struct StaticOrder {
  int vcu;
  __device__ __forceinline__ explicit StaticOrder(int grid,int block):vcu((block%8)*(grid/8)+block/8){}
  __device__ __forceinline__ bool next(int i,AttnUnit&u)const{ if(i>=4)return false; u.bh=vcu>>4; u.qb=(vcu&15)*4+i; return true; }
  __device__ __forceinline__ void a_ready(const AttnUnit&)const{}
  __device__ __forceinline__ void done(const AttnUnit&)const{}
};
template<class Sched,int THRL=8> __device__ __forceinline__ void attn_phase(char*lds,const AttnTensors&T,const Sched&S){
  AttnUnit u;
  for(int i=0;S.next(i,u);++i){ S.a_ready(u); attn_unit<THRL>(u.bh/NHEAD,u.bh%NHEAD,u.qb,T.Q,T.K,T.V,T.O,lds); S.done(u); }
}
#undef SBAR
#undef WAIT_BAR
}

struct Params {
    const float *x, *mem, *ln_in_g, *ln_in_b, *w_mem_kv, *w_in_a, *w_in_b, *q_norm_g, *k_norm_g, *w_in_c, *w_out, *ln_g, *ln_b;
    float* out; unsigned char* ws;
    int s0, s1;
};

DEV float bf2f(bf16_t b) { return __uint_as_float(((unsigned)b) << 16); }
DEV bf16_t f2bf(float f) { unsigned u = __float_as_uint(f); return (bf16_t)((u + 0x7fffu + ((u >> 16) & 1u)) >> 16); }
DEV unsigned pk2(float lo, float hi) { return (unsigned)f2bf(lo) | ((unsigned)f2bf(hi) << 16); }
DEV float wave_sum(float v) {
#pragma unroll
    for (int o = 1; o < 64; o <<= 1) v += __shfl_xor(v, o);
    return v;
}
DEV float silu(float x) { return x / (1.f + __expf(-x)); }
DEV void load8(const bf16_t* p, float* o) {
    u32x4 v = *(const u32x4*)p;
    o[0] = __uint_as_float(v.x << 16); o[1] = __uint_as_float(v.x & 0xffff0000u);
    o[2] = __uint_as_float(v.y << 16); o[3] = __uint_as_float(v.y & 0xffff0000u);
    o[4] = __uint_as_float(v.z << 16); o[5] = __uint_as_float(v.z & 0xffff0000u);
    o[6] = __uint_as_float(v.w << 16); o[7] = __uint_as_float(v.w & 0xffff0000u);
}
DEV void store8(bf16_t* p, const float* o) {
    u32x4 v; v.x = pk2(o[0], o[1]); v.y = pk2(o[2], o[3]); v.z = pk2(o[4], o[5]); v.w = pk2(o[6], o[7]);
    *(u32x4*)p = v;
}
DEV int ltid() { int t = threadIdx.x; asm volatile("" : "+v"(t)); return t; }
#define GTID ((size_t)blockIdx.x * blockDim.x + ltid())
#define GSZ ((size_t)gridDim.x * blockDim.x)

DEV void tconv(const float* src, int K, int Ntot, int ncols, bf16_t* dst, int mode) {
    const size_t total = (size_t)ncols * (K / 8);
    for (size_t idx = GTID; idx < total; idx += GSZ) {
        const int n = (int)(idx % ncols), kc = (int)(idx / ncols);
        int sc = n;
        if (mode == 1 && n < 9216) { const int g = n / 3072, rem = n % 3072, which = rem / 1024, r = rem % 1024; sc = which * 3072 + g * 1024 + r; }
        float v[8];
#pragma unroll
        for (int j = 0; j < 8; ++j) v[j] = src[(size_t)(kc * 8 + j) * Ntot + sc];
        store8(dst + (size_t)n * K + kc * 8, v);
    }
}
DEV void make_wdft(bf16_t* w) {
    for (size_t idx = GTID; idx < 512 * 256; idx += GSZ) {
        const int n = (int)(idx >> 8), c = (int)(idx & 255), which = n >> 8, l = n & 255;
        float s, co; sincospif((float)((l * c) & 255) / 128.f, &s, &co);
        w[idx] = f2bf(which == 0 ? co : -s);
    }
}
DEV void make_mkv(const float* mem, const float* w, float* mkv) {
    for (size_t idx = GTID; idx < 256 * 512; idx += GSZ) {
        const int m = (int)(idx >> 9), n = (int)(idx & 511);
        float a = 0.f;
        for (int k = 0; k < 1024; ++k) a += mem[m * 1024 + k] * w[(size_t)k * 512 + n];
        mkv[idx] = a;
    }
}
DEV void make_rope1d(float* tab) {
    for (size_t idx = GTID; idx < (size_t)S_ * 32; idx += GSZ) {
        const int t = (int)(idx >> 5), i = (int)(idx & 31);
        const float inv = powf(10000.f, -((float)(2 * i) / 64.f));
        const float a = (float)t * inv;
        tab[idx * 2] = cosf(a); tab[idx * 2 + 1] = sinf(a);
    }
}
DEV void ln_rows(const float* a, const float* y, float alpha, const float* g, const float* b, float* outH, bf16_t* outXN) {
    const int lane = ltid() & 63, wpb = blockDim.x >> 6;
    const int gw = blockIdx.x * wpb + (ltid() >> 6), nw = gridDim.x * wpb;
    for (int row = gw; row < S_; row += nw) {
        f32x4 v[4]; float s = 0.f;
#pragma unroll
        for (int j = 0; j < 4; ++j) {
            v[j] = *(const f32x4*)(a + (size_t)row * DM + j * 256 + lane * 4);
            if (y) { const f32x4 u = *(const f32x4*)(y + (size_t)row * DM + j * 256 + lane * 4); v[j] = v[j] * alpha + u; }
            s += (v[j].x + v[j].y) + (v[j].z + v[j].w);
        }
        const float mean = wave_sum(s) * (1.f / DM); float s2 = 0.f;
#pragma unroll
        for (int j = 0; j < 4; ++j) { v[j] = v[j] - mean; s2 += (v[j].x * v[j].x + v[j].y * v[j].y) + (v[j].z * v[j].z + v[j].w * v[j].w); }
        const float rstd = 1.f / sqrtf(wave_sum(s2) * (1.f / DM) + LN_EPS);
#pragma unroll
        for (int j = 0; j < 4; ++j) {
            const f32x4 gg = *(const f32x4*)(g + j * 256 + lane * 4), bb = *(const f32x4*)(b + j * 256 + lane * 4);
            const f32x4 o = v[j] * rstd * gg + bb;
            *(f32x4*)(outH + (size_t)row * DM + j * 256 + lane * 4) = o;
            u32x2 w; w.x = pk2(o.x, o.y); w.y = pk2(o.z, o.w);
            *(u32x2*)(outXN + (size_t)row * DM + j * 256 + lane * 4) = w;
        }
    }
}
DEV void gemm_simple(const bf16_t* A, int lda, const bf16_t* Bt, int ldb, int M, int N, int K, void* C, int ldc, int f32out) {
    const int lane = ltid() & 63, wpb = blockDim.x >> 6;
    const int gw = blockIdx.x * wpb + (ltid() >> 6), nw = gridDim.x * wpb;
    const int tn = N / 64, tiles = (M / 64) * tn, fr = lane & 15, fq = lane >> 4;
    for (int t = gw; t < tiles; t += nw) {
        const int tm = t / tn, tc = t % tn;
        f32x4 acc[4][4];
#pragma unroll
        for (int i = 0; i < 4; ++i)
#pragma unroll
            for (int j = 0; j < 4; ++j) acc[i][j] = (f32x4){0.f, 0.f, 0.f, 0.f};
        const bf16_t* ap = A + (size_t)(tm * 64 + fr) * lda + fq * 8;
        const bf16_t* bp = Bt + (size_t)(tc * 64 + fr) * ldb + fq * 8;
        for (int k0 = 0; k0 < K; k0 += 32) {
            bf16x8 a[4], b[4];
#pragma unroll
            for (int i = 0; i < 4; ++i) { a[i] = *(const bf16x8*)(ap + (size_t)i * 16 * lda + k0); b[i] = *(const bf16x8*)(bp + (size_t)i * 16 * ldb + k0); }
#pragma unroll
            for (int i = 0; i < 4; ++i)
#pragma unroll
                for (int j = 0; j < 4; ++j) acc[i][j] = __builtin_amdgcn_mfma_f32_16x16x32_bf16(a[i], b[j], acc[i][j], 0, 0, 0);
        }
#pragma unroll
        for (int i = 0; i < 4; ++i)
#pragma unroll
            for (int j = 0; j < 4; ++j)
#pragma unroll
                for (int r = 0; r < 4; ++r) {
                    const size_t off = (size_t)(tm * 64 + i * 16 + fq * 4 + r) * ldc + tc * 64 + j * 16 + fr;
                    if (f32out) ((float*)C)[off] = acc[i][j][r]; else ((bf16_t*)C)[off] = f2bf(acc[i][j][r]);
                }
    }
}
DEV int zc(int j) { return ((j >> 8) << 9) + (j & 255); }
DEV void fft_tab(float* tab) {
    __syncthreads();
    for (int i = ltid(); i < 128; i += blockDim.x) { float s, c; sincospif((float)i / 64.f, &s, &c); tab[i] = c; tab[128 + i] = s; }
    __syncthreads();
}
DEV void fft_s1(const bf16_t* Z, bf16_t* T, float* tab) {
    fft_tab(tab);
    const size_t total = (size_t)S_ * 1024;
    for (size_t idx = GTID; idx < total; idx += GSZ) {
        const int j = (int)(idx & 1023), r = (int)(idx >> 10), k1 = r >> 7, s2 = r & 127, cj = zc(j);
        float ar = 0.f, ai = 0.f;
        for (int s1 = 0; s1 < 128; ++s1) {
            const int n = (s1 * k1) & 127; const float c = tab[n], s = tab[128 + n];
            const bf16_t* zp = Z + (size_t)(128 * s1 + s2) * 2048 + cj;
            const float zr = bf2f(zp[0]), zi = bf2f(zp[256]);
            ar += zr * c + zi * s; ai += zi * c - zr * s;
        }
        float ts, tc; sincospif((float)(s2 * k1) / 8192.f, &ts, &tc);
        const float tr = ar * tc + ai * ts, ti = ai * tc - ar * ts;
        T[(size_t)r * 2048 + cj] = f2bf(tr); T[(size_t)r * 2048 + cj + 256] = f2bf(ti);
    }
}
DEV void fft_s2(const bf16_t* T, bf16_t* BR, float* tab) {
    fft_tab(tab);
    const size_t total = (size_t)S_ * 1024;
    for (size_t idx = GTID; idx < total; idx += GSZ) {
        const int j = (int)(idx & 1023), k = (int)(idx >> 10), k1 = k & 127, k2 = k >> 7, cj = zc(j);
        float acc = 0.f;
        for (int s2 = 0; s2 < 128; ++s2) {
            const int n = (s2 * k2) & 127; const float c = tab[n], s = tab[128 + n];
            const bf16_t* tp = T + (size_t)(k1 * 128 + s2) * 2048 + cj;
            acc += bf2f(tp[0]) * c + bf2f(tp[256]) * s;
        }
        BR[(size_t)k * 1024 + j] = f2bf(acc * (1.f / 2048.f));
    }
}

typedef float f32x16 __attribute__((ext_vector_type(16)));
constexpr int FT_LD = 136;
DEV void fft_tables(bf16_t* Ct, bf16_t* St) {
    __syncthreads();
    for (int e = ltid(); e < 128 * 128; e += blockDim.x) { const int r = e >> 7, c = e & 127; float s, co; sincospif((float)((r * c) & 127) / 64.f, &s, &co); Ct[r * FT_LD + c] = f2bf(co); St[r * FT_LD + c] = f2bf(s); }
    __syncthreads();
}
DEV int crow16(int r, int hi) { return (r & 3) + 8 * (r >> 2) + 4 * hi; }
DEV void fft_s1_mfma(const bf16_t* Z, bf16_t* T, unsigned char* lds_raw) {
    bf16_t* Ct = (bf16_t*)lds_raw; bf16_t* St = Ct + 128 * FT_LD;
    fft_tables(Ct, St);
    const int tid = ltid(), lane = tid & 63, r32 = lane & 31, hi = lane >> 5, wpb = blockDim.x >> 6;
    const int gw = blockIdx.x * wpb + (tid >> 6), nw = gridDim.x * wpb;
    for (int task = gw; task < 128 * 32; task += nw) {
        const int s2 = task >> 5, jt = task & 31, j = jt * 32 + r32, cj = zc(j);
        const bf16_t* zp = Z + (size_t)s2 * 2048 + cj;
        bf16x8 zr[8], zi[8];
#pragma unroll
        for (int s = 0; s < 8; ++s)
#pragma unroll
            for (int e = 0; e < 8; ++e) { const size_t off = (size_t)(16 * s + 8 * hi + e) * (128 * 2048); zr[s][e] = (short)zp[off]; zi[s][e] = (short)zp[off + 256]; }
        f32x16 ore[4], oim[4];
#pragma unroll
        for (int mt = 0; mt < 4; ++mt)
#pragma unroll
            for (int r = 0; r < 16; ++r) { ore[mt][r] = 0.f; oim[mt][r] = 0.f; }
#pragma unroll
        for (int s = 0; s < 8; ++s) {
            bf16x8 nzr;
#pragma unroll
            for (int e = 0; e < 8; ++e) nzr[e] = (short)(zr[s][e] ^ (short)0x8000);
#pragma unroll
            for (int mt = 0; mt < 4; ++mt) {
                const bf16x8 c = *(const bf16x8*)(Ct + (mt * 32 + r32) * FT_LD + 16 * s + 8 * hi);
                const bf16x8 sn = *(const bf16x8*)(St + (mt * 32 + r32) * FT_LD + 16 * s + 8 * hi);
                ore[mt] = __builtin_amdgcn_mfma_f32_32x32x16_bf16(c, zr[s], ore[mt], 0, 0, 0);
                ore[mt] = __builtin_amdgcn_mfma_f32_32x32x16_bf16(sn, zi[s], ore[mt], 0, 0, 0);
                oim[mt] = __builtin_amdgcn_mfma_f32_32x32x16_bf16(c, zi[s], oim[mt], 0, 0, 0);
                oim[mt] = __builtin_amdgcn_mfma_f32_32x32x16_bf16(sn, nzr, oim[mt], 0, 0, 0);
            }
        }
#pragma unroll
        for (int mt = 0; mt < 4; ++mt)
#pragma unroll
            for (int r = 0; r < 16; ++r) {
                const int k1 = mt * 32 + crow16(r, hi);
                const float xr = (float)(s2 * k1) * (1.f / 16384.f);
                const float tc = __builtin_amdgcn_cosf(xr), ts = __builtin_amdgcn_sinf(xr);
                const float ar = ore[mt][r], ai = oim[mt][r];
                bf16_t* tp = T + (size_t)(k1 * 128 + s2) * 2048 + cj;
                tp[0] = f2bf(ar * tc + ai * ts); tp[256] = f2bf(ai * tc - ar * ts);
            }
    }
    __syncthreads();
}
DEV void fft_s2_mfma(const bf16_t* T, bf16_t* BR, unsigned char* lds_raw) {
    bf16_t* Ct = (bf16_t*)lds_raw; bf16_t* St = Ct + 128 * FT_LD;
    fft_tables(Ct, St);
    const int tid = ltid(), lane = tid & 63, r32 = lane & 31, hi = lane >> 5, wpb = blockDim.x >> 6;
    const int gw = blockIdx.x * wpb + (tid >> 6), nw = gridDim.x * wpb;
    for (int task = gw; task < 128 * 32; task += nw) {
        const int k1 = task >> 5, jt = task & 31, j = jt * 32 + r32, cj = zc(j);
        const bf16_t* tp = T + (size_t)(k1 * 128) * 2048 + cj;
        bf16x8 tr[8], ti[8];
#pragma unroll
        for (int s = 0; s < 8; ++s)
#pragma unroll
            for (int e = 0; e < 8; ++e) { const size_t off = (size_t)(16 * s + 8 * hi + e) * 2048; tr[s][e] = (short)tp[off]; ti[s][e] = (short)tp[off + 256]; }
        f32x16 o[4];
#pragma unroll
        for (int mt = 0; mt < 4; ++mt)
#pragma unroll
            for (int r = 0; r < 16; ++r) o[mt][r] = 0.f;
#pragma unroll
        for (int s = 0; s < 8; ++s)
#pragma unroll
            for (int mt = 0; mt < 4; ++mt) {
                const bf16x8 c = *(const bf16x8*)(Ct + (mt * 32 + r32) * FT_LD + 16 * s + 8 * hi);
                const bf16x8 sn = *(const bf16x8*)(St + (mt * 32 + r32) * FT_LD + 16 * s + 8 * hi);
                o[mt] = __builtin_amdgcn_mfma_f32_32x32x16_bf16(c, tr[s], o[mt], 0, 0, 0);
                o[mt] = __builtin_amdgcn_mfma_f32_32x32x16_bf16(sn, ti[s], o[mt], 0, 0, 0);
            }
#pragma unroll
        for (int mt = 0; mt < 4; ++mt)
#pragma unroll
            for (int r = 0; r < 16; ++r) {
                const int k = k1 + 128 * (mt * 32 + crow16(r, hi));
                BR[(size_t)k * 1024 + j] = f2bf(o[mt][r] * (1.f / 2048.f));
            }
    }
    __syncthreads();
}
DEV void qk_post(bf16_t* PROJ, const float* qg, const float* kg) {
    const size_t total = (size_t)S_ * 20 * 16;
    for (size_t idx = GTID; idx < total; idx += GSZ) {
        const int i = (int)(idx & 15), head = (int)((idx >> 4) % 20), t = (int)((idx >> 4) / 20);
        bf16_t* p = PROJ + (size_t)t * 3072 + head * 64;
        float a1 = bf2f(p[i]), a2 = bf2f(p[16 + i]), b1 = bf2f(p[32 + i]), b2 = bf2f(p[48 + i]);
        float ss = a1 * a1 + a2 * a2 + b1 * b1 + b2 * b2;
        ss += __shfl_xor(ss, 1); ss += __shfl_xor(ss, 2); ss += __shfl_xor(ss, 4); ss += __shfl_xor(ss, 8);
        const float r = 1.f / sqrtf(ss * (1.f / 64.f) + 1e-6f);
        const float* g = head < 16 ? qg : kg;
        a1 *= r * g[i]; a2 *= r * g[16 + i]; b1 *= r * g[32 + i]; b2 *= r * g[48 + i];
        const float frow = (float)(t >> 6), fcol = (float)(t & 63);
        const float sc = head < 16 ? C2 : 1.f;
        const float inv = powf(10000.f, -((float)(2 * i) / 32.f));
        const float ar = frow * inv, ac = fcol * inv;
        const float cr = cosf(ar), sr = sinf(ar), cc = cosf(ac), scn = sinf(ac);
        p[i] = f2bf((a1 * cr - a2 * sr) * sc); p[16 + i] = f2bf((a2 * cr + a1 * sr) * sc);
        p[32 + i] = f2bf((b1 * cc - b2 * scn) * sc); p[48 + i] = f2bf((b2 * cc + b1 * scn) * sc);
    }
}
DEV void attn_naive(const bf16_t* PROJ, bf16_t* BR, float* lds) {
    const int nth = blockDim.x, qblocks = S_ / nth, items = 16 * qblocks;
    float* Ks = lds; float* Vs = lds + 64 * 64;
    for (int it = blockIdx.x; it < items; it += gridDim.x) {
        const int hq = it / qblocks, qb = it % qblocks, kvh = hq >> 2, t = qb * nth + ltid();
        float q[64], o[64]; float m = -1e30f, l = 0.f;
#pragma unroll
        for (int c = 0; c < 8; ++c) load8(PROJ + (size_t)t * 3072 + hq * 64 + c * 8, q + c * 8);
#pragma unroll
        for (int d = 0; d < 64; ++d) o[d] = 0.f;
        for (int k0 = 0; k0 < S_; k0 += 64) {
            __syncthreads();
            for (int e = ltid(); e < 64 * 8; e += nth) {
                const int r = e >> 3, c8 = e & 7; float tmp[8];
                load8(PROJ + (size_t)(k0 + r) * 3072 + 1024 + kvh * 64 + c8 * 8, tmp);
#pragma unroll
                for (int j = 0; j < 8; ++j) Ks[r * 64 + c8 * 8 + j] = tmp[j];
                load8(PROJ + (size_t)(k0 + r) * 3072 + 1280 + kvh * 64 + c8 * 8, tmp);
#pragma unroll
                for (int j = 0; j < 8; ++j) Vs[r * 64 + c8 * 8 + j] = tmp[j];
            }
            __syncthreads();
            for (int r = 0; r < 64; ++r) {
                float s = 0.f;
#pragma unroll
                for (int d = 0; d < 64; d += 4) { const f32x4 kk = *(const f32x4*)(Ks + r * 64 + d); s += q[d] * kk.x + q[d + 1] * kk.y + q[d + 2] * kk.z + q[d + 3] * kk.w; }
                if (s > m) { const float f = exp2f(m - s); l *= f;
#pragma unroll
                    for (int d = 0; d < 64; ++d) o[d] *= f;
                    m = s; }
                const float p = exp2f(s - m); l += p;
#pragma unroll
                for (int d = 0; d < 64; d += 4) { const f32x4 vv = *(const f32x4*)(Vs + r * 64 + d); o[d] += p * vv.x; o[d + 1] += p * vv.y; o[d + 2] += p * vv.z; o[d + 3] += p * vv.w; }
            }
        }
        const float rl = 1.f / l;
#pragma unroll
        for (int d = 0; d < 64; ++d) o[d] *= rl;
#pragma unroll
        for (int c = 0; c < 8; ++c) store8(BR + (size_t)t * 1024 + hq * 64 + c * 8, o + c * 8);
    }
    __syncthreads();
}
DEV void rope_c(bf16_t* QKV, const float* tab) {
    const size_t total = (size_t)S_ * 32;
    for (size_t idx = GTID; idx < total; idx += GSZ) {
        const int hh = (int)(idx & 31), t = (int)(idx >> 5);
        bf16_t* p = QKV + (size_t)t * 3072 + hh * 64;
        float x[64];
#pragma unroll
        for (int c = 0; c < 8; ++c) load8(p + c * 8, x + c * 8);
        const float sc = hh < 16 ? C2 : 1.f;
        const float* tb = tab + (size_t)t * 64;
#pragma unroll
        for (int i = 0; i < 32; ++i) {
            const float c = tb[2 * i], s = tb[2 * i + 1];
            const float a1 = x[i], a2 = x[32 + i];
            x[i] = (a1 * c - a2 * s) * sc; x[32 + i] = (a2 * c + a1 * s) * sc;
        }
#pragma unroll
        for (int c = 0; c < 8; ++c) store8(p + c * 8, x + c * 8);
    }
}
DEV void dil_naive(const bf16_t* QKV, float* OACC, float* ML, int g) {
    const int dil = g == 0 ? 1 : (g == 1 ? 4 : 16);
    const size_t total = (size_t)16 * S_;
    for (size_t idx = GTID; idx < total; idx += GSZ) {
        const int head = (int)(idx >> 14), t = (int)(idx & 16383);
        float q[64], o[64]; float m, l;
#pragma unroll
        for (int c = 0; c < 8; ++c) load8(QKV + (size_t)t * 3072 + head * 64 + c * 8, q + c * 8);
        if (g == 0) { m = -1e30f; l = 0.f;
#pragma unroll
            for (int d = 0; d < 64; ++d) o[d] = 0.f;
        } else {
            m = ML[((size_t)t * 16 + head) * 2]; l = ML[((size_t)t * 16 + head) * 2 + 1];
#pragma unroll
            for (int d = 0; d < 64; d += 4) { const f32x4 v = *(const f32x4*)(OACC + (size_t)t * 1024 + head * 64 + d); o[d] = v.x; o[d + 1] = v.y; o[d + 2] = v.z; o[d + 3] = v.w; }
        }
        for (int mm = -64; mm <= 64; ++mm) {
            const int tk = t + mm * dil;
            if (tk < 0 || tk >= S_) continue;
            const bf16_t* kp = QKV + (size_t)tk * 3072 + 1024 + head * 64;
            float s = 0.f;
#pragma unroll
            for (int c = 0; c < 8; ++c) { float kk[8]; load8(kp + c * 8, kk);
#pragma unroll
                for (int j = 0; j < 8; ++j) s += q[c * 8 + j] * kk[j]; }
            if (s > m) { const float f = exp2f(m - s); l *= f;
#pragma unroll
                for (int d = 0; d < 64; ++d) o[d] *= f;
                m = s; }
            const float p = exp2f(s - m); l += p;
#pragma unroll
            for (int c = 0; c < 8; ++c) { float vv[8]; load8(kp + 1024 + c * 8, vv);
#pragma unroll
                for (int j = 0; j < 8; ++j) o[c * 8 + j] += p * vv[j]; }
        }
        ML[((size_t)t * 16 + head) * 2] = m; ML[((size_t)t * 16 + head) * 2 + 1] = l;
#pragma unroll
        for (int d = 0; d < 64; d += 4) *(f32x4*)(OACC + (size_t)t * 1024 + head * 64 + d) = (f32x4){o[d], o[d + 1], o[d + 2], o[d + 3]};
    }
}

DEV void dil_mfma(const bf16_t* QKV, float* OACC, float* ML, int g) {
    const int sh = 2 * g, dil = 1 << sh, L = S_ >> sh, nqb = L >> 5;
    const int tid = ltid(), lane = tid & 63, r32 = lane & 31, hi = lane >> 5, wpb = blockDim.x >> 6;
    const int gw = blockIdx.x * wpb + (tid >> 6), nw = gridDim.x * wpb;
    for (int task = gw; task < 16 * 512; task += nw) {
        const int a = task % nqb, hc = task / nqb, c = hc & (dil - 1), head = hc >> sh;
        const int tq = ((32 * a + r32) << sh) + c;
        const bf16_t* qp = QKV + (size_t)tq * 3072 + head * 64 + 8 * hi;
        bf16x8 qf[4];
#pragma unroll
        for (int ks = 0; ks < 4; ++ks) qf[ks] = *(const bf16x8*)(qp + 16 * ks);
        f32x16 st[5];
#pragma unroll
        for (int kt = 0; kt < 5; ++kt) {
            int jj = 32 * a - 64 + 32 * kt + r32; jj = jj < 0 ? 0 : (jj > L - 1 ? L - 1 : jj);
            const bf16_t* kp = QKV + (size_t)((jj << sh) + c) * 3072 + 1024 + head * 64 + 8 * hi;
#pragma unroll
            for (int r = 0; r < 16; ++r) st[kt][r] = 0.f;
#pragma unroll
            for (int ks = 0; ks < 4; ++ks) st[kt] = __builtin_amdgcn_mfma_f32_32x32x16_bf16(*(const bf16x8*)(kp + 16 * ks), qf[ks], st[kt], 0, 0, 0);
        }
        float mx = -1e30f;
#pragma unroll
        for (int kt = 0; kt < 5; ++kt)
#pragma unroll
            for (int r = 0; r < 16; ++r) {
                const int kvl = 32 * kt + crow16(r, hi), jj = 32 * a - 64 + kvl;
                const bool valid = (kvl >= r32) && (kvl <= r32 + 128) && (jj >= 0) && (jj < L);
                const float v = valid ? st[kt][r] : -1e30f; st[kt][r] = v; mx = fmaxf(mx, v);
            }
        mx = fmaxf(mx, __shfl_xor(mx, 32));
        float m_old = -1e30f, l_old = 0.f;
        if (g != 0) { m_old = ML[((size_t)tq * 16 + head) * 2]; l_old = ML[((size_t)tq * 16 + head) * 2 + 1]; }
        const float m_new = fmaxf(m_old, mx), f = exp2f(m_old - m_new);
        float ls = 0.f;
#pragma unroll
        for (int kt = 0; kt < 5; ++kt)
#pragma unroll
            for (int r = 0; r < 16; ++r) { const float pv = exp2f(st[kt][r] - m_new); st[kt][r] = pv; ls += pv; }
        ls += __shfl_xor(ls, 32);
        const float l_new = l_old * f + ls;
        f32x16 o[2];
#pragma unroll
        for (int dt = 0; dt < 2; ++dt)
#pragma unroll
            for (int r = 0; r < 16; ++r) o[dt][r] = 0.f;
#pragma unroll
        for (int kt = 0; kt < 5; ++kt)
#pragma unroll
            for (int s = 0; s < 2; ++s) {
                bf16x8 pf;
#pragma unroll
                for (int e = 0; e < 8; ++e) pf[e] = (short)f2bf(st[kt][8 * s + e]);
                const bf16_t* vrow[8];
#pragma unroll
                for (int e = 0; e < 8; ++e) {
                    int jj = 32 * a - 64 + 32 * kt + 16 * s + (e & 3) + 8 * (e >> 2) + 4 * hi; jj = jj < 0 ? 0 : (jj > L - 1 ? L - 1 : jj);
                    vrow[e] = QKV + (size_t)((jj << sh) + c) * 3072 + 2048 + head * 64 + r32;
                }
#pragma unroll
                for (int dt = 0; dt < 2; ++dt) {
                    bf16x8 vf;
#pragma unroll
                    for (int e = 0; e < 8; ++e) vf[e] = (short)vrow[e][32 * dt];
                    o[dt] = __builtin_amdgcn_mfma_f32_32x32x16_bf16(vf, pf, o[dt], 0, 0, 0);
                }
            }
        float* op = OACC + (size_t)tq * 1024 + head * 64 + 4 * hi;
#pragma unroll
        for (int dt = 0; dt < 2; ++dt)
#pragma unroll
            for (int i = 0; i < 4; ++i) {
                f32x4 old = (f32x4){0.f, 0.f, 0.f, 0.f};
                if (g != 0) old = *(const f32x4*)(op + 32 * dt + 8 * i);
                const f32x4 nw4 = (f32x4){o[dt][4 * i], o[dt][4 * i + 1], o[dt][4 * i + 2], o[dt][4 * i + 3]};
                *(f32x4*)(op + 32 * dt + 8 * i) = old * f + nw4;
            }
        if (hi == 0) { ML[((size_t)tq * 16 + head) * 2] = m_new; ML[((size_t)tq * 16 + head) * 2 + 1] = l_new; }
    }
}
DEV void gate_naive(const bf16_t* BR, const float* OACC, const float* ML, const bf16_t* TAIL, int ldt, const float* MKV, bf16_t* YIN) {
    const size_t total = (size_t)S_ * 1024;
    for (size_t idx = GTID; idx < total; idx += GSZ) {
        const int c = (int)(idx & 1023), t = (int)(idx >> 10);
        const float br = OACC ? OACC[idx] / ML[((size_t)t * 16 + (c >> 6)) * 2 + 1] : bf2f(BR[idx]);
        const float gt = bf2f(TAIL[(size_t)t * ldt + c]);
        YIN[(size_t)t * 1280 + c] = f2bf(br * silu(gt));
    }
    const size_t total2 = (size_t)4 * S_;
    for (size_t idx = GTID; idx < total2; idx += GSZ) {
        const int mh = (int)(idx >> 14), t = (int)(idx & 16383);
        float q[64], o[64]; float m = -1e30f, l = 0.f;
#pragma unroll
        for (int c = 0; c < 8; ++c) load8(TAIL + (size_t)t * ldt + 1280 + mh * 64 + c * 8, q + c * 8);
#pragma unroll
        for (int d = 0; d < 64; ++d) { q[d] *= C2; o[d] = 0.f; }
        for (int mm = 0; mm < 256; ++mm) {
            const float* kp = MKV + (size_t)mm * 512 + mh * 64;
            float s = 0.f;
#pragma unroll
            for (int d = 0; d < 64; ++d) s += q[d] * kp[d];
            if (s > m) { const float f = exp2f(m - s); l *= f;
#pragma unroll
                for (int d = 0; d < 64; ++d) o[d] *= f;
                m = s; }
            const float p = exp2f(s - m); l += p;
#pragma unroll
            for (int d = 0; d < 64; ++d) o[d] += p * kp[256 + d];
        }
        const float rl = 1.f / l;
#pragma unroll
        for (int c = 0; c < 8; ++c) { float gt[8]; load8(TAIL + (size_t)t * ldt + 1024 + mh * 64 + c * 8, gt);
#pragma unroll
            for (int j = 0; j < 8; ++j) o[c * 8 + j] = o[c * 8 + j] * rl * silu(gt[j]); }
#pragma unroll
        for (int c = 0; c < 8; ++c) store8(YIN + (size_t)t * 1280 + 1024 + mh * 64 + c * 8, o + c * 8);
    }
}


#define LAS3 __attribute__((address_space(3)))
DEV void gemm_bf16(unsigned char* lds_raw, const bf16_t* A, int lda, const bf16_t* Bt, int M, int N, int K, bf16_t* C, int ldc, int G, int c) {
    pg8::Gemm g{A, Bt, M, N, K, lda}; pg8::StaticOrder So; So.init(M, N, G, c);
    pg8::EpiBf16<0> E{C, ldc, nullptr, 0, 0, 1.f};
    pg8::gemm_phase<pg8::EpiBf16<0>, pg8::StaticOrder, PG8_ALIGN, PG8_SP2>((LAS3 unsigned char*)lds_raw, g, So, E);
}
DEV void gemm_f32(unsigned char* lds_raw, const bf16_t* A, int lda, const bf16_t* Bt, int M, int N, int K, float* C, int ldc, int G, int c) {
    pg8::Gemm g{A, Bt, M, N, K, lda}; pg8::StaticOrder So; So.init(M, N, G, c);
    pg8::EpiF32 E{C, ldc};
    pg8::gemm_phase<pg8::EpiF32, pg8::StaticOrder, PG8_ALIGN, PG8_SP2>((LAS3 unsigned char*)lds_raw, g, So, E);
}
#define STEP_BEGIN { unsigned char* ws = p.ws; asm volatile("" : "+s"(ws)); float* H = p.out; float* lds = (float*)lds_raw;
#define STEP_END   } grid.sync();
#define AR(off) (ws + WS_AR + (size_t)(off) * MiB)
#define P_WtA ((bf16_t*)(ws + WS_WA))
#define P_WtB ((bf16_t*)(ws + WS_WB))
#define P_WtC ((bf16_t*)(ws + WS_WC))
#define P_WtO ((bf16_t*)(ws + WS_WO))
#define P_Wdft ((bf16_t*)(ws + WS_WDFT))
#define P_MKV ((float*)(ws + WS_MKV))
#define P_XN ((bf16_t*)(ws + WS_XN))
#define GC (int)gridDim.x, (int)blockIdx.x
#define LNG (p.ln_g + LAYER * 1024)
#define LNB (p.ln_b + LAYER * 1024)
#define WO (P_WtO + (size_t)LAYER * 1024 * 1280)

template <int LAYER> DEV void layer_A(const Params& p, cg::grid_group& grid, unsigned char* lds_raw) {
    STEP_BEGIN
        gemm_bf16(lds_raw, P_XN, 1024, P_WtA + (size_t)(LAYER / 3) * 1536 * 1024, S_, 1536, 1024, (bf16_t*)AR(0), 1536, GC);
        if ((gridDim.x & 3) == 0) { const int g = blockIdx.x & 3; gemm_bf16(lds_raw, P_XN + g * 256, 1024, P_Wdft, S_, 512, 256, (bf16_t*)AR(48) + g * 512, 2048, (int)gridDim.x >> 2, (int)blockIdx.x >> 2); }
        else for (int g = 0; g < 4; ++g) gemm_bf16(lds_raw, P_XN + g * 256, 1024, P_Wdft, S_, 512, 256, (bf16_t*)AR(48) + g * 512, 2048, GC);
    STEP_END
    STEP_BEGIN fft_s1_mfma((bf16_t*)AR(48), (bf16_t*)AR(112), lds_raw); STEP_END
    STEP_BEGIN fft_s2_mfma((bf16_t*)AR(112), (bf16_t*)AR(48), lds_raw); STEP_END
    STEP_BEGIN gate_naive((bf16_t*)AR(48), nullptr, nullptr, (bf16_t*)AR(0), 1536, P_MKV, (bf16_t*)AR(80)); STEP_END
    STEP_BEGIN gemm_f32(lds_raw, (bf16_t*)AR(80), 1280, WO, S_, 1024, 1280, (float*)AR(0), 1024, GC); STEP_END
    STEP_BEGIN ln_rows(H, (float*)AR(0), ALPHA, LNG, LNB, H, P_XN); STEP_END
}
template <int LAYER> DEV void layer_B(const Params& p, cg::grid_group& grid, unsigned char* lds_raw) {
    STEP_BEGIN gemm_bf16(lds_raw, P_XN, 1024, P_WtB, S_, 3072, 1024, (bf16_t*)AR(0), 3072, GC); STEP_END
    STEP_BEGIN qk_post((bf16_t*)AR(0), p.q_norm_g, p.k_norm_g); STEP_END
    STEP_BEGIN
        bf16_t* PROJ = (bf16_t*)AR(0); bf16_t* BR = (bf16_t*)AR(96);
        if (gridDim.x == 256) {
            const attn_body::AttnTensors AT{(const attn_body::bf16*)PROJ, (const attn_body::bf16*)(PROJ + 1024), (const attn_body::bf16*)(PROJ + 1280), (attn_body::bf16*)BR};
            const attn_body::StaticOrder SA((int)gridDim.x, (int)blockIdx.x);
            attn_body::attn_phase<attn_body::StaticOrder>((char*)lds_raw, AT, SA);
        } else attn_naive(PROJ, BR, lds);
    STEP_END
    STEP_BEGIN gate_naive((bf16_t*)AR(96), nullptr, nullptr, (bf16_t*)AR(0) + 1536, 3072, P_MKV, (bf16_t*)AR(128)); STEP_END
    STEP_BEGIN gemm_f32(lds_raw, (bf16_t*)AR(128), 1280, WO, S_, 1024, 1280, (float*)AR(0), 1024, GC); STEP_END
    STEP_BEGIN ln_rows(H, (float*)AR(0), ALPHA, LNG, LNB, H, P_XN); STEP_END
}
template <int LAYER> DEV void layer_C(const Params& p, cg::grid_group& grid, unsigned char* lds_raw) {
    for (int g = 0; g < 3; ++g) {
        STEP_BEGIN
            gemm_bf16(lds_raw, P_XN, 1024, P_WtC + (size_t)g * 3072 * 1024, S_, 3072, 1024, (bf16_t*)AR(0), 3072, GC);
            if (g == 0) make_rope1d((float*)AR(164));
        STEP_END
        STEP_BEGIN rope_c((bf16_t*)AR(0), (float*)AR(164)); STEP_END
        STEP_BEGIN dil_mfma((bf16_t*)AR(0), (float*)AR(96), (float*)AR(160), g); STEP_END
    }
    STEP_BEGIN gemm_bf16(lds_raw, P_XN, 1024, P_WtC + (size_t)9216 * 1024, S_, 1536, 1024, (bf16_t*)AR(0), 1536, GC); STEP_END
    STEP_BEGIN gate_naive(nullptr, (float*)AR(96), (float*)AR(160), (bf16_t*)AR(0), 1536, P_MKV, (bf16_t*)AR(48)); STEP_END
    STEP_BEGIN gemm_f32(lds_raw, (bf16_t*)AR(48), 1280, WO, S_, 1024, 1280, (float*)AR(96), 1024, GC); STEP_END
    STEP_BEGIN ln_rows(H, (float*)AR(96), ALPHA, LNG, LNB, H, P_XN); STEP_END
}

__global__ void __launch_bounds__(NTHREADS, 2) mk(Params p) {
    extern __shared__ __attribute__((aligned(16))) unsigned char lds_raw[];
    cg::grid_group grid = cg::this_grid();
    STEP_BEGIN
        tconv(p.w_in_a, 1024, 1536, 1536, P_WtA, 0);
        tconv(p.w_in_a + (size_t)1024 * 1536, 1024, 1536, 1536, P_WtA + (size_t)1536 * 1024, 0);
        tconv(p.w_in_b, 1024, 3072, 3072, P_WtB, 0);
        tconv(p.w_in_c, 1024, 10752, 10752, P_WtC, 1);
        for (int i = 0; i < 4; ++i) tconv(p.w_out + (size_t)i * 1280 * 1024, 1280, 1024, 1024, P_WtO + (size_t)i * 1024 * 1280, 0);
        make_wdft(P_Wdft);
        make_mkv(p.mem, p.w_mem_kv, P_MKV);
        ln_rows(p.x, nullptr, 1.f, p.ln_in_g, p.ln_in_b, H, P_XN);
    STEP_END
    layer_A<0>(p, grid, lds_raw);
    layer_B<1>(p, grid, lds_raw);
    layer_C<2>(p, grid, lds_raw);
    layer_A<3>(p, grid, lds_raw);
}

extern "C" void kernel_launch(void* const* d_in, const int* in_sizes, int n_in, void* d_out, int out_size, void* d_ws, size_t ws_size, hipStream_t stream) {
    if (n_in != 13 || ws_size < 256 * MiB) { fprintf(stderr, "kernel_launch: unexpected inputs (n_in %d, ws %zu)\n", n_in, ws_size); return; }
    Params p{};
    p.x = (const float*)d_in[0]; p.mem = (const float*)d_in[1]; p.ln_in_g = (const float*)d_in[2]; p.ln_in_b = (const float*)d_in[3];
    p.w_mem_kv = (const float*)d_in[4]; p.w_in_a = (const float*)d_in[5]; p.w_in_b = (const float*)d_in[6]; p.q_norm_g = (const float*)d_in[7];
    p.k_norm_g = (const float*)d_in[8]; p.w_in_c = (const float*)d_in[9]; p.w_out = (const float*)d_in[10]; p.ln_g = (const float*)d_in[11]; p.ln_b = (const float*)d_in[12];
    p.out = (float*)d_out; p.ws = (unsigned char*)d_ws;
    static int grid_blocks = 0;
    if (!grid_blocks) {
        int dev = 0, cus = 0, per_cu = 0;
        hipGetDevice(&dev);
        hipDeviceGetAttribute(&cus, hipDeviceAttributeMultiprocessorCount, dev);
        hipFuncSetAttribute((const void*)mk, hipFuncAttributeMaxDynamicSharedMemorySize, LDS_BYTES);
        hipOccupancyMaxActiveBlocksPerMultiprocessor(&per_cu, (const void*)mk, NTHREADS, LDS_BYTES);
        if (per_cu < 1) per_cu = 1;
        grid_blocks = cus * per_cu;
    }
    p.s0 = 0; p.s1 = NSTEPS;
    void* args[] = {&p};
    hipError_t e = hipLaunchCooperativeKernel((const void*)mk, dim3(grid_blocks), dim3(NTHREADS), args, LDS_BYTES, stream);
    if (e != hipSuccess) fprintf(stderr, "cooperative launch failed: %s (grid %d)\n", hipGetErrorString(e), grid_blocks);
}
```

```cpp
#include <hip/hip_runtime.h>
#include <hip/hip_cooperative_groups.h>
#include <cstdio>
#include <cstdint>
namespace cg = cooperative_groups;

#define DEV __device__ __forceinline__
typedef unsigned short bf16_t;
typedef short bf16x8 __attribute__((ext_vector_type(8)));
typedef float f32x4 __attribute__((ext_vector_type(4)));
typedef unsigned u32x4 __attribute__((ext_vector_type(4)));
typedef unsigned u32x2 __attribute__((ext_vector_type(2)));

constexpr int S_ = 16384, DM = 1024;
constexpr float ALPHA = 1.681792830507429f;
constexpr float C2 = 0.125f * 1.4426950408889634f;
constexpr float LN_EPS = 1e-5f;
constexpr size_t MiB = 1u << 20;
constexpr size_t WS_WA = 2 * MiB, WS_WB = 8 * MiB, WS_WC = 14 * MiB, WS_WO = 35 * MiB, WS_WDFT = 45 * MiB, WS_MKV = 45 * MiB + 512 * 1024;
constexpr size_t WS_XN = 48 * MiB, WS_AR = 80 * MiB;
constexpr int NTHREADS = 512;
constexpr int NSTEPS = 32;
constexpr int LDS_BYTES = 147456;


namespace pg8 {
#define PG8_LAS __attribute__((address_space(3)))
typedef unsigned short bf16_t;
typedef short bf16x8 __attribute__((ext_vector_type(8)));
typedef float f32x4 __attribute__((ext_vector_type(4)));
typedef unsigned u32x4 __attribute__((ext_vector_type(4)));
constexpr int BM = 256, BK = 64, HALF = 128, HTB = HALF * BK * 2  , STAGE_BYTES = 8 * HTB, NXCD = 8, WGM = 8;

__host__ __device__ __forceinline__ int lds_byte(int r, int c) { const int st = (r >> 4) * 2 + (c >> 5), rr = r & 15, cc = c & 31, ob = rr * 64 + cc * 2; return st * 1024 + (ob ^ (((ob >> 9) & 1) << 5)); }
__host__ __device__ __forceinline__ void stage_rc(int b, int& R, int& C) { const int st = b / 1024, sb = b % 1024, swz = sb ^ (((sb >> 9) & 1) << 5); R = (st >> 1) * 16 + swz / 64; C = (st & 1) * 32 + (swz % 64) / 2; }
__host__ __device__ __forceinline__ int perm32(int rho) { const int n = rho >> 4, i = rho & 15; return 8 * (i >> 2) + 4 * n + (i & 3); }

struct Unit { int pm, pn; };
struct Gemm { const bf16_t* A; const bf16_t* Bt; int M, N, K, lda; };

struct StaticOrder {
    int nM, nN, nwg, G, c;
    __host__ __device__ void init(int M, int N, int G_, int c_) { nM = M / BM; nN = N / BM; nwg = nM * nN; G = G_; c = c_; }
    __host__ __device__ bool next(int i, Unit& u) const {
        const long L = (long)i * G + c; if (L >= nwg) return false;
        int wgid = (int)L; { const int q = nwg / NXCD, r = nwg % NXCD, xcd = wgid % NXCD, off = wgid / NXCD; wgid = (xcd < r ? xcd * (q + 1) : r * (q + 1) + (xcd - r) * q) + off; }
        const int nig = WGM * nN, gid = wgid / nig, fm = gid * WGM, gsz = (nM - fm) < WGM ? (nM - fm) : WGM;
        u.pm = fm + ((wgid % nig) % gsz); u.pn = (wgid % nig) / gsz; return true;
    }
    __device__ __forceinline__ void a_ready(const Unit&) const {}
    __device__ __forceinline__ void done(const Unit&) const {}
};

__device__ __forceinline__ unsigned cvt_pk_bf16(float lo, float hi) { unsigned r; asm volatile("v_cvt_pk_bf16_f32 %0, %1, %2" : "=v"(r) : "v"(lo), "v"(hi)); return r; }
typedef float f32x2 __attribute__((ext_vector_type(2)));
__device__ __forceinline__ f32x2 gelu_pk(f32x2 v) {
    const f32x2 av = __builtin_elementwise_abs(v), d = av * 0.2316418882f + 1.0f;
    f32x2 t; t.x = __builtin_amdgcn_rcpf(d.x); t.y = __builtin_amdgcn_rcpf(d.y);
    f32x2 q = t * 0.5307027145f + (-0.7265760135f); q = q * t + 0.7107068705f; q = q * t + (-0.142248368f); q = q * t + 0.127414796f; q = q * t;
    const f32x2 s = (v * v) * (-0.72134752044f);
    f32x2 e; e.x = __builtin_amdgcn_exp2f(s.x); e.y = __builtin_amdgcn_exp2f(s.y);
    const f32x2 m = v * (q * e), r = v - m;
    f32x2 o; o.x = v.x < 0.f ? m.x : r.x; o.y = v.y < 0.f ? m.y : r.y; return o;
}

template <int ACT  > struct EpiBf16 {
    static constexpr bool PERM = true, AFTER_DRAIN = false; static_assert(ACT == 0 || ACT == 1, "EpiBf16: ACT is 0 (none) or 1 (gelu_pk)");
    bf16_t* O; int ldc; const float* bias; int split_cols; size_t split_stride; float scale0;
    __device__ __forceinline__ void operator()(const f32x4 (&acc)[2][2][4][2], const Unit& u, int wr, int wc, int fr, int fq) const {
        const int row0 = u.pm * BM + wr * 64 + fr; int colt = u.pn * BM; bf16_t* base = O;
        float sc = 1.f; if (split_cols) { const int t = colt / split_cols; base += (size_t)t * split_stride; colt -= t * split_cols; if (t == 0) sc = scale0; }
        const int col0 = colt + wc * 32 + 8 * fq, bcol0 = u.pn * BM + wc * 32 + 8 * fq;
        f32x4 bv[2][2];
#pragma unroll
        for (int bj = 0; bj < 2; ++bj)
#pragma unroll
            for (int n = 0; n < 2; ++n) bv[bj][n] = bias ? *(const f32x4*)(bias + bcol0 + bj * HALF + 4 * n) : (f32x4){0.f, 0.f, 0.f, 0.f};
#pragma unroll
        for (int ai = 0; ai < 2; ++ai)
#pragma unroll
            for (int m = 0; m < 4; ++m) { bf16_t* rowp = base + (size_t)(row0 + ai * HALF + m * 16) * ldc + col0;
#pragma unroll
                for (int bj = 0; bj < 2; ++bj) { f32x4 v0 = acc[ai][bj][m][0] + bv[bj][0], v1 = acc[ai][bj][m][1] + bv[bj][1];
                    if (ACT == 1) { f32x2 a = gelu_pk((f32x2){v0[0], v0[1]}), b = gelu_pk((f32x2){v0[2], v0[3]}), c = gelu_pk((f32x2){v1[0], v1[1]}), d = gelu_pk((f32x2){v1[2], v1[3]});
                        v0 = (f32x4){a.x, a.y, b.x, b.y}; v1 = (f32x4){c.x, c.y, d.x, d.y}; }
                    v0 = v0 * sc; v1 = v1 * sc; u32x4 w; w.x = cvt_pk_bf16(v0[0], v0[1]); w.y = cvt_pk_bf16(v0[2], v0[3]); w.z = cvt_pk_bf16(v1[0], v1[1]); w.w = cvt_pk_bf16(v1[2], v1[3]);
                    *(u32x4*)(rowp + bj * HALF) = w; } }
    }
};

struct EpiF32 {
    static constexpr bool PERM = false, AFTER_DRAIN = false;
    float* O; int ldc;
    __device__ __forceinline__ void operator()(const f32x4 (&acc)[2][2][4][2], const Unit& u, int wr, int wc, int fr, int fq) const {
        const int row0 = u.pm * BM + wr * 64 + fr, col0 = u.pn * BM + wc * 32 + 4 * fq;
#pragma unroll
        for (int ai = 0; ai < 2; ++ai)
#pragma unroll
            for (int m = 0; m < 4; ++m) { float* rowp = O + (size_t)(row0 + ai * HALF + m * 16) * ldc + col0;
#pragma unroll
                for (int bj = 0; bj < 2; ++bj)
#pragma unroll
                    for (int n = 0; n < 2; ++n) *(f32x4*)(rowp + bj * HALF + n * 16) = acc[ai][bj][m][n]; }
    }
};
template <class Epi, class Sched, bool ALIGN_EPI = false, bool SP2 = false>
__device__ __forceinline__ void gemm_phase(PG8_LAS unsigned char* lds, const Gemm g, const Sched& S, const Epi& E) {
    int tid_ = threadIdx.x; asm volatile("" : "+v"(tid_)); const int tid = tid_, wid = __builtin_amdgcn_readfirstlane(tid >> 6), lane = tid & 63, wr = wid >> 2, wc = wid & 3, fr = lane & 15, fq = lane >> 4;
    const int K = g.K, nt = K / BK;
    unsigned voffA[2], voffB[2];
#pragma unroll
    for (int i = 0; i < 2; ++i) { int R, C; stage_rc(tid * 16 + i * 8192, R, C); const int Rb = Epi::PERM ? ((R & ~31) + perm32(R & 31)) : R;
        voffA[i] = (unsigned)(R * g.lda + C) * 2u; voffB[i] = (unsigned)(Rb * K + C) * 2u; }
    const size_t kstep = (size_t)(BK * 2);
    const size_t hstepB = (size_t)HALF * K * 2, hstepA = (size_t)HALF * g.lda * 2;
    const size_t tstepA = 2 * hstepA, tstepB = 2 * hstepB;
    const unsigned ldsw = (unsigned)wid * 1024u;
    const int aoff = lds_byte(wr * 64 + fr, fq * 8), boff = lds_byte(wc * 32 + fr, fq * 8);
#define PG8_SA(b, h) (((b) * 2 + (h)) * HTB)
#define PG8_SB(b, h) ((4 + (b) * 2 + (h)) * HTB)
#define PG8_STAGE(bufoff, gbase, voff) do { _Pragma("unroll") for (int _i = 0; _i < 2; ++_i) \
        __builtin_amdgcn_global_load_lds((const unsigned*)((const char*)(gbase) + (voff)[_i]), (PG8_LAS unsigned*)(lds + (bufoff) + ldsw + _i * 8192), 16, 0, 0); } while (0)
#define PG8_LDA(dst, b, h) do { _Pragma("unroll") for (int m = 0; m < 4; ++m) _Pragma("unroll") for (int k = 0; k < 2; ++k) dst[m][k] = *(const PG8_LAS bf16x8*)(lds + PG8_SA(b, h) + aoff + m * 2048 + k * 1024); } while (0)
#define PG8_LDB(dst, b, h) do { _Pragma("unroll") for (int n = 0; n < 2; ++n) _Pragma("unroll") for (int k = 0; k < 2; ++k) dst[n][k] = *(const PG8_LAS bf16x8*)(lds + PG8_SB(b, h) + boff + n * 2048 + k * 1024); } while (0)
#define PG8_MMA(ai, bj, At, Bt) do { __builtin_amdgcn_s_setprio(1); _Pragma("unroll") for (int m = 0; m < 4; ++m) _Pragma("unroll") for (int n = 0; n < 2; ++n) _Pragma("unroll") for (int k = 0; k < 2; ++k) \
        acc[ai][bj][m][n] = __builtin_amdgcn_mfma_f32_16x16x32_bf16(Bt[n][k], At[m][k], acc[ai][bj][m][n], 0, 0, 0); __builtin_amdgcn_s_setprio(0); } while (0)
#define PG8_WAIT_V(n) asm volatile("s_waitcnt vmcnt(" #n ")" ::: "memory")
#define PG8_WAIT_L(n) asm volatile("s_waitcnt lgkmcnt(" #n ")" ::: "memory")
#define PG8_BAR __builtin_amdgcn_s_barrier()
#define PG8_SCHED __builtin_amdgcn_sched_barrier(0)
    Unit cur, nxt; int ui = 0;
    if (!S.next(0, cur)) return;
    f32x4 acc[2][2][4][2];
#pragma unroll
    for (int a = 0; a < 2; ++a)
#pragma unroll
        for (int b = 0; b < 2; ++b)
#pragma unroll
            for (int m = 0; m < 4; ++m)
#pragma unroll
                for (int n = 0; n < 2; ++n) acc[a][b][m][n] = (f32x4){0.f, 0.f, 0.f, 0.f};
    bf16x8 At[4][2], B0[2][2], B1[2][2];
    const char* cA = (const char*)g.A + (size_t)cur.pm * tstepA; const char* cB = (const char*)g.Bt + (size_t)cur.pn * tstepB;
    S.a_ready(cur);
    if constexpr (SP2) {
        PG8_STAGE(PG8_SB(0, 0), cB, voffB); PG8_STAGE(PG8_SB(0, 1), cB + hstepB, voffB); PG8_STAGE(PG8_SA(0, 0), cA, voffA); PG8_STAGE(PG8_SA(0, 1), cA + hstepA, voffA);
        if (wr == 1) PG8_BAR;
        PG8_WAIT_V(2); PG8_BAR;
        PG8_STAGE(PG8_SB(1, 0), cB + kstep, voffB); PG8_STAGE(PG8_SA(1, 0), cA + kstep, voffA); PG8_STAGE(PG8_SB(1, 1), cB + hstepB + kstep, voffB);
        PG8_WAIT_V(6); PG8_BAR;
    } else {
        PG8_STAGE(PG8_SB(0, 0), cB, voffB); PG8_STAGE(PG8_SA(0, 0), cA, voffA); PG8_STAGE(PG8_SB(0, 1), cB + hstepB, voffB); PG8_STAGE(PG8_SA(0, 1), cA + hstepA, voffA);
        if (wr == 1) PG8_BAR;
        PG8_WAIT_V(4); PG8_BAR;
        PG8_STAGE(PG8_SB(1, 0), cB + kstep, voffB); PG8_STAGE(PG8_SA(1, 0), cA + kstep, voffA); PG8_STAGE(PG8_SB(1, 1), cB + hstepB + kstep, voffB);
        PG8_WAIT_V(6); PG8_BAR;
    }
    for (;;) {
        const bool has_next = S.next(ui + 1, nxt);
        const char* nA = has_next ? (const char*)g.A + (size_t)nxt.pm * tstepA : cA; const char* nB = has_next ? (const char*)g.Bt + (size_t)nxt.pn * tstepB : cB;
        for (int t = 0; t < nt; t += 2) {
            const bool last = (t == nt - 2);
            const char* a1 = cA + (size_t)(t + 1) * kstep;
            const char* a2 = last ? nA : cA + (size_t)(t + 2) * kstep; const char* b2 = last ? nB : cB + (size_t)(t + 2) * kstep;
            const char* a3 = a2 + kstep; const char* b3 = b2 + kstep;
            if (last && has_next) S.a_ready(nxt);
            if constexpr (SP2) {
            PG8_LDB(B0, 0, 0); PG8_LDB(B1, 0, 1); PG8_SCHED; PG8_LDA(At, 0, 0); PG8_STAGE(PG8_SA(1, 1), a1 + hstepA, voffA);
            PG8_WAIT_V(8); PG8_WAIT_L(0); PG8_BAR; PG8_MMA(0, 0, At, B0); PG8_MMA(0, 1, At, B1); PG8_BAR; PG8_SCHED;
            PG8_LDA(At, 0, 1); PG8_STAGE(PG8_SB(0, 0), b2, voffB); PG8_STAGE(PG8_SB(0, 1), b2 + hstepB, voffB); PG8_STAGE(PG8_SA(0, 0), a2, voffA);
            PG8_WAIT_V(8); PG8_WAIT_L(0); PG8_BAR; PG8_MMA(1, 0, At, B0); PG8_MMA(1, 1, At, B1); PG8_BAR; PG8_SCHED;
            PG8_LDB(B0, 1, 0); PG8_LDB(B1, 1, 1); PG8_SCHED; PG8_LDA(At, 1, 0); PG8_STAGE(PG8_SA(0, 1), a2 + hstepA, voffA);
            PG8_WAIT_V(8); PG8_WAIT_L(0); PG8_BAR; PG8_MMA(0, 0, At, B0); PG8_MMA(0, 1, At, B1); PG8_BAR; PG8_SCHED;
            PG8_LDA(At, 1, 1); PG8_STAGE(PG8_SB(1, 0), b3, voffB); PG8_STAGE(PG8_SB(1, 1), b3 + hstepB, voffB); PG8_STAGE(PG8_SA(1, 0), a3, voffA);
            PG8_WAIT_V(8); PG8_WAIT_L(0); PG8_BAR; PG8_MMA(1, 0, At, B0); PG8_MMA(1, 1, At, B1); PG8_BAR; PG8_SCHED;
            } else {
            PG8_LDB(B0, 0, 0); PG8_SCHED; PG8_LDA(At, 0, 0); PG8_STAGE(PG8_SA(1, 1), a1 + hstepA, voffA);
            PG8_WAIT_L(8); PG8_BAR; PG8_WAIT_L(0); PG8_MMA(0, 0, At, B0); PG8_BAR; PG8_SCHED;
            PG8_LDB(B1, 0, 1); PG8_STAGE(PG8_SB(0, 0), b2, voffB);
            PG8_BAR; PG8_WAIT_L(0); PG8_MMA(0, 1, At, B1); PG8_BAR;
            PG8_LDA(At, 0, 1); PG8_STAGE(PG8_SA(0, 0), a2, voffA);
            PG8_BAR; PG8_WAIT_L(0); PG8_MMA(1, 0, At, B0); PG8_BAR; PG8_SCHED;
            PG8_STAGE(PG8_SB(0, 1), b2 + hstepB, voffB);
            PG8_WAIT_V(6); PG8_BAR; PG8_MMA(1, 1, At, B1); PG8_BAR;
            PG8_LDB(B0, 1, 0); PG8_SCHED; PG8_LDA(At, 1, 0); PG8_STAGE(PG8_SA(0, 1), a2 + hstepA, voffA);
            PG8_WAIT_L(8); PG8_BAR; PG8_WAIT_L(0); PG8_MMA(0, 0, At, B0); PG8_BAR; PG8_SCHED;
            PG8_LDB(B1, 1, 1); PG8_STAGE(PG8_SB(1, 0), b3, voffB);
            PG8_BAR; PG8_WAIT_L(0); PG8_MMA(0, 1, At, B1); PG8_BAR;
            PG8_LDA(At, 1, 1); PG8_STAGE(PG8_SA(1, 0), a3, voffA);
            PG8_BAR; PG8_WAIT_L(0); PG8_MMA(1, 0, At, B0); PG8_BAR; PG8_SCHED;
            PG8_STAGE(PG8_SB(1, 1), b3 + hstepB, voffB);
            PG8_WAIT_V(6); PG8_BAR; PG8_MMA(1, 1, At, B1); PG8_BAR;
            }
        }
        if constexpr (ALIGN_EPI) { if (wr == 0) PG8_BAR; }
        if constexpr (!Epi::AFTER_DRAIN) { E(acc, cur, wr, wc, fr, fq); S.done(cur); }
        if (!has_next) break;
#pragma unroll
        for (int a = 0; a < 2; ++a)
#pragma unroll
            for (int b = 0; b < 2; ++b)
#pragma unroll
                for (int m = 0; m < 4; ++m)
#pragma unroll
                    for (int n = 0; n < 2; ++n) acc[a][b][m][n] = (f32x4){0.f, 0.f, 0.f, 0.f};
        cur = nxt; cA = nA; cB = nB; ++ui;
        if constexpr (ALIGN_EPI) { if (wr == 1) PG8_BAR; }
    }
    PG8_WAIT_V(0);
    if constexpr (!ALIGN_EPI) { if (wr == 0) PG8_BAR; }
    PG8_BAR;
    if constexpr (Epi::AFTER_DRAIN) { E.fused(acc, cur, wr, wc, fr, fq, lds, wid, lane); S.done(cur); }
#undef PG8_SA
#undef PG8_SB
#undef PG8_STAGE
#undef PG8_LDA
#undef PG8_LDB
#undef PG8_MMA
#undef PG8_WAIT_V
#undef PG8_WAIT_L
#undef PG8_BAR
#undef PG8_SCHED
}
}

#define PG8_SP2 true
#define PG8_ALIGN true
#include <hip/hip_bf16.h>
#include <cmath>
namespace attn_body {
using bf16=__hip_bfloat16;
using bf16x8=__attribute__((ext_vector_type(8)))short;
using s16x4=__attribute__((ext_vector_type(4)))short;
using f32x16=__attribute__((ext_vector_type(16)))float;
using u32x4=__attribute__((ext_vector_type(4)))unsigned;
constexpr int BATCH=1,NHEAD=16,SEQ=16384,D=64,DM=NHEAD*D,QP=3072,KP=3072,OP=1024;
constexpr int NW=8,QBLK=32,QB=QBLK*NW,KVBLK=64,NQB=SEQ/QB;
constexpr int ATTN_PITCH=DM, ATTN_UNIT_ROWS=QB;
__device__ __forceinline__ int crow(int r,int hi){return (r&3)+8*(r>>2)+4*hi;}
#define SBAR() __builtin_amdgcn_sched_barrier(0)
__device__ __forceinline__ void cmask(f32x16&p0,f32x16&p1,int jb,int qrel,int hi){
  const float NEG=-INFINITY; int kb=64*jb+4*hi;
  #pragma unroll
  for(int r=0;r<16;++r){int kv=kb+(r&3)+8*(r>>2); if(kv>qrel)p0[r]=NEG; if(kv+32>qrel)p1[r]=NEG;}
}

constexpr int NSLOT=3, SLOTB=8192;
constexpr int LDS_K=0, LDS_V=NSLOT*SLOTB, LDS_WS=2*NSLOT*SLOTB, LDS_OST=LDS_WS+NW*64*4, LDS_BYTES=LDS_OST+NW*4096;
constexpr float C2=0.125f*1.4426950408889634f;
__device__ __forceinline__ void glds16(const void*gsrc,unsigned lds_dst){unsigned keep;
  asm volatile("s_mov_b32 %0, m0\n\ts_mov_b32 m0, %2\n\ts_nop 0\n\tglobal_load_lds_dwordx4 %1, off\n\ts_mov_b32 m0, %0":"=&s"(keep):"v"(gsrc),"s"(lds_dst):"memory");}
__device__ __forceinline__ float max3f(float a,float b,float c){float r;asm("v_max3_f32 %0, %1, %2, %3":"=v"(r):"v"(a),"v"(b),"v"(c));return r;}
__device__ __forceinline__ float max2f(float a,float b){float r;asm("v_max_f32_e32 %0, %1, %2":"=v"(r):"v"(a),"v"(b));return r;}
__device__ __forceinline__ float fadd_s(float a,float b){float r;asm("v_add_f32_e32 %0, %1, %2":"=v"(r):"v"(a),"v"(b));return r;}
__device__ __forceinline__ float fsub_s(float a,float b){float r;asm("v_sub_f32_e32 %0, %1, %2":"=v"(r):"v"(a),"v"(b));return r;}
typedef float f32x2_t __attribute__((ext_vector_type(2))); typedef __bf16 bf16x2_t __attribute__((ext_vector_type(2)));
__device__ __forceinline__ unsigned cvtpk_s(float lo,float hi){f32x2_t v={lo,hi};bf16x2_t b=__builtin_convertvector(v,bf16x2_t);return __builtin_bit_cast(unsigned,b);}
#define WAIT_BAR(N) asm volatile("s_waitcnt vmcnt(" #N ") lgkmcnt(0)\n\ts_barrier":::"memory")

__device__ __forceinline__ void qkt(f32x16&p0,f32x16&p1,const char*Kslot,const bf16x8*qr,const f32x16&negm,int r32,int hi){
  const char*kb=Kslot+hi*1024+r32*16;
  #pragma unroll
  for(int d0=0;d0<4;++d0){
    const bf16x8 b0=*reinterpret_cast<const bf16x8*>(kb+d0*2048);
    const bf16x8 b1=*reinterpret_cast<const bf16x8*>(kb+d0*2048+512);
    if(d0==0){p0=__builtin_amdgcn_mfma_f32_32x32x16_bf16(b0,qr[0],negm,0,0,0);p1=__builtin_amdgcn_mfma_f32_32x32x16_bf16(b1,qr[0],negm,0,0,0);}
    else{p0=__builtin_amdgcn_mfma_f32_32x32x16_bf16(b0,qr[d0],p0,0,0,0);p1=__builtin_amdgcn_mfma_f32_32x32x16_bf16(b1,qr[d0],p1,0,0,0);}}
}
typedef __attribute__((address_space(3))) const char* lds_cptr;
typedef short v4i16_t __attribute__((ext_vector_type(4)));
__device__ __forceinline__ void kload8(bf16x8*kf,lds_cptr kp){
  kf[0]=*(const __attribute__((address_space(3))) bf16x8*)(kp);      kf[1]=*(const __attribute__((address_space(3))) bf16x8*)(kp+512);
  kf[2]=*(const __attribute__((address_space(3))) bf16x8*)(kp+2048); kf[3]=*(const __attribute__((address_space(3))) bf16x8*)(kp+2560);
  kf[4]=*(const __attribute__((address_space(3))) bf16x8*)(kp+4096); kf[5]=*(const __attribute__((address_space(3))) bf16x8*)(kp+4608);
  kf[6]=*(const __attribute__((address_space(3))) bf16x8*)(kp+6144); kf[7]=*(const __attribute__((address_space(3))) bf16x8*)(kp+6656);
}
__device__ __forceinline__ void kload2(bf16x8*kf,lds_cptr kp,int j){ kf[2*j]=*(const __attribute__((address_space(3))) bf16x8*)(kp+j*2048); kf[2*j+1]=*(const __attribute__((address_space(3))) bf16x8*)(kp+j*2048+512); }
__device__ __forceinline__ s16x4 vtr(lds_cptr p){ return __builtin_bit_cast(s16x4,__builtin_amdgcn_ds_read_tr16_b64_v4i16((__attribute__((address_space(3))) v4i16_t*)p)); }
__device__ __forceinline__ float rowmax(const f32x16&p0,const f32x16&p1){
  float a=max3f(p0[0],p0[1],p1[0]),b=max3f(p0[2],p0[3],p1[1]);a=max3f(a,p1[2],p1[3]);
  #pragma unroll
  for(int r=4;r<16;r+=4){a=max3f(a,p0[r],p0[r+1]);b=max3f(b,p0[r+2],p0[r+3]);a=max3f(a,p1[r],p1[r+1]);b=max3f(b,p1[r+2],p1[r+3]);}
  const float m=max2f(a,b);
  auto rr=__builtin_amdgcn_permlane32_swap(__float_as_uint(m),__float_as_uint(m),false,false);
  return max2f(__uint_as_float(rr[0]),__uint_as_float(rr[1]));
}
__device__ __forceinline__ void pv(f32x16*o,int vb,bf16x8 pa0,bf16x8 pa1,bf16x8 pa2,bf16x8 pa3){
  #pragma unroll
  for(int d0=0;d0<2;++d0){s16x4 lo[4],hi[4];
    #pragma unroll
    for(int ks=0;ks<4;++ks){
      asm volatile("ds_read_b64_tr_b16 %0,%1 offset:%c2":"=&v"(lo[ks]):"v"(vb),"i"(d0*4096+ks*1024):"memory");
      asm volatile("ds_read_b64_tr_b16 %0,%1 offset:%c2":"=&v"(hi[ks]):"v"(vb),"i"(d0*4096+ks*1024+512):"memory");}
    asm volatile("s_waitcnt lgkmcnt(0)":::"memory");SBAR();
    #define PK(k) (bf16x8){lo[k][0],lo[k][1],lo[k][2],lo[k][3],hi[k][0],hi[k][1],hi[k][2],hi[k][3]}
    o[d0]=__builtin_amdgcn_mfma_f32_32x32x16_bf16(pa0,PK(0),o[d0],0,0,0);
    o[d0]=__builtin_amdgcn_mfma_f32_32x32x16_bf16(pa1,PK(1),o[d0],0,0,0);
    o[d0]=__builtin_amdgcn_mfma_f32_32x32x16_bf16(pa2,PK(2),o[d0],0,0,0);
    o[d0]=__builtin_amdgcn_mfma_f32_32x32x16_bf16(pa3,PK(3),o[d0],0,0,0);
    #undef PK
  }
}

#ifndef ATTN_STORE16
#define ATTN_STORE16(p,v) (*(u32x4*)(p)=(v))
#endif
template<int THRL> __device__ __forceinline__ void attn_unit(int b,int h,int qb,const bf16*Q,const bf16*__restrict__ K,const bf16*__restrict__ V,bf16*O,char*shm){
  int tid_=threadIdx.x; asm volatile("":"+v"(tid_)); const int tid=tid_,lane=tid&63,r32=lane&31,hi=lane>>5; const int wid=__builtin_amdgcn_readfirstlane(tid>>6);
  const long rowbase=(long)b*SEQ; const int q0=qb*QB;
  const bf16*Qw=Q+(rowbase+q0+wid*QBLK)*QP+h*D;
  const int kvh=h>>2; const bf16*Kh=K+rowbase*KP+kvh*D,*Vh=V+rowbase*KP+kvh*D;
  const unsigned lds0=(unsigned)(uintptr_t)shm;
  float*wsf=(float*)(shm+LDS_WS)+wid*64;
  const bf16*ksrc=Kh+(long)lane*KP+wid*8;
  const bf16*vsrc=Vh+(long)(16*(wid&3)+(lane>>2))*KP+(wid>>2)*32+(lane&3)*8;
  const unsigned kdst=lds0+LDS_K+wid*1024, vdst=lds0+LDS_V+wid*1024;
  #define DMA_K(t,slot) glds16(ksrc+(long)(t)*KVBLK*KP,(unsigned)__builtin_amdgcn_readfirstlane(kdst+(slot)))
  #define DMA_V(t,slot) glds16(vsrc+(long)(t)*KVBLK*KP,(unsigned)__builtin_amdgcn_readfirstlane(vdst+(slot)))
  const int vb0=(int)(lds0+LDS_V)+((lane>>4)&1)*32+(lane&3)*8+(4*hi+((lane&15)>>2))*64;
  const char*Kbase=shm+LDS_K; bf16x8 kf[8];
  const lds_cptr shm3=(lds_cptr)shm; const lds_cptr kp0=shm3+LDS_K+hi*1024+r32*16; const lds_cptr vp0=shm3+LDS_V+((lane>>4)&1)*32+(lane&3)*8+(4*hi+((lane&15)>>2))*64;
  const int NT=SEQ/KVBLK;
  DMA_K(0,0);DMA_V(0,0);DMA_K(1,SLOTB);
  bf16x8 qr[4];
  #pragma unroll
  for(int d0=0;d0<4;++d0)qr[d0]=*reinterpret_cast<const bf16x8*>(&Qw[(long)r32*QP+d0*16+hi*8]);
  float mhat=0.f,l_reg=0.f;f32x16 o[2];o[0]=f32x16{};o[1]=f32x16{};f32x16 negm=f32x16{};asm volatile("":"+v"(negm));
  const int qrel=wid*QBLK+r32;
  #define CMASK(P0,P1,t) do{}while(0)
  bool resc=false;
  #define START(P0,P1) do{ const float rm=rowmax(P0,P1); resc=false; \
    { const float dl=rm; mhat=fadd_s(mhat,dl); \
      _Pragma("unroll") for(int r=0;r<16;++r){P0[r]=fsub_s(P0[r],dl);P1[r]=fsub_s(P1[r],dl);} \
      _Pragma("unroll") for(int r=0;r<16;++r)negm[r]=-mhat; asm volatile("":"+v"(negm)); } \
    _Pragma("unroll") for(int r=0;r<16;++r)P0[r]=__builtin_amdgcn_exp2f(P0[r]); }while(0)
  #define RESC() do{ if(resc){ asm volatile("s_waitcnt lgkmcnt(0)":::"memory"); \
      _Pragma("unroll") for(int d_=0;d_<2;++d_) _Pragma("unroll") for(int r=0;r<16;++r)o[d_][r]*=wsf[crow(r,hi)]; } }while(0)
  f32x16 pA0,pA1,pB0,pB1;
  int sl_prev=0,sl_cur=0,sl_next=SLOTB;
  #define ROT() do{sl_prev=sl_cur;sl_cur=sl_next;sl_next=(sl_next==(NSLOT-1)*SLOTB)?0:sl_next+SLOTB;}while(0)
  DMA_K(2,2*SLOTB);
  WAIT_BAR(3);
  qkt(pA0,pA1,Kbase,qr,negm,r32,hi);asm volatile("s_nop 15\n\ts_nop 7":"+v"(pA0),"+v"(pA1));CMASK(pA0,pA1,0);
  START(pA0,pA1);
  _Pragma("unroll") for(int r=0;r<16;++r)pA1[r]=__builtin_amdgcn_exp2f(pA1[r]);
  WAIT_BAR(0);
  DMA_K(3,0);DMA_V(1,SLOTB);
  ROT();
  kload8(kf,kp0+sl_cur);
  WAIT_BAR(2);
  s16x4 vlo[8],vhi[8]; u32x4 pw0,pw1,pw2,pw3;
  #define PKW(P,B) cvtpk_s(P[B],P[B+1])
  #define PAF(k) __builtin_bit_cast(bf16x8,pw##k)
  #define VFR(i) (bf16x8){vlo[i][0],vlo[i][1],vlo[i][2],vlo[i][3],vhi[i][0],vhi[i][1],vhi[i][2],vhi[i][3]}
  #define PIN(x) asm volatile("":"+v"(x))
  #define MX3(a,b,c) __builtin_fmaxf(__builtin_fmaxf((a),(b)),(c))
  #define GAPA(MF,A0,A1,A2,A3,W0,W1,PW) do{ MF; sacc+=A0; sacc+=A1; sacc+=A2; sacc+=A3; PIN(sacc); W0; W1; PIN(PW); SBAR(); }while(0)
  #define EX(v) __builtin_amdgcn_exp2f(v)
  #define GAPB(MF,X,B) do{ MF; X[B]=EX(X[B]); X[B+1]=EX(X[B+1]); X[B+2]=EX(X[B+2]); X[B+3]=EX(X[B+3]); PIN(X); SBAR(); }while(0)
  #define VRD(i) do{ vlo[i]=vtr(vp_+(((i)>>2)*4096+((i)&3)*1024)); vhi[i]=vtr(vp_+(((i)>>2)*4096+((i)&3)*1024+512)); }while(0)
  #define KRD(G,j) do{ if(G){ kload2(kf,kp0+sl_next,j); SBAR(); } }while(0)
  #define STEP(C0,C1,P0,P1,t,GK,GV,GL) do{ SBAR(); \
    const lds_cptr vp_=vp0+sl_prev; \
    VRD(0); SBAR(); float sacc=(P0[0]+P0[1]); \
    GAPA(C0=__builtin_amdgcn_mfma_f32_32x32x16_bf16(kf[0],qr[0],negm,0,0,0), P0[2],P0[3],P0[4],P0[5],     pw0[0]=PKW(P0,0), pw0[1]=PKW(P0,2), pw0); \
    VRD(4); SBAR(); GAPA(C1=__builtin_amdgcn_mfma_f32_32x32x16_bf16(kf[1],qr[0],negm,0,0,0), P0[6],P0[7],P0[8],P0[9],     pw0[2]=PKW(P0,4), pw0[3]=PKW(P0,6), pw0); \
    VRD(1); SBAR(); GAPA(C0=__builtin_amdgcn_mfma_f32_32x32x16_bf16(kf[2],qr[1],C0,0,0,0),   P0[10],P0[11],P0[12],P0[13], pw1[0]=PKW(P0,8), pw1[1]=PKW(P0,10), pw1); \
    VRD(5); SBAR(); GAPA(C1=__builtin_amdgcn_mfma_f32_32x32x16_bf16(kf[3],qr[1],C1,0,0,0),   P0[14],P0[15],P1[0],P1[1],   pw1[2]=PKW(P0,12),pw1[3]=PKW(P0,14), pw1); \
    VRD(2); SBAR(); GAPA(C0=__builtin_amdgcn_mfma_f32_32x32x16_bf16(kf[4],qr[2],C0,0,0,0),   P1[2],P1[3],P1[4],P1[5],     pw2[0]=PKW(P1,0), pw2[1]=PKW(P1,2), pw2); \
    VRD(6); SBAR(); GAPA(C1=__builtin_amdgcn_mfma_f32_32x32x16_bf16(kf[5],qr[2],C1,0,0,0),   P1[6],P1[7],P1[8],P1[9],     pw2[2]=PKW(P1,4), pw2[3]=PKW(P1,6), pw2); \
    VRD(3); SBAR(); GAPA(C0=__builtin_amdgcn_mfma_f32_32x32x16_bf16(kf[6],qr[3],C0,0,0,0),   P1[10],P1[11],P1[12],P1[13], pw3[0]=PKW(P1,8), pw3[1]=PKW(P1,10), pw3); \
    VRD(7); SBAR(); GAPA(C1=__builtin_amdgcn_mfma_f32_32x32x16_bf16(kf[7],qr[3],C1,0,0,0),   P1[14],P1[15],0.f,0.f,       pw3[2]=PKW(P1,12),pw3[3]=PKW(P1,14), pw3); \
    l_reg+=sacc; \
    if(GK){DMA_K((t)+3,sl_cur);} if(GV){DMA_V((t)+1,sl_next);} \
    CMASK(C0,C1,t); \
    { float a=MX3(C0[0],C0[1],C1[0]),b=MX3(C0[2],C0[3],C1[1]); a=MX3(a,C1[2],C1[3]); \
      _Pragma("unroll") for(int r=4;r<16;r+=4){a=MX3(a,C0[r],C0[r+1]);b=MX3(b,C0[r+2],C0[r+3]);a=MX3(a,C1[r],C1[r+1]);b=MX3(b,C1[r+2],C1[r+3]);} \
      float rm=__builtin_fmaxf(a,b); { auto rr=__builtin_amdgcn_permlane32_swap(__float_as_uint(rm),__float_as_uint(rm),false,false); rm=__builtin_fmaxf(__uint_as_float(rr[0]),__uint_as_float(rr[1])); } \
      resc=false; \
      if(__builtin_expect(__any(rm>(float)THRL),0)){ const float dl=__builtin_fmaxf(rm,0.f); mhat+=dl; \
        _Pragma("unroll") for(int r=0;r<16;++r){C0[r]-=dl;C1[r]-=dl;} \
        _Pragma("unroll") for(int r=0;r<16;++r)negm[r]=-mhat; asm volatile("":"+v"(negm)); \
        const float f=__builtin_amdgcn_exp2f(-dl); l_reg*=f; if(hi==0)wsf[r32]=f; resc=true; } } \
    SBAR(); \
    GAPB(o[0]=__builtin_amdgcn_mfma_f32_32x32x16_bf16(PAF(0),VFR(0),o[0],0,0,0), C0,0); \
    GAPB(o[1]=__builtin_amdgcn_mfma_f32_32x32x16_bf16(PAF(0),VFR(4),o[1],0,0,0), C0,4); \
    KRD(GL,0); GAPB(o[0]=__builtin_amdgcn_mfma_f32_32x32x16_bf16(PAF(1),VFR(1),o[0],0,0,0), C0,8); \
    KRD(GL,1); GAPB(o[1]=__builtin_amdgcn_mfma_f32_32x32x16_bf16(PAF(1),VFR(5),o[1],0,0,0), C0,12); \
    KRD(GL,2); GAPB(o[0]=__builtin_amdgcn_mfma_f32_32x32x16_bf16(PAF(2),VFR(2),o[0],0,0,0), C1,0); \
    KRD(GL,3); GAPB(o[1]=__builtin_amdgcn_mfma_f32_32x32x16_bf16(PAF(2),VFR(6),o[1],0,0,0), C1,4); \
    GAPB(o[0]=__builtin_amdgcn_mfma_f32_32x32x16_bf16(PAF(3),VFR(3),o[0],0,0,0), C1,8); \
    GAPB(o[1]=__builtin_amdgcn_mfma_f32_32x32x16_bf16(PAF(3),VFR(7),o[1],0,0,0), C1,12); \
    }while(0)
  int t=1;
  #undef CMASK
  #define CMASK(P0,P1,t) do{}while(0)
  for(;t+5<NT;t+=2){
    STEP(pB0,pB1,pA0,pA1,t,true,true,true);     WAIT_BAR(2); RESC(); ROT();
    STEP(pA0,pA1,pB0,pB1,t+1,true,true,true);   WAIT_BAR(2); RESC(); ROT();
  }
  #undef CMASK
  #define CMASK(P0,P1,t) do{}while(0)
  #define ENDW(tt) do{ if((tt)+3<NT){WAIT_BAR(2);} else if((tt)+2<NT){WAIT_BAR(1);} else {WAIT_BAR(0);} }while(0)
  for(;t+1<NT;t+=2){
    STEP(pB0,pB1,pA0,pA1,t,(t+3<NT),(t+1<NT),(t+1<NT));       ENDW(t);   RESC(); ROT();
    STEP(pA0,pA1,pB0,pB1,t+1,(t+4<NT),(t+2<NT),(t+2<NT));     ENDW(t+1); RESC(); ROT();
  }
  STEP(pB0,pB1,pA0,pA1,NT-1,false,false,false); RESC();
  { float sacc=pB0[0]+pB0[1]; _Pragma("unroll") for(int r=2;r<16;++r)sacc+=pB0[r]; _Pragma("unroll") for(int r=0;r<16;++r)sacc+=pB1[r]; l_reg+=sacc;
    pw0=(u32x4){PKW(pB0,0),PKW(pB0,2),PKW(pB0,4),PKW(pB0,6)};pw1=(u32x4){PKW(pB0,8),PKW(pB0,10),PKW(pB0,12),PKW(pB0,14)};pw2=(u32x4){PKW(pB1,0),PKW(pB1,2),PKW(pB1,4),PKW(pB1,6)};pw3=(u32x4){PKW(pB1,8),PKW(pB1,10),PKW(pB1,12),PKW(pB1,14)};
    SBAR(); pv(o,vb0+sl_cur,PAF(0),PAF(1),PAF(2),PAF(3)); }
  #undef PKW
  #undef PAF
  #undef VFR
  #undef PIN
  #undef MX3
  #undef GAPA
  #undef GAPB
  #undef EX
  #undef VRD
  #undef KRD
  #undef STEP
  #undef ENDW
  {auto rr=__builtin_amdgcn_permlane32_swap(__float_as_uint(l_reg),__float_as_uint(l_reg),false,false);l_reg=__uint_as_float(rr[0])+__uint_as_float(rr[1]);}
  if(hi==0)wsf[32+r32]=l_reg;asm volatile("s_waitcnt lgkmcnt(0)":::"memory");
  float rli[16];
  #pragma unroll
  for(int r=0;r<16;++r)rli[r]=__builtin_amdgcn_rcpf(wsf[32+crow(r,hi)]);
  bf16*Ow=O+(rowbase+q0+wid*QBLK)*OP+h*D;
  { bf16*stg=(bf16*)(shm+LDS_OST)+wid*2048;
    #pragma unroll
    for(int r=0;r<16;++r){const int orow=crow(r,hi);
      #pragma unroll
      for(int d0=0;d0<2;++d0)stg[orow*64+d0*32+r32]=__float2bfloat16(o[d0][r]*rli[r]);}
    asm volatile("s_waitcnt lgkmcnt(0)":::"memory");
    #pragma unroll
    for(int i=0;i<4;++i){const int row=i*8+(lane>>3),ch=lane&7; const u32x4 v=*(const u32x4*)(stg+row*64+ch*8); ATTN_STORE16(Ow+(long)row*OP+ch*8,v);} }
  asm volatile("s_waitcnt lgkmcnt(0)\n\ts_barrier":::"memory");
  #undef DMA_K
  #undef DMA_V
  #undef CMASK
  #undef START
  #undef RESC
  #undef ROT
}
constexpr int ATTN_LDS_BYTES=LDS_BYTES;
struct AttnTensors { const bf16* Q; const bf16* K; const bf16* V; bf16* O; };
struct AttnUnit { int bh; int qb; };
struct StaticOrder {
  int vcu;
  __device__ __forceinline__ explicit StaticOrder(int grid,int block):vcu((block%8)*(grid/8)+block/8){}
  __device__ __forceinline__ bool next(int i,AttnUnit&u)const{ if(i>=4)return false; u.bh=vcu>>4; u.qb=(vcu&15)*4+i; return true; }
  __device__ __forceinline__ void a_ready(const AttnUnit&)const{}
  __device__ __forceinline__ void done(const AttnUnit&)const{}
};
template<class Sched,int THRL=8> __device__ __forceinline__ void attn_phase(char*lds,const AttnTensors&T,const Sched&S){
  AttnUnit u;
  for(int i=0;S.next(i,u);++i){ S.a_ready(u); attn_unit<THRL>(u.bh/NHEAD,u.bh%NHEAD,u.qb,T.Q,T.K,T.V,T.O,lds); S.done(u); }
}
#undef SBAR
#undef WAIT_BAR
}

struct Params {
    const float *x, *mem, *ln_in_g, *ln_in_b, *w_mem_kv, *w_in_a, *w_in_b, *q_norm_g, *k_norm_g, *w_in_c, *w_out, *ln_g, *ln_b;
    float* out; unsigned char* ws;
    int s0, s1;
};

DEV float bf2f(bf16_t b) { return __uint_as_float(((unsigned)b) << 16); }
DEV bf16_t f2bf(float f) { unsigned u = __float_as_uint(f); return (bf16_t)((u + 0x7fffu + ((u >> 16) & 1u)) >> 16); }
DEV unsigned pk2(float lo, float hi) { return (unsigned)f2bf(lo) | ((unsigned)f2bf(hi) << 16); }
DEV float wave_sum(float v) {
#pragma unroll
    for (int o = 1; o < 64; o <<= 1) v += __shfl_xor(v, o);
    return v;
}
DEV float silu(float x) { return x / (1.f + __expf(-x)); }
DEV void load8(const bf16_t* p, float* o) {
    u32x4 v = *(const u32x4*)p;
    o[0] = __uint_as_float(v.x << 16); o[1] = __uint_as_float(v.x & 0xffff0000u);
    o[2] = __uint_as_float(v.y << 16); o[3] = __uint_as_float(v.y & 0xffff0000u);
    o[4] = __uint_as_float(v.z << 16); o[5] = __uint_as_float(v.z & 0xffff0000u);
    o[6] = __uint_as_float(v.w << 16); o[7] = __uint_as_float(v.w & 0xffff0000u);
}
DEV void store8(bf16_t* p, const float* o) {
    u32x4 v; v.x = pk2(o[0], o[1]); v.y = pk2(o[2], o[3]); v.z = pk2(o[4], o[5]); v.w = pk2(o[6], o[7]);
    *(u32x4*)p = v;
}
DEV int ltid() { int t = threadIdx.x; asm volatile("" : "+v"(t)); return t; }
#define GTID ((size_t)blockIdx.x * blockDim.x + ltid())
#define GSZ ((size_t)gridDim.x * blockDim.x)

DEV void tconv(const float* src, int K, int Ntot, int ncols, bf16_t* dst, int mode) {
    const size_t total = (size_t)ncols * (K / 8);
    for (size_t idx = GTID; idx < total; idx += GSZ) {
        const int n = (int)(idx % ncols), kc = (int)(idx / ncols);
        int sc = n;
        if (mode == 1 && n < 9216) { const int g = n / 3072, rem = n % 3072, which = rem / 1024, r = rem % 1024; sc = which * 3072 + g * 1024 + r; }
        float v[8];
#pragma unroll
        for (int j = 0; j < 8; ++j) v[j] = src[(size_t)(kc * 8 + j) * Ntot + sc];
        store8(dst + (size_t)n * K + kc * 8, v);
    }
}
DEV void make_wdft(bf16_t* w) {
    for (size_t idx = GTID; idx < 512 * 256; idx += GSZ) {
        const int n = (int)(idx >> 8), c = (int)(idx & 255), which = n >> 8, l = n & 255;
        float s, co; sincospif((float)((l * c) & 255) / 128.f, &s, &co);
        w[idx] = f2bf(which == 0 ? co : -s);
    }
}
DEV void make_mkv(const float* mem, const float* w, float* mkv) {
    for (size_t idx = GTID; idx < 256 * 512; idx += GSZ) {
        const int m = (int)(idx >> 9), n = (int)(idx & 511);
        float a = 0.f;
        for (int k = 0; k < 1024; ++k) a += mem[m * 1024 + k] * w[(size_t)k * 512 + n];
        mkv[idx] = a;
    }
}
DEV void make_rope1d(float* tab) {
    for (size_t idx = GTID; idx < (size_t)S_ * 32; idx += GSZ) {
        const int t = (int)(idx >> 5), i = (int)(idx & 31);
        const float inv = powf(10000.f, -((float)(2 * i) / 64.f));
        const float a = (float)t * inv;
        tab[idx * 2] = cosf(a); tab[idx * 2 + 1] = sinf(a);
    }
}
DEV void ln_rows(const float* a, const float* y, float alpha, const float* g, const float* b, float* outH, bf16_t* outXN) {
    const int lane = ltid() & 63, wpb = blockDim.x >> 6;
    const int gw = blockIdx.x * wpb + (ltid() >> 6), nw = gridDim.x * wpb;
    for (int row = gw; row < S_; row += nw) {
        f32x4 v[4]; float s = 0.f;
#pragma unroll
        for (int j = 0; j < 4; ++j) {
            v[j] = *(const f32x4*)(a + (size_t)row * DM + j * 256 + lane * 4);
            if (y) { const f32x4 u = *(const f32x4*)(y + (size_t)row * DM + j * 256 + lane * 4); v[j] = v[j] * alpha + u; }
            s += (v[j].x + v[j].y) + (v[j].z + v[j].w);
        }
        const float mean = wave_sum(s) * (1.f / DM); float s2 = 0.f;
#pragma unroll
        for (int j = 0; j < 4; ++j) { v[j] = v[j] - mean; s2 += (v[j].x * v[j].x + v[j].y * v[j].y) + (v[j].z * v[j].z + v[j].w * v[j].w); }
        const float rstd = 1.f / sqrtf(wave_sum(s2) * (1.f / DM) + LN_EPS);
#pragma unroll
        for (int j = 0; j < 4; ++j) {
            const f32x4 gg = *(const f32x4*)(g + j * 256 + lane * 4), bb = *(const f32x4*)(b + j * 256 + lane * 4);
            const f32x4 o = v[j] * rstd * gg + bb;
            *(f32x4*)(outH + (size_t)row * DM + j * 256 + lane * 4) = o;
            u32x2 w; w.x = pk2(o.x, o.y); w.y = pk2(o.z, o.w);
            *(u32x2*)(outXN + (size_t)row * DM + j * 256 + lane * 4) = w;
        }
    }
}
DEV void gemm_simple(const bf16_t* A, int lda, const bf16_t* Bt, int ldb, int M, int N, int K, void* C, int ldc, int f32out) {
    const int lane = ltid() & 63, wpb = blockDim.x >> 6;
    const int gw = blockIdx.x * wpb + (ltid() >> 6), nw = gridDim.x * wpb;
    const int tn = N / 64, tiles = (M / 64) * tn, fr = lane & 15, fq = lane >> 4;
    for (int t = gw; t < tiles; t += nw) {
        const int tm = t / tn, tc = t % tn;
        f32x4 acc[4][4];
#pragma unroll
        for (int i = 0; i < 4; ++i)
#pragma unroll
            for (int j = 0; j < 4; ++j) acc[i][j] = (f32x4){0.f, 0.f, 0.f, 0.f};
        const bf16_t* ap = A + (size_t)(tm * 64 + fr) * lda + fq * 8;
        const bf16_t* bp = Bt + (size_t)(tc * 64 + fr) * ldb + fq * 8;
        for (int k0 = 0; k0 < K; k0 += 32) {
            bf16x8 a[4], b[4];
#pragma unroll
            for (int i = 0; i < 4; ++i) { a[i] = *(const bf16x8*)(ap + (size_t)i * 16 * lda + k0); b[i] = *(const bf16x8*)(bp + (size_t)i * 16 * ldb + k0); }
#pragma unroll
            for (int i = 0; i < 4; ++i)
#pragma unroll
                for (int j = 0; j < 4; ++j) acc[i][j] = __builtin_amdgcn_mfma_f32_16x16x32_bf16(a[i], b[j], acc[i][j], 0, 0, 0);
        }
#pragma unroll
        for (int i = 0; i < 4; ++i)
#pragma unroll
            for (int j = 0; j < 4; ++j)
#pragma unroll
                for (int r = 0; r < 4; ++r) {
                    const size_t off = (size_t)(tm * 64 + i * 16 + fq * 4 + r) * ldc + tc * 64 + j * 16 + fr;
                    if (f32out) ((float*)C)[off] = acc[i][j][r]; else ((bf16_t*)C)[off] = f2bf(acc[i][j][r]);
                }
    }
}
DEV int zc(int j) { return ((j >> 8) << 9) + (j & 255); }
DEV void fft_tab(float* tab) {
    __syncthreads();
    for (int i = ltid(); i < 128; i += blockDim.x) { float s, c; sincospif((float)i / 64.f, &s, &c); tab[i] = c; tab[128 + i] = s; }
    __syncthreads();
}
DEV void fft_s1(const bf16_t* Z, bf16_t* T, float* tab) {
    fft_tab(tab);
    const size_t total = (size_t)S_ * 1024;
    for (size_t idx = GTID; idx < total; idx += GSZ) {
        const int j = (int)(idx & 1023), r = (int)(idx >> 10), k1 = r >> 7, s2 = r & 127, cj = zc(j);
        float ar = 0.f, ai = 0.f;
        for (int s1 = 0; s1 < 128; ++s1) {
            const int n = (s1 * k1) & 127; const float c = tab[n], s = tab[128 + n];
            const bf16_t* zp = Z + (size_t)(128 * s1 + s2) * 2048 + cj;
            const float zr = bf2f(zp[0]), zi = bf2f(zp[256]);
            ar += zr * c + zi * s; ai += zi * c - zr * s;
        }
        float ts, tc; sincospif((float)(s2 * k1) / 8192.f, &ts, &tc);
        const float tr = ar * tc + ai * ts, ti = ai * tc - ar * ts;
        T[(size_t)r * 2048 + cj] = f2bf(tr); T[(size_t)r * 2048 + cj + 256] = f2bf(ti);
    }
}
DEV void fft_s2(const bf16_t* T, bf16_t* BR, float* tab) {
    fft_tab(tab);
    const size_t total = (size_t)S_ * 1024;
    for (size_t idx = GTID; idx < total; idx += GSZ) {
        const int j = (int)(idx & 1023), k = (int)(idx >> 10), k1 = k & 127, k2 = k >> 7, cj = zc(j);
        float acc = 0.f;
        for (int s2 = 0; s2 < 128; ++s2) {
            const int n = (s2 * k2) & 127; const float c = tab[n], s = tab[128 + n];
            const bf16_t* tp = T + (size_t)(k1 * 128 + s2) * 2048 + cj;
            acc += bf2f(tp[0]) * c + bf2f(tp[256]) * s;
        }
        BR[(size_t)k * 1024 + j] = f2bf(acc * (1.f / 2048.f));
    }
}

typedef float f32x16 __attribute__((ext_vector_type(16)));
constexpr int FT_LD = 136;
DEV void fft_tables(bf16_t* Ct, bf16_t* St) {
    __syncthreads();
    for (int e = ltid(); e < 128 * 128; e += blockDim.x) { const int r = e >> 7, c = e & 127; float s, co; sincospif((float)((r * c) & 127) / 64.f, &s, &co); Ct[r * FT_LD + c] = f2bf(co); St[r * FT_LD + c] = f2bf(s); }
    __syncthreads();
}
DEV int crow16(int r, int hi) { return (r & 3) + 8 * (r >> 2) + 4 * hi; }
DEV void fft_s1_mfma(const bf16_t* Z, bf16_t* T, unsigned char* lds_raw) {
    bf16_t* Ct = (bf16_t*)lds_raw; bf16_t* St = Ct + 128 * FT_LD;
    fft_tables(Ct, St);
    const int tid = ltid(), lane = tid & 63, r32 = lane & 31, hi = lane >> 5, wpb = blockDim.x >> 6;
    const int gw = blockIdx.x * wpb + (tid >> 6), nw = gridDim.x * wpb;
    for (int task = gw; task < 128 * 32; task += nw) {
        const int s2 = task >> 5, jt = task & 31, j = jt * 32 + r32, cj = zc(j);
        const bf16_t* zp = Z + (size_t)s2 * 2048 + cj;
        bf16x8 zr[8], zi[8];
#pragma unroll
        for (int s = 0; s < 8; ++s)
#pragma unroll
            for (int e = 0; e < 8; ++e) { const size_t off = (size_t)(16 * s + 8 * hi + e) * (128 * 2048); zr[s][e] = (short)zp[off]; zi[s][e] = (short)zp[off + 256]; }
        f32x16 ore[4], oim[4];
#pragma unroll
        for (int mt = 0; mt < 4; ++mt)
#pragma unroll
            for (int r = 0; r < 16; ++r) { ore[mt][r] = 0.f; oim[mt][r] = 0.f; }
#pragma unroll
        for (int s = 0; s < 8; ++s) {
            bf16x8 nzr;
#pragma unroll
            for (int e = 0; e < 8; ++e) nzr[e] = (short)(zr[s][e] ^ (short)0x8000);
#pragma unroll
            for (int mt = 0; mt < 4; ++mt) {
                const bf16x8 c = *(const bf16x8*)(Ct + (mt * 32 + r32) * FT_LD + 16 * s + 8 * hi);
                const bf16x8 sn = *(const bf16x8*)(St + (mt * 32 + r32) * FT_LD + 16 * s + 8 * hi);
                ore[mt] = __builtin_amdgcn_mfma_f32_32x32x16_bf16(c, zr[s], ore[mt], 0, 0, 0);
                ore[mt] = __builtin_amdgcn_mfma_f32_32x32x16_bf16(sn, zi[s], ore[mt], 0, 0, 0);
                oim[mt] = __builtin_amdgcn_mfma_f32_32x32x16_bf16(c, zi[s], oim[mt], 0, 0, 0);
                oim[mt] = __builtin_amdgcn_mfma_f32_32x32x16_bf16(sn, nzr, oim[mt], 0, 0, 0);
            }
        }
#pragma unroll
        for (int mt = 0; mt < 4; ++mt)
#pragma unroll
            for (int r = 0; r < 16; ++r) {
                const int k1 = mt * 32 + crow16(r, hi);
                const float xr = (float)(s2 * k1) * (1.f / 16384.f);
                const float tc = __builtin_amdgcn_cosf(xr), ts = __builtin_amdgcn_sinf(xr);
                const float ar = ore[mt][r], ai = oim[mt][r];
                bf16_t* tp = T + (size_t)(k1 * 128 + s2) * 2048 + cj;
                tp[0] = f2bf(ar * tc + ai * ts); tp[256] = f2bf(ai * tc - ar * ts);
            }
    }
    __syncthreads();
}
DEV void fft_s2_mfma(const bf16_t* T, bf16_t* BR, unsigned char* lds_raw) {
    bf16_t* Ct = (bf16_t*)lds_raw; bf16_t* St = Ct + 128 * FT_LD;
    fft_tables(Ct, St);
    const int tid = ltid(), lane = tid & 63, r32 = lane & 31, hi = lane >> 5, wpb = blockDim.x >> 6;
    const int gw = blockIdx.x * wpb + (tid >> 6), nw = gridDim.x * wpb;
    for (int task = gw; task < 128 * 32; task += nw) {
        const int k1 = task >> 5, jt = task & 31, j = jt * 32 + r32, cj = zc(j);
        const bf16_t* tp = T + (size_t)(k1 * 128) * 2048 + cj;
        bf16x8 tr[8], ti[8];
#pragma unroll
        for (int s = 0; s < 8; ++s)
#pragma unroll
            for (int e = 0; e < 8; ++e) { const size_t off = (size_t)(16 * s + 8 * hi + e) * 2048; tr[s][e] = (short)tp[off]; ti[s][e] = (short)tp[off + 256]; }
        f32x16 o[4];
#pragma unroll
        for (int mt = 0; mt < 4; ++mt)
#pragma unroll
            for (int r = 0; r < 16; ++r) o[mt][r] = 0.f;
#pragma unroll
        for (int s = 0; s < 8; ++s)
#pragma unroll
            for (int mt = 0; mt < 4; ++mt) {
                const bf16x8 c = *(const bf16x8*)(Ct + (mt * 32 + r32) * FT_LD + 16 * s + 8 * hi);
                const bf16x8 sn = *(const bf16x8*)(St + (mt * 32 + r32) * FT_LD + 16 * s + 8 * hi);
                o[mt] = __builtin_amdgcn_mfma_f32_32x32x16_bf16(c, tr[s], o[mt], 0, 0, 0);
                o[mt] = __builtin_amdgcn_mfma_f32_32x32x16_bf16(sn, ti[s], o[mt], 0, 0, 0);
            }
#pragma unroll
        for (int mt = 0; mt < 4; ++mt)
#pragma unroll
            for (int r = 0; r < 16; ++r) {
                const int k = k1 + 128 * (mt * 32 + crow16(r, hi));
                BR[(size_t)k * 1024 + j] = f2bf(o[mt][r] * (1.f / 2048.f));
            }
    }
    __syncthreads();
}
DEV void qk_post(bf16_t* PROJ, const float* qg, const float* kg) {
    const size_t total = (size_t)S_ * 20 * 16;
    for (size_t idx = GTID; idx < total; idx += GSZ) {
        const int i = (int)(idx & 15), head = (int)((idx >> 4) % 20), t = (int)((idx >> 4) / 20);
        bf16_t* p = PROJ + (size_t)t * 3072 + head * 64;
        float a1 = bf2f(p[i]), a2 = bf2f(p[16 + i]), b1 = bf2f(p[32 + i]), b2 = bf2f(p[48 + i]);
        float ss = a1 * a1 + a2 * a2 + b1 * b1 + b2 * b2;
        ss += __shfl_xor(ss, 1); ss += __shfl_xor(ss, 2); ss += __shfl_xor(ss, 4); ss += __shfl_xor(ss, 8);
        const float r = 1.f / sqrtf(ss * (1.f / 64.f) + 1e-6f);
        const float* g = head < 16 ? qg : kg;
        a1 *= r * g[i]; a2 *= r * g[16 + i]; b1 *= r * g[32 + i]; b2 *= r * g[48 + i];
        const float frow = (float)(t >> 6), fcol = (float)(t & 63);
        const float sc = head < 16 ? C2 : 1.f;
        const float inv = powf(10000.f, -((float)(2 * i) / 32.f));
        const float ar = frow * inv, ac = fcol * inv;
        const float cr = cosf(ar), sr = sinf(ar), cc = cosf(ac), scn = sinf(ac);
        p[i] = f2bf((a1 * cr - a2 * sr) * sc); p[16 + i] = f2bf((a2 * cr + a1 * sr) * sc);
        p[32 + i] = f2bf((b1 * cc - b2 * scn) * sc); p[48 + i] = f2bf((b2 * cc + b1 * scn) * sc);
    }
}
DEV void attn_naive(const bf16_t* PROJ, bf16_t* BR, float* lds) {
    const int nth = blockDim.x, qblocks = S_ / nth, items = 16 * qblocks;
    float* Ks = lds; float* Vs = lds + 64 * 64;
    for (int it = blockIdx.x; it < items; it += gridDim.x) {
        const int hq = it / qblocks, qb = it % qblocks, kvh = hq >> 2, t = qb * nth + ltid();
        float q[64], o[64]; float m = -1e30f, l = 0.f;
#pragma unroll
        for (int c = 0; c < 8; ++c) load8(PROJ + (size_t)t * 3072 + hq * 64 + c * 8, q + c * 8);
#pragma unroll
        for (int d = 0; d < 64; ++d) o[d] = 0.f;
        for (int k0 = 0; k0 < S_; k0 += 64) {
            __syncthreads();
            for (int e = ltid(); e < 64 * 8; e += nth) {
                const int r = e >> 3, c8 = e & 7; float tmp[8];
                load8(PROJ + (size_t)(k0 + r) * 3072 + 1024 + kvh * 64 + c8 * 8, tmp);
#pragma unroll
                for (int j = 0; j < 8; ++j) Ks[r * 64 + c8 * 8 + j] = tmp[j];
                load8(PROJ + (size_t)(k0 + r) * 3072 + 1280 + kvh * 64 + c8 * 8, tmp);
#pragma unroll
                for (int j = 0; j < 8; ++j) Vs[r * 64 + c8 * 8 + j] = tmp[j];
            }
            __syncthreads();
            for (int r = 0; r < 64; ++r) {
                float s = 0.f;
#pragma unroll
                for (int d = 0; d < 64; d += 4) { const f32x4 kk = *(const f32x4*)(Ks + r * 64 + d); s += q[d] * kk.x + q[d + 1] * kk.y + q[d + 2] * kk.z + q[d + 3] * kk.w; }
                if (s > m) { const float f = exp2f(m - s); l *= f;
#pragma unroll
                    for (int d = 0; d < 64; ++d) o[d] *= f;
                    m = s; }
                const float p = exp2f(s - m); l += p;
#pragma unroll
                for (int d = 0; d < 64; d += 4) { const f32x4 vv = *(const f32x4*)(Vs + r * 64 + d); o[d] += p * vv.x; o[d + 1] += p * vv.y; o[d + 2] += p * vv.z; o[d + 3] += p * vv.w; }
            }
        }
        const float rl = 1.f / l;
#pragma unroll
        for (int d = 0; d < 64; ++d) o[d] *= rl;
#pragma unroll
        for (int c = 0; c < 8; ++c) store8(BR + (size_t)t * 1024 + hq * 64 + c * 8, o + c * 8);
    }
    __syncthreads();
}
DEV void rope_c(bf16_t* QKV, const float* tab) {
    const size_t total = (size_t)S_ * 32;
    for (size_t idx = GTID; idx < total; idx += GSZ) {
        const int hh = (int)(idx & 31), t = (int)(idx >> 5);
        bf16_t* p = QKV + (size_t)t * 3072 + hh * 64;
        float x[64];
#pragma unroll
        for (int c = 0; c < 8; ++c) load8(p + c * 8, x + c * 8);
        const float sc = hh < 16 ? C2 : 1.f;
        const float* tb = tab + (size_t)t * 64;
#pragma unroll
        for (int i = 0; i < 32; ++i) {
            const float c = tb[2 * i], s = tb[2 * i + 1];
            const float a1 = x[i], a2 = x[32 + i];
            x[i] = (a1 * c - a2 * s) * sc; x[32 + i] = (a2 * c + a1 * s) * sc;
        }
#pragma unroll
        for (int c = 0; c < 8; ++c) store8(p + c * 8, x + c * 8);
    }
}
DEV void dil_naive(const bf16_t* QKV, float* OACC, float* ML, int g) {
    const int dil = g == 0 ? 1 : (g == 1 ? 4 : 16);
    const size_t total = (size_t)16 * S_;
    for (size_t idx = GTID; idx < total; idx += GSZ) {
        const int head = (int)(idx >> 14), t = (int)(idx & 16383);
        float q[64], o[64]; float m, l;
#pragma unroll
        for (int c = 0; c < 8; ++c) load8(QKV + (size_t)t * 3072 + head * 64 + c * 8, q + c * 8);
        if (g == 0) { m = -1e30f; l = 0.f;
#pragma unroll
            for (int d = 0; d < 64; ++d) o[d] = 0.f;
        } else {
            m = ML[((size_t)t * 16 + head) * 2]; l = ML[((size_t)t * 16 + head) * 2 + 1];
#pragma unroll
            for (int d = 0; d < 64; d += 4) { const f32x4 v = *(const f32x4*)(OACC + (size_t)t * 1024 + head * 64 + d); o[d] = v.x; o[d + 1] = v.y; o[d + 2] = v.z; o[d + 3] = v.w; }
        }
        for (int mm = -64; mm <= 64; ++mm) {
            const int tk = t + mm * dil;
            if (tk < 0 || tk >= S_) continue;
            const bf16_t* kp = QKV + (size_t)tk * 3072 + 1024 + head * 64;
            float s = 0.f;
#pragma unroll
            for (int c = 0; c < 8; ++c) { float kk[8]; load8(kp + c * 8, kk);
#pragma unroll
                for (int j = 0; j < 8; ++j) s += q[c * 8 + j] * kk[j]; }
            if (s > m) { const float f = exp2f(m - s); l *= f;
#pragma unroll
                for (int d = 0; d < 64; ++d) o[d] *= f;
                m = s; }
            const float p = exp2f(s - m); l += p;
#pragma unroll
            for (int c = 0; c < 8; ++c) { float vv[8]; load8(kp + 1024 + c * 8, vv);
#pragma unroll
                for (int j = 0; j < 8; ++j) o[c * 8 + j] += p * vv[j]; }
        }
        ML[((size_t)t * 16 + head) * 2] = m; ML[((size_t)t * 16 + head) * 2 + 1] = l;
#pragma unroll
        for (int d = 0; d < 64; d += 4) *(f32x4*)(OACC + (size_t)t * 1024 + head * 64 + d) = (f32x4){o[d], o[d + 1], o[d + 2], o[d + 3]};
    }
}

DEV void dil_mfma(const bf16_t* QKV, float* OACC, float* ML, int g) {
    const int sh = 2 * g, dil = 1 << sh, L = S_ >> sh, nqb = L >> 5;
    const int tid = ltid(), lane = tid & 63, r32 = lane & 31, hi = lane >> 5, wpb = blockDim.x >> 6;
    const int gw = blockIdx.x * wpb + (tid >> 6), nw = gridDim.x * wpb;
    for (int task = gw; task < 16 * 512; task += nw) {
        const int a = task % nqb, hc = task / nqb, c = hc & (dil - 1), head = hc >> sh;
        const int tq = ((32 * a + r32) << sh) + c;
        const bf16_t* qp = QKV + (size_t)tq * 3072 + head * 64 + 8 * hi;
        bf16x8 qf[4];
#pragma unroll
        for (int ks = 0; ks < 4; ++ks) qf[ks] = *(const bf16x8*)(qp + 16 * ks);
        f32x16 st[5];
#pragma unroll
        for (int kt = 0; kt < 5; ++kt) {
            int jj = 32 * a - 64 + 32 * kt + r32; jj = jj < 0 ? 0 : (jj > L - 1 ? L - 1 : jj);
            const bf16_t* kp = QKV + (size_t)((jj << sh) + c) * 3072 + 1024 + head * 64 + 8 * hi;
#pragma unroll
            for (int r = 0; r < 16; ++r) st[kt][r] = 0.f;
#pragma unroll
            for (int ks = 0; ks < 4; ++ks) st[kt] = __builtin_amdgcn_mfma_f32_32x32x16_bf16(*(const bf16x8*)(kp + 16 * ks), qf[ks], st[kt], 0, 0, 0);
        }
        float mx = -1e30f;
#pragma unroll
        for (int kt = 0; kt < 5; ++kt)
#pragma unroll
            for (int r = 0; r < 16; ++r) {
                const int kvl = 32 * kt + crow16(r, hi), jj = 32 * a - 64 + kvl;
                const bool valid = (kvl >= r32) && (kvl <= r32 + 128) && (jj >= 0) && (jj < L);
                const float v = valid ? st[kt][r] : -1e30f; st[kt][r] = v; mx = fmaxf(mx, v);
            }
        mx = fmaxf(mx, __shfl_xor(mx, 32));
        float m_old = -1e30f, l_old = 0.f;
        if (g != 0) { m_old = ML[((size_t)tq * 16 + head) * 2]; l_old = ML[((size_t)tq * 16 + head) * 2 + 1]; }
        const float m_new = fmaxf(m_old, mx), f = exp2f(m_old - m_new);
        float ls = 0.f;
#pragma unroll
        for (int kt = 0; kt < 5; ++kt)
#pragma unroll
            for (int r = 0; r < 16; ++r) { const float pv = exp2f(st[kt][r] - m_new); st[kt][r] = pv; ls += pv; }
        ls += __shfl_xor(ls, 32);
        const float l_new = l_old * f + ls;
        f32x16 o[2];
#pragma unroll
        for (int dt = 0; dt < 2; ++dt)
#pragma unroll
            for (int r = 0; r < 16; ++r) o[dt][r] = 0.f;
#pragma unroll
        for (int kt = 0; kt < 5; ++kt)
#pragma unroll
            for (int s = 0; s < 2; ++s) {
                bf16x8 pf;
#pragma unroll
                for (int e = 0; e < 8; ++e) pf[e] = (short)f2bf(st[kt][8 * s + e]);
                const bf16_t* vrow[8];
#pragma unroll
                for (int e = 0; e < 8; ++e) {
                    int jj = 32 * a - 64 + 32 * kt + 16 * s + (e & 3) + 8 * (e >> 2) + 4 * hi; jj = jj < 0 ? 0 : (jj > L - 1 ? L - 1 : jj);
                    vrow[e] = QKV + (size_t)((jj << sh) + c) * 3072 + 2048 + head * 64 + r32;
                }
#pragma unroll
                for (int dt = 0; dt < 2; ++dt) {
                    bf16x8 vf;
#pragma unroll
                    for (int e = 0; e < 8; ++e) vf[e] = (short)vrow[e][32 * dt];
                    o[dt] = __builtin_amdgcn_mfma_f32_32x32x16_bf16(vf, pf, o[dt], 0, 0, 0);
                }
            }
        float* op = OACC + (size_t)tq * 1024 + head * 64 + 4 * hi;
#pragma unroll
        for (int dt = 0; dt < 2; ++dt)
#pragma unroll
            for (int i = 0; i < 4; ++i) {
                f32x4 old = (f32x4){0.f, 0.f, 0.f, 0.f};
                if (g != 0) old = *(const f32x4*)(op + 32 * dt + 8 * i);
                const f32x4 nw4 = (f32x4){o[dt][4 * i], o[dt][4 * i + 1], o[dt][4 * i + 2], o[dt][4 * i + 3]};
                *(f32x4*)(op + 32 * dt + 8 * i) = old * f + nw4;
            }
        if (hi == 0) { ML[((size_t)tq * 16 + head) * 2] = m_new; ML[((size_t)tq * 16 + head) * 2 + 1] = l_new; }
    }
}
DEV void gate_naive(const bf16_t* BR, const float* OACC, const float* ML, const bf16_t* TAIL, int ldt, const float* MKV, bf16_t* YIN) {
    const size_t total = (size_t)S_ * 1024;
    for (size_t idx = GTID; idx < total; idx += GSZ) {
        const int c = (int)(idx & 1023), t = (int)(idx >> 10);
        const float br = OACC ? OACC[idx] / ML[((size_t)t * 16 + (c >> 6)) * 2 + 1] : bf2f(BR[idx]);
        const float gt = bf2f(TAIL[(size_t)t * ldt + c]);
        YIN[(size_t)t * 1280 + c] = f2bf(br * silu(gt));
    }
    const size_t total2 = (size_t)4 * S_;
    for (size_t idx = GTID; idx < total2; idx += GSZ) {
        const int mh = (int)(idx >> 14), t = (int)(idx & 16383);
        float q[64], o[64]; float m = -1e30f, l = 0.f;
#pragma unroll
        for (int c = 0; c < 8; ++c) load8(TAIL + (size_t)t * ldt + 1280 + mh * 64 + c * 8, q + c * 8);
#pragma unroll
        for (int d = 0; d < 64; ++d) { q[d] *= C2; o[d] = 0.f; }
        for (int mm = 0; mm < 256; ++mm) {
            const float* kp = MKV + (size_t)mm * 512 + mh * 64;
            float s = 0.f;
#pragma unroll
            for (int d = 0; d < 64; ++d) s += q[d] * kp[d];
            if (s > m) { const float f = exp2f(m - s); l *= f;
#pragma unroll
                for (int d = 0; d < 64; ++d) o[d] *= f;
                m = s; }
            const float p = exp2f(s - m); l += p;
#pragma unroll
            for (int d = 0; d < 64; ++d) o[d] += p * kp[256 + d];
        }
        const float rl = 1.f / l;
#pragma unroll
        for (int c = 0; c < 8; ++c) { float gt[8]; load8(TAIL + (size_t)t * ldt + 1024 + mh * 64 + c * 8, gt);
#pragma unroll
            for (int j = 0; j < 8; ++j) o[c * 8 + j] = o[c * 8 + j] * rl * silu(gt[j]); }
#pragma unroll
        for (int c = 0; c < 8; ++c) store8(YIN + (size_t)t * 1280 + 1024 + mh * 64 + c * 8, o + c * 8);
    }
}


#define LAS3 __attribute__((address_space(3)))
DEV void gemm_bf16(unsigned char* lds_raw, const bf16_t* A, int lda, const bf16_t* Bt, int M, int N, int K, bf16_t* C, int ldc, int G, int c) {
    pg8::Gemm g{A, Bt, M, N, K, lda}; pg8::StaticOrder So; So.init(M, N, G, c);
    pg8::EpiBf16<0> E{C, ldc, nullptr, 0, 0, 1.f};
    pg8::gemm_phase<pg8::EpiBf16<0>, pg8::StaticOrder, PG8_ALIGN, PG8_SP2>((LAS3 unsigned char*)lds_raw, g, So, E);
}
DEV void gemm_f32(unsigned char* lds_raw, const bf16_t* A, int lda, const bf16_t* Bt, int M, int N, int K, float* C, int ldc, int G, int c) {
    pg8::Gemm g{A, Bt, M, N, K, lda}; pg8::StaticOrder So; So.init(M, N, G, c);
    pg8::EpiF32 E{C, ldc};
    pg8::gemm_phase<pg8::EpiF32, pg8::StaticOrder, PG8_ALIGN, PG8_SP2>((LAS3 unsigned char*)lds_raw, g, So, E);
}

#define LAS __attribute__((address_space(3)))
#define XB_TMO      128
#define XB_XCNT(j)  (256  + 64 * (j))
#define XB_XSUB(j)  (1280 + 64 * (j))
#define XB_XGEN(j)  (2304 + 64 * (j))
#define XB_TOP      3328
#define XB_TOPGEN   3392
#define XCD_BAR_WORDS 3456
#define XB_SPIN_CAP (1u << 18)

__device__ __forceinline__ unsigned xb_ld(unsigned* p)              { return __hip_atomic_load(p, __ATOMIC_RELAXED, __HIP_MEMORY_SCOPE_AGENT); }
__device__ __forceinline__ unsigned xb_add(unsigned* p, unsigned v) { return __hip_atomic_fetch_add(p, v, __ATOMIC_RELAXED, __HIP_MEMORY_SCOPE_AGENT); }
__device__ __forceinline__ unsigned xb_xcc_id() { return (unsigned)__builtin_amdgcn_s_getreg((3 << 11) | 20) & 0xFu; }
#define XB_SPIN(cond, bar) do { unsigned _sp = 0; while (cond) { __builtin_amdgcn_s_sleep(1); \
    if ((++_sp & 255u) == 0u) { if (xb_ld(&(bar)[XB_TMO])) break; if (_sp > XB_SPIN_CAP) { atomicAdd(&(bar)[XB_TMO], 1u); break; } } } } while (0)

struct XcdBarrier {
    unsigned* bar; unsigned x;
    volatile LAS unsigned* st;
};

__device__ __forceinline__ XcdBarrier xcd_barrier_post(unsigned* bar, volatile LAS unsigned* st) {
    XcdBarrier b; b.bar = bar; b.x = xb_xcc_id(); b.st = st;
    if (threadIdx.x == 0) (void)xb_add(&bar[XB_XCNT(b.x)], 1u);
    return b;
}
__device__ __forceinline__ void xcd_barrier_complete(unsigned* bar, unsigned x, unsigned& nloc, unsigned& nx) {
    const unsigned G = gridDim.x * gridDim.y * gridDim.z;
    unsigned sum, cnt, mine, sp = 0u;
    for (;;) {
        sum = 0u; cnt = 0u; mine = 0u;
#pragma unroll
        for (unsigned j = 0; j < 16; ++j) { const unsigned c = xb_ld(&bar[XB_XCNT(j)]); sum += c; cnt += (c > 0u) ? 1u : 0u; mine = (j == x) ? c : mine; }
        if (sum == G) break;
        __builtin_amdgcn_s_sleep(1);
        if ((++sp & 255u) == 0u) { if (xb_ld(&bar[XB_TMO])) break; if (sp > XB_SPIN_CAP) { atomicAdd(&bar[XB_TMO], 1u); break; } }
    }
    nloc = mine > 0u ? mine : 1u; nx = cnt > 0u ? cnt : 1u;
}

__device__ __forceinline__ void xcd_barrier(const XcdBarrier& b) {
    asm volatile("s_waitcnt vmcnt(0)" ::: "memory");
    __syncthreads();
    if (threadIdx.x == 0) {
        unsigned* bar = b.bar;
        __builtin_amdgcn_s_waitcnt(0);
        unsigned nloc = b.st[0], nx = b.st[1];
        if (nloc == 0u) { xcd_barrier_complete(bar, b.x, nloc, nx); b.st[0] = nloc; b.st[1] = nx; }
        const unsigned old = xb_add(&bar[XB_XSUB(b.x)], 1u);
        const unsigned gen = old / nloc;
        if (old + 1u == (gen + 1u) * nloc) {
            __builtin_amdgcn_fence(__ATOMIC_RELEASE, "agent");
            asm volatile("s_waitcnt vmcnt(0)" ::: "memory");
            const unsigned og = xb_add(&bar[XB_TOP], 1u);
            const unsigned tg = og / nx;
            if (og + 1u == (tg + 1u) * nx) xb_add(&bar[XB_TOPGEN], 1u);
            else XB_SPIN(xb_ld(&bar[XB_TOPGEN]) == tg, bar);
            __builtin_amdgcn_fence(__ATOMIC_ACQUIRE, "agent");
            xb_add(&bar[XB_XGEN(b.x)], 1u);
            asm volatile("s_waitcnt vmcnt(0)" ::: "memory");
        } else {
            XB_SPIN(xb_ld(&bar[XB_XGEN(b.x)]) == gen, bar);
            __builtin_amdgcn_fence(__ATOMIC_ACQUIRE, "agent");
            asm volatile("s_waitcnt vmcnt(0)" ::: "memory");
        }
    }
    __syncthreads();
}
DEV void seam(const Params& p, unsigned char* lds_raw) {
    unsigned char* w = p.ws; asm volatile("" : "+s"(w));
    XcdBarrier b; b.bar = (unsigned*)(w + 16384); b.st = (volatile LAS unsigned*)((LAS unsigned char*)lds_raw + (LDS_BYTES - 64)); b.x = b.st[2];
    xcd_barrier(b);
}
#define STEP_BEGIN { unsigned char* ws = p.ws; asm volatile("" : "+s"(ws)); float* H = p.out; float* lds = (float*)lds_raw;
#define STEP_END   } seam(p, lds_raw);
#define AR(off) (ws + WS_AR + (size_t)(off) * MiB)
#define P_WtA ((bf16_t*)(ws + WS_WA))
#define P_WtB ((bf16_t*)(ws + WS_WB))
#define P_WtC ((bf16_t*)(ws + WS_WC))
#define P_WtO ((bf16_t*)(ws + WS_WO))
#define P_Wdft ((bf16_t*)(ws + WS_WDFT))
#define P_MKV ((float*)(ws + WS_MKV))
#define P_XN ((bf16_t*)(ws + WS_XN))
#define GC (int)gridDim.x, (int)blockIdx.x
#define LNG (p.ln_g + LAYER * 1024)
#define LNB (p.ln_b + LAYER * 1024)
#define WO (P_WtO + (size_t)LAYER * 1024 * 1280)

template <int LAYER> DEV void layer_A(const Params& p, unsigned char* lds_raw) {
    STEP_BEGIN
        gemm_bf16(lds_raw, P_XN, 1024, P_WtA + (size_t)(LAYER / 3) * 1536 * 1024, S_, 1536, 1024, (bf16_t*)AR(0), 1536, GC);
        if ((gridDim.x & 3) == 0) { const int g = blockIdx.x & 3; gemm_bf16(lds_raw, P_XN + g * 256, 1024, P_Wdft, S_, 512, 256, (bf16_t*)AR(48) + g * 512, 2048, (int)gridDim.x >> 2, (int)blockIdx.x >> 2); }
        else for (int g = 0; g < 4; ++g) gemm_bf16(lds_raw, P_XN + g * 256, 1024, P_Wdft, S_, 512, 256, (bf16_t*)AR(48) + g * 512, 2048, GC);
    STEP_END
    STEP_BEGIN fft_s1_mfma((bf16_t*)AR(48), (bf16_t*)AR(112), lds_raw); STEP_END
    STEP_BEGIN fft_s2_mfma((bf16_t*)AR(112), (bf16_t*)AR(48), lds_raw); STEP_END
    STEP_BEGIN gate_naive((bf16_t*)AR(48), nullptr, nullptr, (bf16_t*)AR(0), 1536, P_MKV, (bf16_t*)AR(80)); STEP_END
    STEP_BEGIN gemm_f32(lds_raw, (bf16_t*)AR(80), 1280, WO, S_, 1024, 1280, (float*)AR(0), 1024, GC); STEP_END
    STEP_BEGIN ln_rows(H, (float*)AR(0), ALPHA, LNG, LNB, H, P_XN); STEP_END
}
template <int LAYER> DEV void layer_B(const Params& p, unsigned char* lds_raw) {
    STEP_BEGIN gemm_bf16(lds_raw, P_XN, 1024, P_WtB, S_, 3072, 1024, (bf16_t*)AR(0), 3072, GC); STEP_END
    STEP_BEGIN qk_post((bf16_t*)AR(0), p.q_norm_g, p.k_norm_g); STEP_END
    STEP_BEGIN
        bf16_t* PROJ = (bf16_t*)AR(0); bf16_t* BR = (bf16_t*)AR(96);
        if (gridDim.x == 256) {
            const attn_body::AttnTensors AT{(const attn_body::bf16*)PROJ, (const attn_body::bf16*)(PROJ + 1024), (const attn_body::bf16*)(PROJ + 1280), (attn_body::bf16*)BR};
            const attn_body::StaticOrder SA((int)gridDim.x, (int)blockIdx.x);
            attn_body::attn_phase<attn_body::StaticOrder>((char*)lds_raw, AT, SA);
        } else attn_naive(PROJ, BR, lds);
    STEP_END
    STEP_BEGIN gate_naive((bf16_t*)AR(96), nullptr, nullptr, (bf16_t*)AR(0) + 1536, 3072, P_MKV, (bf16_t*)AR(128)); STEP_END
    STEP_BEGIN gemm_f32(lds_raw, (bf16_t*)AR(128), 1280, WO, S_, 1024, 1280, (float*)AR(0), 1024, GC); STEP_END
    STEP_BEGIN ln_rows(H, (float*)AR(0), ALPHA, LNG, LNB, H, P_XN); STEP_END
}
template <int LAYER> DEV void layer_C(const Params& p, unsigned char* lds_raw) {
    for (int g = 0; g < 3; ++g) {
        STEP_BEGIN
            gemm_bf16(lds_raw, P_XN, 1024, P_WtC + (size_t)g * 3072 * 1024, S_, 3072, 1024, (bf16_t*)AR(0), 3072, GC);
            if (g == 0) make_rope1d((float*)AR(164));
        STEP_END
        STEP_BEGIN rope_c((bf16_t*)AR(0), (float*)AR(164)); STEP_END
        STEP_BEGIN dil_mfma((bf16_t*)AR(0), (float*)AR(96), (float*)AR(160), g); STEP_END
    }
    STEP_BEGIN gemm_bf16(lds_raw, P_XN, 1024, P_WtC + (size_t)9216 * 1024, S_, 1536, 1024, (bf16_t*)AR(0), 1536, GC); STEP_END
    STEP_BEGIN gate_naive(nullptr, (float*)AR(96), (float*)AR(160), (bf16_t*)AR(0), 1536, P_MKV, (bf16_t*)AR(48)); STEP_END
    STEP_BEGIN gemm_f32(lds_raw, (bf16_t*)AR(48), 1280, WO, S_, 1024, 1280, (float*)AR(96), 1024, GC); STEP_END
    STEP_BEGIN ln_rows(H, (float*)AR(96), ALPHA, LNG, LNB, H, P_XN); STEP_END
}

__global__ void __launch_bounds__(NTHREADS, 2) mk(Params p) {
    extern __shared__ __attribute__((aligned(16))) unsigned char lds_raw[];
    cg::grid_group grid = cg::this_grid();
    volatile LAS unsigned* bst = (volatile LAS unsigned*)((LAS unsigned char*)lds_raw + (LDS_BYTES - 64));
    if (threadIdx.x < 16) bst[threadIdx.x] = 0u;
    __syncthreads();
    { const XcdBarrier b0 = xcd_barrier_post((unsigned*)(p.ws + 16384), bst); if (threadIdx.x == 0) bst[2] = b0.x; }
    __syncthreads();
    STEP_BEGIN
        tconv(p.w_in_a, 1024, 1536, 1536, P_WtA, 0);
        tconv(p.w_in_a + (size_t)1024 * 1536, 1024, 1536, 1536, P_WtA + (size_t)1536 * 1024, 0);
        tconv(p.w_in_b, 1024, 3072, 3072, P_WtB, 0);
        tconv(p.w_in_c, 1024, 10752, 10752, P_WtC, 1);
        for (int i = 0; i < 4; ++i) tconv(p.w_out + (size_t)i * 1280 * 1024, 1280, 1024, 1024, P_WtO + (size_t)i * 1024 * 1280, 0);
        make_wdft(P_Wdft);
        make_mkv(p.mem, p.w_mem_kv, P_MKV);
        ln_rows(p.x, nullptr, 1.f, p.ln_in_g, p.ln_in_b, H, P_XN);
    } grid.sync();
    layer_A<0>(p, lds_raw);
    layer_B<1>(p, lds_raw);
    layer_C<2>(p, lds_raw);
    layer_A<3>(p, lds_raw);
}

extern "C" void kernel_launch(void* const* d_in, const int* in_sizes, int n_in, void* d_out, int out_size, void* d_ws, size_t ws_size, hipStream_t stream) {
    if (n_in != 13 || ws_size < 256 * MiB) { fprintf(stderr, "kernel_launch: unexpected inputs (n_in %d, ws %zu)\n", n_in, ws_size); return; }
    Params p{};
    p.x = (const float*)d_in[0]; p.mem = (const float*)d_in[1]; p.ln_in_g = (const float*)d_in[2]; p.ln_in_b = (const float*)d_in[3];
    p.w_mem_kv = (const float*)d_in[4]; p.w_in_a = (const float*)d_in[5]; p.w_in_b = (const float*)d_in[6]; p.q_norm_g = (const float*)d_in[7];
    p.k_norm_g = (const float*)d_in[8]; p.w_in_c = (const float*)d_in[9]; p.w_out = (const float*)d_in[10]; p.ln_g = (const float*)d_in[11]; p.ln_b = (const float*)d_in[12];
    p.out = (float*)d_out; p.ws = (unsigned char*)d_ws;
    static int grid_blocks = 0;
    if (!grid_blocks) {
        int dev = 0, cus = 0, per_cu = 0;
        hipGetDevice(&dev);
        hipDeviceGetAttribute(&cus, hipDeviceAttributeMultiprocessorCount, dev);
        hipFuncSetAttribute((const void*)mk, hipFuncAttributeMaxDynamicSharedMemorySize, LDS_BYTES);
        hipOccupancyMaxActiveBlocksPerMultiprocessor(&per_cu, (const void*)mk, NTHREADS, LDS_BYTES);
        if (per_cu < 1) per_cu = 1;
        grid_blocks = cus * per_cu;
    }
    p.s0 = 0; p.s1 = NSTEPS;
    hipMemsetAsync(d_ws, 0, 65536, stream);
    void* args[] = {&p};
    hipError_t e = hipLaunchCooperativeKernel((const void*)mk, dim3(grid_blocks), dim3(NTHREADS), args, LDS_BYTES, stream);
    if (e != hipSuccess) fprintf(stderr, "cooperative launch failed: %s (grid %d)\n", hipGetErrorString(e), grid_blocks);
}
```

```cpp
#include <hip/hip_runtime.h>
#include <hip/hip_cooperative_groups.h>
#include <cstdio>
#include <cstdint>
namespace cg = cooperative_groups;

#define DEV __device__ __forceinline__
typedef unsigned short bf16_t;
typedef short bf16x8 __attribute__((ext_vector_type(8)));
typedef float f32x4 __attribute__((ext_vector_type(4)));
typedef unsigned u32x4 __attribute__((ext_vector_type(4)));
typedef unsigned u32x2 __attribute__((ext_vector_type(2)));

constexpr int S_ = 16384, DM = 1024;
constexpr float ALPHA = 1.681792830507429f;
constexpr float C2 = 0.125f * 1.4426950408889634f;
constexpr float LN_EPS = 1e-5f;
constexpr size_t MiB = 1u << 20;
constexpr size_t WS_WA = 2 * MiB, WS_WB = 8 * MiB, WS_WC = 14 * MiB, WS_WO = 35 * MiB, WS_WDFT = 45 * MiB, WS_MKV = 45 * MiB + 512 * 1024;
constexpr size_t WS_XN = 48 * MiB, WS_AR = 80 * MiB;
constexpr int NTHREADS = 512;
constexpr int NSTEPS = 32;
constexpr int LDS_BYTES = 147456;


namespace pg8 {
#define PG8_LAS __attribute__((address_space(3)))
typedef unsigned short bf16_t;
typedef short bf16x8 __attribute__((ext_vector_type(8)));
typedef float f32x4 __attribute__((ext_vector_type(4)));
typedef unsigned u32x4 __attribute__((ext_vector_type(4)));
constexpr int BM = 256, BK = 64, HALF = 128, HTB = HALF * BK * 2  , STAGE_BYTES = 8 * HTB, NXCD = 8, WGM = 8;

__host__ __device__ __forceinline__ int lds_byte(int r, int c) { const int st = (r >> 4) * 2 + (c >> 5), rr = r & 15, cc = c & 31, ob = rr * 64 + cc * 2; return st * 1024 + (ob ^ (((ob >> 9) & 1) << 5)); }
__host__ __device__ __forceinline__ void stage_rc(int b, int& R, int& C) { const int st = b / 1024, sb = b % 1024, swz = sb ^ (((sb >> 9) & 1) << 5); R = (st >> 1) * 16 + swz / 64; C = (st & 1) * 32 + (swz % 64) / 2; }
__host__ __device__ __forceinline__ int perm32(int rho) { const int n = rho >> 4, i = rho & 15; return 8 * (i >> 2) + 4 * n + (i & 3); }

struct Unit { int pm, pn; };
struct Gemm { const bf16_t* A; const bf16_t* Bt; int M, N, K, lda; };

struct StaticOrder {
    int nM, nN, nwg, G, c;
    __host__ __device__ void init(int M, int N, int G_, int c_) { nM = M / BM; nN = N / BM; nwg = nM * nN; G = G_; c = c_; }
    __host__ __device__ bool next(int i, Unit& u) const {
        const long L = (long)i * G + c; if (L >= nwg) return false;
        int wgid = (int)L; { const int q = nwg / NXCD, r = nwg % NXCD, xcd = wgid % NXCD, off = wgid / NXCD; wgid = (xcd < r ? xcd * (q + 1) : r * (q + 1) + (xcd - r) * q) + off; }
        const int nig = WGM * nN, gid = wgid / nig, fm = gid * WGM, gsz = (nM - fm) < WGM ? (nM - fm) : WGM;
        u.pm = fm + ((wgid % nig) % gsz); u.pn = (wgid % nig) / gsz; return true;
    }
    __device__ __forceinline__ void a_ready(const Unit&) const {}
    __device__ __forceinline__ void done(const Unit&) const {}
};

__device__ __forceinline__ unsigned cvt_pk_bf16(float lo, float hi) { unsigned r; asm volatile("v_cvt_pk_bf16_f32 %0, %1, %2" : "=v"(r) : "v"(lo), "v"(hi)); return r; }
typedef float f32x2 __attribute__((ext_vector_type(2)));
__device__ __forceinline__ f32x2 gelu_pk(f32x2 v) {
    const f32x2 av = __builtin_elementwise_abs(v), d = av * 0.2316418882f + 1.0f;
    f32x2 t; t.x = __builtin_amdgcn_rcpf(d.x); t.y = __builtin_amdgcn_rcpf(d.y);
    f32x2 q = t * 0.5307027145f + (-0.7265760135f); q = q * t + 0.7107068705f; q = q * t + (-0.142248368f); q = q * t + 0.127414796f; q = q * t;
    const f32x2 s = (v * v) * (-0.72134752044f);
    f32x2 e; e.x = __builtin_amdgcn_exp2f(s.x); e.y = __builtin_amdgcn_exp2f(s.y);
    const f32x2 m = v * (q * e), r = v - m;
    f32x2 o; o.x = v.x < 0.f ? m.x : r.x; o.y = v.y < 0.f ? m.y : r.y; return o;
}

template <int ACT  > struct EpiBf16 {
    static constexpr bool PERM = true, AFTER_DRAIN = false; static_assert(ACT == 0 || ACT == 1, "EpiBf16: ACT is 0 (none) or 1 (gelu_pk)");
    bf16_t* O; int ldc; const float* bias; int split_cols; size_t split_stride; float scale0;
    __device__ __forceinline__ void operator()(const f32x4 (&acc)[2][2][4][2], const Unit& u, int wr, int wc, int fr, int fq) const {
        const int row0 = u.pm * BM + wr * 64 + fr; int colt = u.pn * BM; bf16_t* base = O;
        float sc = 1.f; if (split_cols) { const int t = colt / split_cols; base += (size_t)t * split_stride; colt -= t * split_cols; if (t == 0) sc = scale0; }
        const int col0 = colt + wc * 32 + 8 * fq, bcol0 = u.pn * BM + wc * 32 + 8 * fq;
        f32x4 bv[2][2];
#pragma unroll
        for (int bj = 0; bj < 2; ++bj)
#pragma unroll
            for (int n = 0; n < 2; ++n) bv[bj][n] = bias ? *(const f32x4*)(bias + bcol0 + bj * HALF + 4 * n) : (f32x4){0.f, 0.f, 0.f, 0.f};
#pragma unroll
        for (int ai = 0; ai < 2; ++ai)
#pragma unroll
            for (int m = 0; m < 4; ++m) { bf16_t* rowp = base + (size_t)(row0 + ai * HALF + m * 16) * ldc + col0;
#pragma unroll
                for (int bj = 0; bj < 2; ++bj) { f32x4 v0 = acc[ai][bj][m][0] + bv[bj][0], v1 = acc[ai][bj][m][1] + bv[bj][1];
                    if (ACT == 1) { f32x2 a = gelu_pk((f32x2){v0[0], v0[1]}), b = gelu_pk((f32x2){v0[2], v0[3]}), c = gelu_pk((f32x2){v1[0], v1[1]}), d = gelu_pk((f32x2){v1[2], v1[3]});
                        v0 = (f32x4){a.x, a.y, b.x, b.y}; v1 = (f32x4){c.x, c.y, d.x, d.y}; }
                    v0 = v0 * sc; v1 = v1 * sc; u32x4 w; w.x = cvt_pk_bf16(v0[0], v0[1]); w.y = cvt_pk_bf16(v0[2], v0[3]); w.z = cvt_pk_bf16(v1[0], v1[1]); w.w = cvt_pk_bf16(v1[2], v1[3]);
                    *(u32x4*)(rowp + bj * HALF) = w; } }
    }
};

struct EpiF32 {
    static constexpr bool PERM = false, AFTER_DRAIN = false;
    float* O; int ldc;
    __device__ __forceinline__ void operator()(const f32x4 (&acc)[2][2][4][2], const Unit& u, int wr, int wc, int fr, int fq) const {
        const int row0 = u.pm * BM + wr * 64 + fr, col0 = u.pn * BM + wc * 32 + 4 * fq;
#pragma unroll
        for (int ai = 0; ai < 2; ++ai)
#pragma unroll
            for (int m = 0; m < 4; ++m) { float* rowp = O + (size_t)(row0 + ai * HALF + m * 16) * ldc + col0;
#pragma unroll
                for (int bj = 0; bj < 2; ++bj)
#pragma unroll
                    for (int n = 0; n < 2; ++n) *(f32x4*)(rowp + bj * HALF + n * 16) = acc[ai][bj][m][n]; }
    }
};
template <class Epi, class Sched, bool ALIGN_EPI = false, bool SP2 = false>
__device__ __forceinline__ void gemm_phase(PG8_LAS unsigned char* lds, const Gemm g, const Sched& S, const Epi& E) {
    int tid_ = threadIdx.x; asm volatile("" : "+v"(tid_)); const int tid = tid_, wid = __builtin_amdgcn_readfirstlane(tid >> 6), lane = tid & 63, wr = wid >> 2, wc = wid & 3, fr = lane & 15, fq = lane >> 4;
    const int K = g.K, nt = K / BK;
    unsigned voffA[2], voffB[2];
#pragma unroll
    for (int i = 0; i < 2; ++i) { int R, C; stage_rc(tid * 16 + i * 8192, R, C); const int Rb = Epi::PERM ? ((R & ~31) + perm32(R & 31)) : R;
        voffA[i] = (unsigned)(R * g.lda + C) * 2u; voffB[i] = (unsigned)(Rb * K + C) * 2u; }
    const size_t kstep = (size_t)(BK * 2);
    const size_t hstepB = (size_t)HALF * K * 2, hstepA = (size_t)HALF * g.lda * 2;
    const size_t tstepA = 2 * hstepA, tstepB = 2 * hstepB;
    const unsigned ldsw = (unsigned)wid * 1024u;
    const int aoff = lds_byte(wr * 64 + fr, fq * 8), boff = lds_byte(wc * 32 + fr, fq * 8);
#define PG8_SA(b, h) (((b) * 2 + (h)) * HTB)
#define PG8_SB(b, h) ((4 + (b) * 2 + (h)) * HTB)
#define PG8_STAGE(bufoff, gbase, voff) do { _Pragma("unroll") for (int _i = 0; _i < 2; ++_i) \
        __builtin_amdgcn_global_load_lds((const unsigned*)((const char*)(gbase) + (voff)[_i]), (PG8_LAS unsigned*)(lds + (bufoff) + ldsw + _i * 8192), 16, 0, 0); } while (0)
#define PG8_LDA(dst, b, h) do { _Pragma("unroll") for (int m = 0; m < 4; ++m) _Pragma("unroll") for (int k = 0; k < 2; ++k) dst[m][k] = *(const PG8_LAS bf16x8*)(lds + PG8_SA(b, h) + aoff + m * 2048 + k * 1024); } while (0)
#define PG8_LDB(dst, b, h) do { _Pragma("unroll") for (int n = 0; n < 2; ++n) _Pragma("unroll") for (int k = 0; k < 2; ++k) dst[n][k] = *(const PG8_LAS bf16x8*)(lds + PG8_SB(b, h) + boff + n * 2048 + k * 1024); } while (0)
#define PG8_MMA(ai, bj, At, Bt) do { __builtin_amdgcn_s_setprio(1); _Pragma("unroll") for (int m = 0; m < 4; ++m) _Pragma("unroll") for (int n = 0; n < 2; ++n) _Pragma("unroll") for (int k = 0; k < 2; ++k) \
        acc[ai][bj][m][n] = __builtin_amdgcn_mfma_f32_16x16x32_bf16(Bt[n][k], At[m][k], acc[ai][bj][m][n], 0, 0, 0); __builtin_amdgcn_s_setprio(0); } while (0)
#define PG8_WAIT_V(n) asm volatile("s_waitcnt vmcnt(" #n ")" ::: "memory")
#define PG8_WAIT_L(n) asm volatile("s_waitcnt lgkmcnt(" #n ")" ::: "memory")
#define PG8_BAR __builtin_amdgcn_s_barrier()
#define PG8_SCHED __builtin_amdgcn_sched_barrier(0)
    Unit cur, nxt; int ui = 0;
    if (!S.next(0, cur)) return;
    f32x4 acc[2][2][4][2];
#pragma unroll
    for (int a = 0; a < 2; ++a)
#pragma unroll
        for (int b = 0; b < 2; ++b)
#pragma unroll
            for (int m = 0; m < 4; ++m)
#pragma unroll
                for (int n = 0; n < 2; ++n) acc[a][b][m][n] = (f32x4){0.f, 0.f, 0.f, 0.f};
    bf16x8 At[4][2], B0[2][2], B1[2][2];
    const char* cA = (const char*)g.A + (size_t)cur.pm * tstepA; const char* cB = (const char*)g.Bt + (size_t)cur.pn * tstepB;
    S.a_ready(cur);
    if constexpr (SP2) {
        PG8_STAGE(PG8_SB(0, 0), cB, voffB); PG8_STAGE(PG8_SB(0, 1), cB + hstepB, voffB); PG8_STAGE(PG8_SA(0, 0), cA, voffA); PG8_STAGE(PG8_SA(0, 1), cA + hstepA, voffA);
        if (wr == 1) PG8_BAR;
        PG8_WAIT_V(2); PG8_BAR;
        PG8_STAGE(PG8_SB(1, 0), cB + kstep, voffB); PG8_STAGE(PG8_SA(1, 0), cA + kstep, voffA); PG8_STAGE(PG8_SB(1, 1), cB + hstepB + kstep, voffB);
        PG8_WAIT_V(6); PG8_BAR;
    } else {
        PG8_STAGE(PG8_SB(0, 0), cB, voffB); PG8_STAGE(PG8_SA(0, 0), cA, voffA); PG8_STAGE(PG8_SB(0, 1), cB + hstepB, voffB); PG8_STAGE(PG8_SA(0, 1), cA + hstepA, voffA);
        if (wr == 1) PG8_BAR;
        PG8_WAIT_V(4); PG8_BAR;
        PG8_STAGE(PG8_SB(1, 0), cB + kstep, voffB); PG8_STAGE(PG8_SA(1, 0), cA + kstep, voffA); PG8_STAGE(PG8_SB(1, 1), cB + hstepB + kstep, voffB);
        PG8_WAIT_V(6); PG8_BAR;
    }
    for (;;) {
        const bool has_next = S.next(ui + 1, nxt);
        const char* nA = has_next ? (const char*)g.A + (size_t)nxt.pm * tstepA : cA; const char* nB = has_next ? (const char*)g.Bt + (size_t)nxt.pn * tstepB : cB;
        for (int t = 0; t < nt; t += 2) {
            const bool last = (t == nt - 2);
            const char* a1 = cA + (size_t)(t + 1) * kstep;
            const char* a2 = last ? nA : cA + (size_t)(t + 2) * kstep; const char* b2 = last ? nB : cB + (size_t)(t + 2) * kstep;
            const char* a3 = a2 + kstep; const char* b3 = b2 + kstep;
            if (last && has_next) S.a_ready(nxt);
            if constexpr (SP2) {
            PG8_LDB(B0, 0, 0); PG8_LDB(B1, 0, 1); PG8_SCHED; PG8_LDA(At, 0, 0); PG8_STAGE(PG8_SA(1, 1), a1 + hstepA, voffA);
            PG8_WAIT_V(8); PG8_WAIT_L(0); PG8_BAR; PG8_MMA(0, 0, At, B0); PG8_MMA(0, 1, At, B1); PG8_BAR; PG8_SCHED;
            PG8_LDA(At, 0, 1); PG8_STAGE(PG8_SB(0, 0), b2, voffB); PG8_STAGE(PG8_SB(0, 1), b2 + hstepB, voffB); PG8_STAGE(PG8_SA(0, 0), a2, voffA);
            PG8_WAIT_V(8); PG8_WAIT_L(0); PG8_BAR; PG8_MMA(1, 0, At, B0); PG8_MMA(1, 1, At, B1); PG8_BAR; PG8_SCHED;
            PG8_LDB(B0, 1, 0); PG8_LDB(B1, 1, 1); PG8_SCHED; PG8_LDA(At, 1, 0); PG8_STAGE(PG8_SA(0, 1), a2 + hstepA, voffA);
            PG8_WAIT_V(8); PG8_WAIT_L(0); PG8_BAR; PG8_MMA(0, 0, At, B0); PG8_MMA(0, 1, At, B1); PG8_BAR; PG8_SCHED;
            PG8_LDA(At, 1, 1); PG8_STAGE(PG8_SB(1, 0), b3, voffB); PG8_STAGE(PG8_SB(1, 1), b3 + hstepB, voffB); PG8_STAGE(PG8_SA(1, 0), a3, voffA);
            PG8_WAIT_V(8); PG8_WAIT_L(0); PG8_BAR; PG8_MMA(1, 0, At, B0); PG8_MMA(1, 1, At, B1); PG8_BAR; PG8_SCHED;
            } else {
            PG8_LDB(B0, 0, 0); PG8_SCHED; PG8_LDA(At, 0, 0); PG8_STAGE(PG8_SA(1, 1), a1 + hstepA, voffA);
            PG8_WAIT_L(8); PG8_BAR; PG8_WAIT_L(0); PG8_MMA(0, 0, At, B0); PG8_BAR; PG8_SCHED;
            PG8_LDB(B1, 0, 1); PG8_STAGE(PG8_SB(0, 0), b2, voffB);
            PG8_BAR; PG8_WAIT_L(0); PG8_MMA(0, 1, At, B1); PG8_BAR;
            PG8_LDA(At, 0, 1); PG8_STAGE(PG8_SA(0, 0), a2, voffA);
            PG8_BAR; PG8_WAIT_L(0); PG8_MMA(1, 0, At, B0); PG8_BAR; PG8_SCHED;
            PG8_STAGE(PG8_SB(0, 1), b2 + hstepB, voffB);
            PG8_WAIT_V(6); PG8_BAR; PG8_MMA(1, 1, At, B1); PG8_BAR;
            PG8_LDB(B0, 1, 0); PG8_SCHED; PG8_LDA(At, 1, 0); PG8_STAGE(PG8_SA(0, 1), a2 + hstepA, voffA);
            PG8_WAIT_L(8); PG8_BAR; PG8_WAIT_L(0); PG8_MMA(0, 0, At, B0); PG8_BAR; PG8_SCHED;
            PG8_LDB(B1, 1, 1); PG8_STAGE(PG8_SB(1, 0), b3, voffB);
            PG8_BAR; PG8_WAIT_L(0); PG8_MMA(0, 1, At, B1); PG8_BAR;
            PG8_LDA(At, 1, 1); PG8_STAGE(PG8_SA(1, 0), a3, voffA);
            PG8_BAR; PG8_WAIT_L(0); PG8_MMA(1, 0, At, B0); PG8_BAR; PG8_SCHED;
            PG8_STAGE(PG8_SB(1, 1), b3 + hstepB, voffB);
            PG8_WAIT_V(6); PG8_BAR; PG8_MMA(1, 1, At, B1); PG8_BAR;
            }
        }
        if constexpr (ALIGN_EPI) { if (wr == 0) PG8_BAR; }
        if constexpr (!Epi::AFTER_DRAIN) { E(acc, cur, wr, wc, fr, fq); S.done(cur); }
        if (!has_next) break;
#pragma unroll
        for (int a = 0; a < 2; ++a)
#pragma unroll
            for (int b = 0; b < 2; ++b)
#pragma unroll
                for (int m = 0; m < 4; ++m)
#pragma unroll
                    for (int n = 0; n < 2; ++n) acc[a][b][m][n] = (f32x4){0.f, 0.f, 0.f, 0.f};
        cur = nxt; cA = nA; cB = nB; ++ui;
        if constexpr (ALIGN_EPI) { if (wr == 1) PG8_BAR; }
    }
    PG8_WAIT_V(0);
    if constexpr (!ALIGN_EPI) { if (wr == 0) PG8_BAR; }
    PG8_BAR;
    if constexpr (Epi::AFTER_DRAIN) { E.fused(acc, cur, wr, wc, fr, fq, lds, wid, lane); S.done(cur); }
#undef PG8_SA
#undef PG8_SB
#undef PG8_STAGE
#undef PG8_LDA
#undef PG8_LDB
#undef PG8_MMA
#undef PG8_WAIT_V
#undef PG8_WAIT_L
#undef PG8_BAR
#undef PG8_SCHED
}
}

#define PG8_SP2 true
#define PG8_ALIGN true
#include <hip/hip_bf16.h>
#include <cmath>
namespace attn_body {
using bf16=__hip_bfloat16;
using bf16x8=__attribute__((ext_vector_type(8)))short;
using s16x4=__attribute__((ext_vector_type(4)))short;
using f32x16=__attribute__((ext_vector_type(16)))float;
using u32x4=__attribute__((ext_vector_type(4)))unsigned;
constexpr int BATCH=1,NHEAD=16,SEQ=16384,D=64,DM=NHEAD*D,QP=3072,KP=3072,OP=1024;
constexpr int NW=8,QBLK=32,QB=QBLK*NW,KVBLK=64,NQB=SEQ/QB;
constexpr int ATTN_PITCH=DM, ATTN_UNIT_ROWS=QB;
__device__ __forceinline__ int crow(int r,int hi){return (r&3)+8*(r>>2)+4*hi;}
#define SBAR() __builtin_amdgcn_sched_barrier(0)
__device__ __forceinline__ void cmask(f32x16&p0,f32x16&p1,int jb,int qrel,int hi){
  const float NEG=-INFINITY; int kb=64*jb+4*hi;
  #pragma unroll
  for(int r=0;r<16;++r){int kv=kb+(r&3)+8*(r>>2); if(kv>qrel)p0[r]=NEG; if(kv+32>qrel)p1[r]=NEG;}
}

constexpr int NSLOT=3, SLOTB=8192;
constexpr int LDS_K=0, LDS_V=NSLOT*SLOTB, LDS_WS=2*NSLOT*SLOTB, LDS_OST=LDS_WS+NW*64*4, LDS_BYTES=LDS_OST+NW*4096;
constexpr float C2=0.125f*1.4426950408889634f;
__device__ __forceinline__ void glds16(const void*gsrc,unsigned lds_dst){unsigned keep;
  asm volatile("s_mov_b32 %0, m0\n\ts_mov_b32 m0, %2\n\ts_nop 0\n\tglobal_load_lds_dwordx4 %1, off\n\ts_mov_b32 m0, %0":"=&s"(keep):"v"(gsrc),"s"(lds_dst):"memory");}
__device__ __forceinline__ float max3f(float a,float b,float c){float r;asm("v_max3_f32 %0, %1, %2, %3":"=v"(r):"v"(a),"v"(b),"v"(c));return r;}
__device__ __forceinline__ float max2f(float a,float b){float r;asm("v_max_f32_e32 %0, %1, %2":"=v"(r):"v"(a),"v"(b));return r;}
__device__ __forceinline__ float fadd_s(float a,float b){float r;asm("v_add_f32_e32 %0, %1, %2":"=v"(r):"v"(a),"v"(b));return r;}
__device__ __forceinline__ float fsub_s(float a,float b){float r;asm("v_sub_f32_e32 %0, %1, %2":"=v"(r):"v"(a),"v"(b));return r;}
typedef float f32x2_t __attribute__((ext_vector_type(2))); typedef __bf16 bf16x2_t __attribute__((ext_vector_type(2)));
__device__ __forceinline__ unsigned cvtpk_s(float lo,float hi){f32x2_t v={lo,hi};bf16x2_t b=__builtin_convertvector(v,bf16x2_t);return __builtin_bit_cast(unsigned,b);}
#define WAIT_BAR(N) asm volatile("s_waitcnt vmcnt(" #N ") lgkmcnt(0)\n\ts_barrier":::"memory")

__device__ __forceinline__ void qkt(f32x16&p0,f32x16&p1,const char*Kslot,const bf16x8*qr,const f32x16&negm,int r32,int hi){
  const char*kb=Kslot+hi*1024+r32*16;
  #pragma unroll
  for(int d0=0;d0<4;++d0){
    const bf16x8 b0=*reinterpret_cast<const bf16x8*>(kb+d0*2048);
    const bf16x8 b1=*reinterpret_cast<const bf16x8*>(kb+d0*2048+512);
    if(d0==0){p0=__builtin_amdgcn_mfma_f32_32x32x16_bf16(b0,qr[0],negm,0,0,0);p1=__builtin_amdgcn_mfma_f32_32x32x16_bf16(b1,qr[0],negm,0,0,0);}
    else{p0=__builtin_amdgcn_mfma_f32_32x32x16_bf16(b0,qr[d0],p0,0,0,0);p1=__builtin_amdgcn_mfma_f32_32x32x16_bf16(b1,qr[d0],p1,0,0,0);}}
}
typedef __attribute__((address_space(3))) const char* lds_cptr;
typedef short v4i16_t __attribute__((ext_vector_type(4)));
__device__ __forceinline__ void kload8(bf16x8*kf,lds_cptr kp){
  kf[0]=*(const __attribute__((address_space(3))) bf16x8*)(kp);      kf[1]=*(const __attribute__((address_space(3))) bf16x8*)(kp+512);
  kf[2]=*(const __attribute__((address_space(3))) bf16x8*)(kp+2048); kf[3]=*(const __attribute__((address_space(3))) bf16x8*)(kp+2560);
  kf[4]=*(const __attribute__((address_space(3))) bf16x8*)(kp+4096); kf[5]=*(const __attribute__((address_space(3))) bf16x8*)(kp+4608);
  kf[6]=*(const __attribute__((address_space(3))) bf16x8*)(kp+6144); kf[7]=*(const __attribute__((address_space(3))) bf16x8*)(kp+6656);
}
__device__ __forceinline__ void kload2(bf16x8*kf,lds_cptr kp,int j){ kf[2*j]=*(const __attribute__((address_space(3))) bf16x8*)(kp+j*2048); kf[2*j+1]=*(const __attribute__((address_space(3))) bf16x8*)(kp+j*2048+512); }
__device__ __forceinline__ s16x4 vtr(lds_cptr p){ return __builtin_bit_cast(s16x4,__builtin_amdgcn_ds_read_tr16_b64_v4i16((__attribute__((address_space(3))) v4i16_t*)p)); }
__device__ __forceinline__ float rowmax(const f32x16&p0,const f32x16&p1){
  float a=max3f(p0[0],p0[1],p1[0]),b=max3f(p0[2],p0[3],p1[1]);a=max3f(a,p1[2],p1[3]);
  #pragma unroll
  for(int r=4;r<16;r+=4){a=max3f(a,p0[r],p0[r+1]);b=max3f(b,p0[r+2],p0[r+3]);a=max3f(a,p1[r],p1[r+1]);b=max3f(b,p1[r+2],p1[r+3]);}
  const float m=max2f(a,b);
  auto rr=__builtin_amdgcn_permlane32_swap(__float_as_uint(m),__float_as_uint(m),false,false);
  return max2f(__uint_as_float(rr[0]),__uint_as_float(rr[1]));
}
__device__ __forceinline__ void pv(f32x16*o,int vb,bf16x8 pa0,bf16x8 pa1,bf16x8 pa2,bf16x8 pa3){
  #pragma unroll
  for(int d0=0;d0<2;++d0){s16x4 lo[4],hi[4];
    #pragma unroll
    for(int ks=0;ks<4;++ks){
      asm volatile("ds_read_b64_tr_b16 %0,%1 offset:%c2":"=&v"(lo[ks]):"v"(vb),"i"(d0*4096+ks*1024):"memory");
      asm volatile("ds_read_b64_tr_b16 %0,%1 offset:%c2":"=&v"(hi[ks]):"v"(vb),"i"(d0*4096+ks*1024+512):"memory");}
    asm volatile("s_waitcnt lgkmcnt(0)":::"memory");SBAR();
    #define PK(k) (bf16x8){lo[k][0],lo[k][1],lo[k][2],lo[k][3],hi[k][0],hi[k][1],hi[k][2],hi[k][3]}
    o[d0]=__builtin_amdgcn_mfma_f32_32x32x16_bf16(pa0,PK(0),o[d0],0,0,0);
    o[d0]=__builtin_amdgcn_mfma_f32_32x32x16_bf16(pa1,PK(1),o[d0],0,0,0);
    o[d0]=__builtin_amdgcn_mfma_f32_32x32x16_bf16(pa2,PK(2),o[d0],0,0,0);
    o[d0]=__builtin_amdgcn_mfma_f32_32x32x16_bf16(pa3,PK(3),o[d0],0,0,0);
    #undef PK
  }
}

#ifndef ATTN_STORE16
#define ATTN_STORE16(p,v) (*(u32x4*)(p)=(v))
#endif
template<int THRL> __device__ __forceinline__ void attn_unit(int b,int h,int qb,const bf16*Q,const bf16*__restrict__ K,const bf16*__restrict__ V,bf16*O,char*shm){
  int tid_=threadIdx.x; asm volatile("":"+v"(tid_)); const int tid=tid_,lane=tid&63,r32=lane&31,hi=lane>>5; const int wid=__builtin_amdgcn_readfirstlane(tid>>6);
  const long rowbase=(long)b*SEQ; const int q0=qb*QB;
  const bf16*Qw=Q+(rowbase+q0+wid*QBLK)*QP+h*D;
  const int kvh=h>>2; const bf16*Kh=K+rowbase*KP+kvh*D,*Vh=V+rowbase*KP+kvh*D;
  const unsigned lds0=(unsigned)(uintptr_t)shm;
  float*wsf=(float*)(shm+LDS_WS)+wid*64;
  const bf16*ksrc=Kh+(long)lane*KP+wid*8;
  const bf16*vsrc=Vh+(long)(16*(wid&3)+(lane>>2))*KP+(wid>>2)*32+(lane&3)*8;
  const unsigned kdst=lds0+LDS_K+wid*1024, vdst=lds0+LDS_V+wid*1024;
  #define DMA_K(t,slot) glds16(ksrc+(long)(t)*KVBLK*KP,(unsigned)__builtin_amdgcn_readfirstlane(kdst+(slot)))
  #define DMA_V(t,slot) glds16(vsrc+(long)(t)*KVBLK*KP,(unsigned)__builtin_amdgcn_readfirstlane(vdst+(slot)))
  const int vb0=(int)(lds0+LDS_V)+((lane>>4)&1)*32+(lane&3)*8+(4*hi+((lane&15)>>2))*64;
  const char*Kbase=shm+LDS_K; bf16x8 kf[8];
  const lds_cptr shm3=(lds_cptr)shm; const lds_cptr kp0=shm3+LDS_K+hi*1024+r32*16; const lds_cptr vp0=shm3+LDS_V+((lane>>4)&1)*32+(lane&3)*8+(4*hi+((lane&15)>>2))*64;
  const int NT=SEQ/KVBLK;
  DMA_K(0,0);DMA_V(0,0);DMA_K(1,SLOTB);
  bf16x8 qr[4];
  #pragma unroll
  for(int d0=0;d0<4;++d0)qr[d0]=*reinterpret_cast<const bf16x8*>(&Qw[(long)r32*QP+d0*16+hi*8]);
  float mhat=0.f,l_reg=0.f;f32x16 o[2];o[0]=f32x16{};o[1]=f32x16{};f32x16 negm=f32x16{};asm volatile("":"+v"(negm));
  const int qrel=wid*QBLK+r32;
  #define CMASK(P0,P1,t) do{}while(0)
  bool resc=false;
  #define START(P0,P1) do{ const float rm=rowmax(P0,P1); resc=false; \
    { const float dl=rm; mhat=fadd_s(mhat,dl); \
      _Pragma("unroll") for(int r=0;r<16;++r){P0[r]=fsub_s(P0[r],dl);P1[r]=fsub_s(P1[r],dl);} \
      _Pragma("unroll") for(int r=0;r<16;++r)negm[r]=-mhat; asm volatile("":"+v"(negm)); } \
    _Pragma("unroll") for(int r=0;r<16;++r)P0[r]=__builtin_amdgcn_exp2f(P0[r]); }while(0)
  #define RESC() do{ if(resc){ asm volatile("s_waitcnt lgkmcnt(0)":::"memory"); \
      _Pragma("unroll") for(int d_=0;d_<2;++d_) _Pragma("unroll") for(int r=0;r<16;++r)o[d_][r]*=wsf[crow(r,hi)]; } }while(0)
  f32x16 pA0,pA1,pB0,pB1;
  int sl_prev=0,sl_cur=0,sl_next=SLOTB;
  #define ROT() do{sl_prev=sl_cur;sl_cur=sl_next;sl_next=(sl_next==(NSLOT-1)*SLOTB)?0:sl_next+SLOTB;}while(0)
  DMA_K(2,2*SLOTB);
  WAIT_BAR(3);
  qkt(pA0,pA1,Kbase,qr,negm,r32,hi);asm volatile("s_nop 15\n\ts_nop 7":"+v"(pA0),"+v"(pA1));CMASK(pA0,pA1,0);
  START(pA0,pA1);
  _Pragma("unroll") for(int r=0;r<16;++r)pA1[r]=__builtin_amdgcn_exp2f(pA1[r]);
  WAIT_BAR(0);
  DMA_K(3,0);DMA_V(1,SLOTB);
  ROT();
  kload8(kf,kp0+sl_cur);
  WAIT_BAR(2);
  s16x4 vlo[8],vhi[8]; u32x4 pw0,pw1,pw2,pw3;
  #define PKW(P,B) cvtpk_s(P[B],P[B+1])
  #define PAF(k) __builtin_bit_cast(bf16x8,pw##k)
  #define VFR(i) (bf16x8){vlo[i][0],vlo[i][1],vlo[i][2],vlo[i][3],vhi[i][0],vhi[i][1],vhi[i][2],vhi[i][3]}
  #define PIN(x) asm volatile("":"+v"(x))
  #define MX3(a,b,c) __builtin_fmaxf(__builtin_fmaxf((a),(b)),(c))
  #define GAPA(MF,A0,A1,A2,A3,W0,W1,PW) do{ MF; sacc+=A0; sacc+=A1; sacc+=A2; sacc+=A3; PIN(sacc); W0; W1; PIN(PW); SBAR(); }while(0)
  #define EX(v) __builtin_amdgcn_exp2f(v)
  #define GAPB(MF,X,B) do{ MF; X[B]=EX(X[B]); X[B+1]=EX(X[B+1]); X[B+2]=EX(X[B+2]); X[B+3]=EX(X[B+3]); PIN(X); SBAR(); }while(0)
  #define VRD(i) do{ vlo[i]=vtr(vp_+(((i)>>2)*4096+((i)&3)*1024)); vhi[i]=vtr(vp_+(((i)>>2)*4096+((i)&3)*1024+512)); }while(0)
  #define KRD(G,j) do{ if(G){ kload2(kf,kp0+sl_next,j); SBAR(); } }while(0)
  #define STEP(C0,C1,P0,P1,t,GK,GV,GL) do{ SBAR(); \
    const lds_cptr vp_=vp0+sl_prev; \
    VRD(0); SBAR(); float sacc=(P0[0]+P0[1]); \
    GAPA(C0=__builtin_amdgcn_mfma_f32_32x32x16_bf16(kf[0],qr[0],negm,0,0,0), P0[2],P0[3],P0[4],P0[5],     pw0[0]=PKW(P0,0), pw0[1]=PKW(P0,2), pw0); \
    VRD(4); SBAR(); GAPA(C1=__builtin_amdgcn_mfma_f32_32x32x16_bf16(kf[1],qr[0],negm,0,0,0), P0[6],P0[7],P0[8],P0[9],     pw0[2]=PKW(P0,4), pw0[3]=PKW(P0,6), pw0); \
    VRD(1); SBAR(); GAPA(C0=__builtin_amdgcn_mfma_f32_32x32x16_bf16(kf[2],qr[1],C0,0,0,0),   P0[10],P0[11],P0[12],P0[13], pw1[0]=PKW(P0,8), pw1[1]=PKW(P0,10), pw1); \
    VRD(5); SBAR(); GAPA(C1=__builtin_amdgcn_mfma_f32_32x32x16_bf16(kf[3],qr[1],C1,0,0,0),   P0[14],P0[15],P1[0],P1[1],   pw1[2]=PKW(P0,12),pw1[3]=PKW(P0,14), pw1); \
    VRD(2); SBAR(); GAPA(C0=__builtin_amdgcn_mfma_f32_32x32x16_bf16(kf[4],qr[2],C0,0,0,0),   P1[2],P1[3],P1[4],P1[5],     pw2[0]=PKW(P1,0), pw2[1]=PKW(P1,2), pw2); \
    VRD(6); SBAR(); GAPA(C1=__builtin_amdgcn_mfma_f32_32x32x16_bf16(kf[5],qr[2],C1,0,0,0),   P1[6],P1[7],P1[8],P1[9],     pw2[2]=PKW(P1,4), pw2[3]=PKW(P1,6), pw2); \
    VRD(3); SBAR(); GAPA(C0=__builtin_amdgcn_mfma_f32_32x32x16_bf16(kf[6],qr[3],C0,0,0,0),   P1[10],P1[11],P1[12],P1[13], pw3[0]=PKW(P1,8), pw3[1]=PKW(P1,10), pw3); \
    VRD(7); SBAR(); GAPA(C1=__builtin_amdgcn_mfma_f32_32x32x16_bf16(kf[7],qr[3],C1,0,0,0),   P1[14],P1[15],0.f,0.f,       pw3[2]=PKW(P1,12),pw3[3]=PKW(P1,14), pw3); \
    l_reg+=sacc; \
    if(GK){DMA_K((t)+3,sl_cur);} if(GV){DMA_V((t)+1,sl_next);} \
    CMASK(C0,C1,t); \
    { float a=MX3(C0[0],C0[1],C1[0]),b=MX3(C0[2],C0[3],C1[1]); a=MX3(a,C1[2],C1[3]); \
      _Pragma("unroll") for(int r=4;r<16;r+=4){a=MX3(a,C0[r],C0[r+1]);b=MX3(b,C0[r+2],C0[r+3]);a=MX3(a,C1[r],C1[r+1]);b=MX3(b,C1[r+2],C1[r+3]);} \
      float rm=__builtin_fmaxf(a,b); { auto rr=__builtin_amdgcn_permlane32_swap(__float_as_uint(rm),__float_as_uint(rm),false,false); rm=__builtin_fmaxf(__uint_as_float(rr[0]),__uint_as_float(rr[1])); } \
      resc=false; \
      if(__builtin_expect(__any(rm>(float)THRL),0)){ const float dl=__builtin_fmaxf(rm,0.f); mhat+=dl; \
        _Pragma("unroll") for(int r=0;r<16;++r){C0[r]-=dl;C1[r]-=dl;} \
        _Pragma("unroll") for(int r=0;r<16;++r)negm[r]=-mhat; asm volatile("":"+v"(negm)); \
        const float f=__builtin_amdgcn_exp2f(-dl); l_reg*=f; if(hi==0)wsf[r32]=f; resc=true; } } \
    SBAR(); \
    GAPB(o[0]=__builtin_amdgcn_mfma_f32_32x32x16_bf16(PAF(0),VFR(0),o[0],0,0,0), C0,0); \
    GAPB(o[1]=__builtin_amdgcn_mfma_f32_32x32x16_bf16(PAF(0),VFR(4),o[1],0,0,0), C0,4); \
    KRD(GL,0); GAPB(o[0]=__builtin_amdgcn_mfma_f32_32x32x16_bf16(PAF(1),VFR(1),o[0],0,0,0), C0,8); \
    KRD(GL,1); GAPB(o[1]=__builtin_amdgcn_mfma_f32_32x32x16_bf16(PAF(1),VFR(5),o[1],0,0,0), C0,12); \
    KRD(GL,2); GAPB(o[0]=__builtin_amdgcn_mfma_f32_32x32x16_bf16(PAF(2),VFR(2),o[0],0,0,0), C1,0); \
    KRD(GL,3); GAPB(o[1]=__builtin_amdgcn_mfma_f32_32x32x16_bf16(PAF(2),VFR(6),o[1],0,0,0), C1,4); \
    GAPB(o[0]=__builtin_amdgcn_mfma_f32_32x32x16_bf16(PAF(3),VFR(3),o[0],0,0,0), C1,8); \
    GAPB(o[1]=__builtin_amdgcn_mfma_f32_32x32x16_bf16(PAF(3),VFR(7),o[1],0,0,0), C1,12); \
    }while(0)
  int t=1;
  #undef CMASK
  #define CMASK(P0,P1,t) do{}while(0)
  for(;t+5<NT;t+=2){
    STEP(pB0,pB1,pA0,pA1,t,true,true,true);     WAIT_BAR(2); RESC(); ROT();
    STEP(pA0,pA1,pB0,pB1,t+1,true,true,true);   WAIT_BAR(2); RESC(); ROT();
  }
  #undef CMASK
  #define CMASK(P0,P1,t) do{}while(0)
  #define ENDW(tt) do{ if((tt)+3<NT){WAIT_BAR(2);} else if((tt)+2<NT){WAIT_BAR(1);} else {WAIT_BAR(0);} }while(0)
  for(;t+1<NT;t+=2){
    STEP(pB0,pB1,pA0,pA1,t,(t+3<NT),(t+1<NT),(t+1<NT));       ENDW(t);   RESC(); ROT();
    STEP(pA0,pA1,pB0,pB1,t+1,(t+4<NT),(t+2<NT),(t+2<NT));     ENDW(t+1); RESC(); ROT();
  }
  STEP(pB0,pB1,pA0,pA1,NT-1,false,false,false); RESC();
  { float sacc=pB0[0]+pB0[1]; _Pragma("unroll") for(int r=2;r<16;++r)sacc+=pB0[r]; _Pragma("unroll") for(int r=0;r<16;++r)sacc+=pB1[r]; l_reg+=sacc;
    pw0=(u32x4){PKW(pB0,0),PKW(pB0,2),PKW(pB0,4),PKW(pB0,6)};pw1=(u32x4){PKW(pB0,8),PKW(pB0,10),PKW(pB0,12),PKW(pB0,14)};pw2=(u32x4){PKW(pB1,0),PKW(pB1,2),PKW(pB1,4),PKW(pB1,6)};pw3=(u32x4){PKW(pB1,8),PKW(pB1,10),PKW(pB1,12),PKW(pB1,14)};
    SBAR(); pv(o,vb0+sl_cur,PAF(0),PAF(1),PAF(2),PAF(3)); }
  #undef PKW
  #undef PAF
  #undef VFR
  #undef PIN
  #undef MX3
  #undef GAPA
  #undef GAPB
  #undef EX
  #undef VRD
  #undef KRD
  #undef STEP
  #undef ENDW
  {auto rr=__builtin_amdgcn_permlane32_swap(__float_as_uint(l_reg),__float_as_uint(l_reg),false,false);l_reg=__uint_as_float(rr[0])+__uint_as_float(rr[1]);}
  if(hi==0)wsf[32+r32]=l_reg;asm volatile("s_waitcnt lgkmcnt(0)":::"memory");
  float rli[16];
  #pragma unroll
  for(int r=0;r<16;++r)rli[r]=__builtin_amdgcn_rcpf(wsf[32+crow(r,hi)]);
  bf16*Ow=O+(rowbase+q0+wid*QBLK)*OP+h*D;
  { bf16*stg=(bf16*)(shm+LDS_OST)+wid*2048;
    #pragma unroll
    for(int r=0;r<16;++r){const int orow=crow(r,hi);
      #pragma unroll
      for(int d0=0;d0<2;++d0)stg[orow*64+d0*32+r32]=__float2bfloat16(o[d0][r]*rli[r]);}
    asm volatile("s_waitcnt lgkmcnt(0)":::"memory");
    #pragma unroll
    for(int i=0;i<4;++i){const int row=i*8+(lane>>3),ch=lane&7; const u32x4 v=*(const u32x4*)(stg+row*64+ch*8); ATTN_STORE16(Ow+(long)row*OP+ch*8,v);} }
  asm volatile("s_waitcnt lgkmcnt(0)\n\ts_barrier":::"memory");
  #undef DMA_K
  #undef DMA_V
  #undef CMASK
  #undef START
  #undef RESC
  #undef ROT
}
constexpr int ATTN_LDS_BYTES=LDS_BYTES;
struct AttnTensors { const bf16* Q; const bf16* K; const bf16* V; bf16* O; };
struct AttnUnit { int bh; int qb; };
struct StaticOrder {
  int vcu;
  __device__ __forceinline__ explicit StaticOrder(int grid,int block):vcu((block%8)*(grid/8)+block/8){}
  __device__ __forceinline__ bool next(int i,AttnUnit&u)const{ if(i>=4)return false; u.bh=vcu>>4; u.qb=(vcu&15)*4+i; return true; }
  __device__ __forceinline__ void a_ready(const AttnUnit&)const{}
  __device__ __forceinline__ void done(const AttnUnit&)const{}
};
template<class Sched,int THRL=8> __device__ __forceinline__ void attn_phase(char*lds,const AttnTensors&T,const Sched&S){
  AttnUnit u;
  for(int i=0;S.next(i,u);++i){ S.a_ready(u); attn_unit<THRL>(u.bh/NHEAD,u.bh%NHEAD,u.qb,T.Q,T.K,T.V,T.O,lds); S.done(u); }
}
#undef SBAR
#undef WAIT_BAR
}

struct Params {
    const float *x, *mem, *ln_in_g, *ln_in_b, *w_mem_kv, *w_in_a, *w_in_b, *q_norm_g, *k_norm_g, *w_in_c, *w_out, *ln_g, *ln_b;
    float* out; unsigned char* ws;
    int s0, s1;
};

DEV float bf2f(bf16_t b) { return __uint_as_float(((unsigned)b) << 16); }
DEV bf16_t f2bf(float f) { unsigned u = __float_as_uint(f); return (bf16_t)((u + 0x7fffu + ((u >> 16) & 1u)) >> 16); }
DEV unsigned pk2(float lo, float hi) { return (unsigned)f2bf(lo) | ((unsigned)f2bf(hi) << 16); }
DEV float wave_sum(float v) {
#pragma unroll
    for (int o = 1; o < 64; o <<= 1) v += __shfl_xor(v, o);
    return v;
}
DEV float silu(float x) { return x / (1.f + __expf(-x)); }
DEV void load8(const bf16_t* p, float* o) {
    u32x4 v = *(const u32x4*)p;
    o[0] = __uint_as_float(v.x << 16); o[1] = __uint_as_float(v.x & 0xffff0000u);
    o[2] = __uint_as_float(v.y << 16); o[3] = __uint_as_float(v.y & 0xffff0000u);
    o[4] = __uint_as_float(v.z << 16); o[5] = __uint_as_float(v.z & 0xffff0000u);
    o[6] = __uint_as_float(v.w << 16); o[7] = __uint_as_float(v.w & 0xffff0000u);
}
DEV void store8(bf16_t* p, const float* o) {
    u32x4 v; v.x = pk2(o[0], o[1]); v.y = pk2(o[2], o[3]); v.z = pk2(o[4], o[5]); v.w = pk2(o[6], o[7]);
    *(u32x4*)p = v;
}
DEV int ltid() { int t = threadIdx.x; asm volatile("" : "+v"(t)); return t; }
#define GTID ((size_t)blockIdx.x * blockDim.x + ltid())
#define GSZ ((size_t)gridDim.x * blockDim.x)

DEV void tconv(const float* src, int K, int Ntot, int ncols, bf16_t* dst, int mode) {
    const size_t total = (size_t)ncols * (K / 8);
    for (size_t idx = GTID; idx < total; idx += GSZ) {
        const int n = (int)(idx % ncols), kc = (int)(idx / ncols);
        int sc = n;
        if (mode == 1 && n < 9216) { const int g = n / 3072, rem = n % 3072, which = rem / 1024, r = rem % 1024; sc = which * 3072 + g * 1024 + r; }
        float v[8];
#pragma unroll
        for (int j = 0; j < 8; ++j) v[j] = src[(size_t)(kc * 8 + j) * Ntot + sc];
        store8(dst + (size_t)n * K + kc * 8, v);
    }
}
DEV void make_wdft(bf16_t* w) {
    for (size_t idx = GTID; idx < 512 * 256; idx += GSZ) {
        const int n = (int)(idx >> 8), c = (int)(idx & 255), which = n >> 8, l = n & 255;
        float s, co; sincospif((float)((l * c) & 255) / 128.f, &s, &co);
        w[idx] = f2bf(which == 0 ? co : -s);
    }
}
DEV void make_mkv(const float* mem, const float* w, bf16_t* MKb, bf16_t* MVp) {
    for (size_t idx = GTID; idx < 256 * 512; idx += GSZ) {
        const int m = (int)(idx >> 9), n = (int)(idx & 511);
        float a = 0.f;
        for (int k = 0; k < 1024; ++k) a += mem[m * 1024 + k] * w[(size_t)k * 512 + n];
        if (n < 256) MKb[m * 256 + n] = f2bf(a);
        else { const int np = n - 256, kt = m >> 5, s = (m >> 4) & 1, wv = m & 15, hi = (wv >> 2) & 1, e = (wv & 3) + 4 * (wv >> 3);
               MVp[((np * 8 + kt) * 2 + s) * 16 + hi * 8 + e] = f2bf(a); }
    }
}
DEV void make_rope1d(float* tab) {
    for (size_t idx = GTID; idx < (size_t)S_ * 32; idx += GSZ) {
        const int t = (int)(idx >> 5), i = (int)(idx & 31);
        const float inv = powf(10000.f, -((float)(2 * i) / 64.f));
        const float a = (float)t * inv;
        tab[idx * 2] = cosf(a); tab[idx * 2 + 1] = sinf(a);
    }
}
DEV void ln_rows(const float* a, const float* y, float alpha, const float* g, const float* b, float* outH, bf16_t* outXN) {
    const int lane = ltid() & 63, wpb = blockDim.x >> 6;
    const int gw = blockIdx.x * wpb + (ltid() >> 6), nw = gridDim.x * wpb;
    for (int row = gw; row < S_; row += nw) {
        f32x4 v[4]; float s = 0.f;
#pragma unroll
        for (int j = 0; j < 4; ++j) {
            v[j] = *(const f32x4*)(a + (size_t)row * DM + j * 256 + lane * 4);
            if (y) { const f32x4 u = *(const f32x4*)(y + (size_t)row * DM + j * 256 + lane * 4); v[j] = v[j] * alpha + u; }
            s += (v[j].x + v[j].y) + (v[j].z + v[j].w);
        }
        const float mean = wave_sum(s) * (1.f / DM); float s2 = 0.f;
#pragma unroll
        for (int j = 0; j < 4; ++j) { v[j] = v[j] - mean; s2 += (v[j].x * v[j].x + v[j].y * v[j].y) + (v[j].z * v[j].z + v[j].w * v[j].w); }
        const float rstd = 1.f / sqrtf(wave_sum(s2) * (1.f / DM) + LN_EPS);
#pragma unroll
        for (int j = 0; j < 4; ++j) {
            const f32x4 gg = *(const f32x4*)(g + j * 256 + lane * 4), bb = *(const f32x4*)(b + j * 256 + lane * 4);
            const f32x4 o = v[j] * rstd * gg + bb;
            *(f32x4*)(outH + (size_t)row * DM + j * 256 + lane * 4) = o;
            u32x2 w; w.x = pk2(o.x, o.y); w.y = pk2(o.z, o.w);
            *(u32x2*)(outXN + (size_t)row * DM + j * 256 + lane * 4) = w;
        }
    }
}
DEV void gemm_simple(const bf16_t* A, int lda, const bf16_t* Bt, int ldb, int M, int N, int K, void* C, int ldc, int f32out) {
    const int lane = ltid() & 63, wpb = blockDim.x >> 6;
    const int gw = blockIdx.x * wpb + (ltid() >> 6), nw = gridDim.x * wpb;
    const int tn = N / 64, tiles = (M / 64) * tn, fr = lane & 15, fq = lane >> 4;
    for (int t = gw; t < tiles; t += nw) {
        const int tm = t / tn, tc = t % tn;
        f32x4 acc[4][4];
#pragma unroll
        for (int i = 0; i < 4; ++i)
#pragma unroll
            for (int j = 0; j < 4; ++j) acc[i][j] = (f32x4){0.f, 0.f, 0.f, 0.f};
        const bf16_t* ap = A + (size_t)(tm * 64 + fr) * lda + fq * 8;
        const bf16_t* bp = Bt + (size_t)(tc * 64 + fr) * ldb + fq * 8;
        for (int k0 = 0; k0 < K; k0 += 32) {
            bf16x8 a[4], b[4];
#pragma unroll
            for (int i = 0; i < 4; ++i) { a[i] = *(const bf16x8*)(ap + (size_t)i * 16 * lda + k0); b[i] = *(const bf16x8*)(bp + (size_t)i * 16 * ldb + k0); }
#pragma unroll
            for (int i = 0; i < 4; ++i)
#pragma unroll
                for (int j = 0; j < 4; ++j) acc[i][j] = __builtin_amdgcn_mfma_f32_16x16x32_bf16(a[i], b[j], acc[i][j], 0, 0, 0);
        }
#pragma unroll
        for (int i = 0; i < 4; ++i)
#pragma unroll
            for (int j = 0; j < 4; ++j)
#pragma unroll
                for (int r = 0; r < 4; ++r) {
                    const size_t off = (size_t)(tm * 64 + i * 16 + fq * 4 + r) * ldc + tc * 64 + j * 16 + fr;
                    if (f32out) ((float*)C)[off] = acc[i][j][r]; else ((bf16_t*)C)[off] = f2bf(acc[i][j][r]);
                }
    }
}
DEV int zc(int j) { return ((j >> 8) << 9) + (j & 255); }
DEV void fft_tab(float* tab) {
    __syncthreads();
    for (int i = ltid(); i < 128; i += blockDim.x) { float s, c; sincospif((float)i / 64.f, &s, &c); tab[i] = c; tab[128 + i] = s; }
    __syncthreads();
}
DEV void fft_s1(const bf16_t* Z, bf16_t* T, float* tab) {
    fft_tab(tab);
    const size_t total = (size_t)S_ * 1024;
    for (size_t idx = GTID; idx < total; idx += GSZ) {
        const int j = (int)(idx & 1023), r = (int)(idx >> 10), k1 = r >> 7, s2 = r & 127, cj = zc(j);
        float ar = 0.f, ai = 0.f;
        for (int s1 = 0; s1 < 128; ++s1) {
            const int n = (s1 * k1) & 127; const float c = tab[n], s = tab[128 + n];
            const bf16_t* zp = Z + (size_t)(128 * s1 + s2) * 2048 + cj;
            const float zr = bf2f(zp[0]), zi = bf2f(zp[256]);
            ar += zr * c + zi * s; ai += zi * c - zr * s;
        }
        float ts, tc; sincospif((float)(s2 * k1) / 8192.f, &ts, &tc);
        const float tr = ar * tc + ai * ts, ti = ai * tc - ar * ts;
        T[(size_t)r * 2048 + cj] = f2bf(tr); T[(size_t)r * 2048 + cj + 256] = f2bf(ti);
    }
}
DEV void fft_s2(const bf16_t* T, bf16_t* BR, float* tab) {
    fft_tab(tab);
    const size_t total = (size_t)S_ * 1024;
    for (size_t idx = GTID; idx < total; idx += GSZ) {
        const int j = (int)(idx & 1023), k = (int)(idx >> 10), k1 = k & 127, k2 = k >> 7, cj = zc(j);
        float acc = 0.f;
        for (int s2 = 0; s2 < 128; ++s2) {
            const int n = (s2 * k2) & 127; const float c = tab[n], s = tab[128 + n];
            const bf16_t* tp = T + (size_t)(k1 * 128 + s2) * 2048 + cj;
            acc += bf2f(tp[0]) * c + bf2f(tp[256]) * s;
        }
        BR[(size_t)k * 1024 + j] = f2bf(acc * (1.f / 2048.f));
    }
}

typedef float f32x16 __attribute__((ext_vector_type(16)));
constexpr int FT_LD = 136;
DEV void fft_tables(bf16_t* Ct, bf16_t* St) {
    __syncthreads();
    for (int e = ltid(); e < 128 * 128; e += blockDim.x) { const int r = e >> 7, c = e & 127; float s, co; sincospif((float)((r * c) & 127) / 64.f, &s, &co); Ct[r * FT_LD + c] = f2bf(co); St[r * FT_LD + c] = f2bf(s); }
    __syncthreads();
}
DEV int crow16(int r, int hi) { return (r & 3) + 8 * (r >> 2) + 4 * hi; }
DEV void fft_s1_mfma(const bf16_t* Z, bf16_t* T, unsigned char* lds_raw) {
    bf16_t* Ct = (bf16_t*)lds_raw; bf16_t* St = Ct + 128 * FT_LD;
    fft_tables(Ct, St);
    const int tid = ltid(), lane = tid & 63, r32 = lane & 31, hi = lane >> 5, wpb = blockDim.x >> 6;
    const int gw = blockIdx.x * wpb + (tid >> 6), nw = gridDim.x * wpb;
    for (int task = gw; task < 128 * 32; task += nw) {
        const int s2 = task >> 5, jt = task & 31, j = jt * 32 + r32, cj = zc(j);
        const bf16_t* zp = Z + (size_t)s2 * 2048 + cj;
        f32x16 ore[4], oim[4];
#pragma unroll
        for (int mt = 0; mt < 4; ++mt)
#pragma unroll
            for (int r = 0; r < 16; ++r) { ore[mt][r] = 0.f; oim[mt][r] = 0.f; }
#pragma unroll 1
        for (int sh = 0; sh < 2; ++sh) {
            bf16x8 zr[4], zi[4];
#pragma unroll
            for (int s = 0; s < 4; ++s)
#pragma unroll
                for (int e = 0; e < 8; ++e) { const size_t off = (size_t)(64 * sh + 16 * s + 8 * hi + e) * (128 * 2048); zr[s][e] = (short)zp[off]; zi[s][e] = (short)zp[off + 256]; }
#pragma unroll
            for (int s = 0; s < 4; ++s) {
                bf16x8 nzr;
#pragma unroll
                for (int e = 0; e < 8; ++e) nzr[e] = (short)(zr[s][e] ^ (short)0x8000);
#pragma unroll
                for (int mt = 0; mt < 4; ++mt) {
                    const bf16x8 c = *(const bf16x8*)(Ct + (mt * 32 + r32) * FT_LD + 64 * sh + 16 * s + 8 * hi);
                    const bf16x8 sn = *(const bf16x8*)(St + (mt * 32 + r32) * FT_LD + 64 * sh + 16 * s + 8 * hi);
                    ore[mt] = __builtin_amdgcn_mfma_f32_32x32x16_bf16(c, zr[s], ore[mt], 0, 0, 0);
                    ore[mt] = __builtin_amdgcn_mfma_f32_32x32x16_bf16(sn, zi[s], ore[mt], 0, 0, 0);
                    oim[mt] = __builtin_amdgcn_mfma_f32_32x32x16_bf16(c, zi[s], oim[mt], 0, 0, 0);
                    oim[mt] = __builtin_amdgcn_mfma_f32_32x32x16_bf16(sn, nzr, oim[mt], 0, 0, 0);
                }
            }
        }
#pragma unroll
        for (int mt = 0; mt < 4; ++mt)
#pragma unroll
            for (int r = 0; r < 16; ++r) {
                const int k1 = mt * 32 + crow16(r, hi);
                const float xr = (float)(s2 * k1) * (1.f / 16384.f);
                const float tc = __builtin_amdgcn_cosf(xr), ts = __builtin_amdgcn_sinf(xr);
                const float ar = ore[mt][r], ai = oim[mt][r];
                bf16_t* tp = T + (size_t)(k1 * 128 + s2) * 2048 + cj;
                tp[0] = f2bf(ar * tc + ai * ts); tp[256] = f2bf(ai * tc - ar * ts);
            }
    }
    __syncthreads();
}
DEV void fft_s2_mfma(const bf16_t* T, bf16_t* BR, unsigned char* lds_raw) {
    bf16_t* Ct = (bf16_t*)lds_raw; bf16_t* St = Ct + 128 * FT_LD;
    fft_tables(Ct, St);
    const int tid = ltid(), lane = tid & 63, r32 = lane & 31, hi = lane >> 5, wpb = blockDim.x >> 6;
    const int gw = blockIdx.x * wpb + (tid >> 6), nw = gridDim.x * wpb;
    for (int task = gw; task < 128 * 32; task += nw) {
        const int k1 = task >> 5, jt = task & 31, j = jt * 32 + r32, cj = zc(j);
        const bf16_t* tp = T + (size_t)(k1 * 128) * 2048 + cj;
        bf16x8 tr[8], ti[8];
#pragma unroll
        for (int s = 0; s < 8; ++s)
#pragma unroll
            for (int e = 0; e < 8; ++e) { const size_t off = (size_t)(16 * s + 8 * hi + e) * 2048; tr[s][e] = (short)tp[off]; ti[s][e] = (short)tp[off + 256]; }
        f32x16 o[4];
#pragma unroll
        for (int mt = 0; mt < 4; ++mt)
#pragma unroll
            for (int r = 0; r < 16; ++r) o[mt][r] = 0.f;
#pragma unroll
        for (int s = 0; s < 8; ++s)
#pragma unroll
            for (int mt = 0; mt < 4; ++mt) {
                const bf16x8 c = *(const bf16x8*)(Ct + (mt * 32 + r32) * FT_LD + 16 * s + 8 * hi);
                const bf16x8 sn = *(const bf16x8*)(St + (mt * 32 + r32) * FT_LD + 16 * s + 8 * hi);
                o[mt] = __builtin_amdgcn_mfma_f32_32x32x16_bf16(c, tr[s], o[mt], 0, 0, 0);
                o[mt] = __builtin_amdgcn_mfma_f32_32x32x16_bf16(sn, ti[s], o[mt], 0, 0, 0);
            }
#pragma unroll
        for (int mt = 0; mt < 4; ++mt)
#pragma unroll
            for (int r = 0; r < 16; ++r) {
                const int k = k1 + 128 * (mt * 32 + crow16(r, hi));
                BR[(size_t)k * 1024 + j] = f2bf(o[mt][r] * (1.f / 2048.f));
            }
    }
    __syncthreads();
}
DEV void qk_post(bf16_t* PROJ, const float* qg, const float* kg) {
    const size_t total = (size_t)S_ * 20 * 16;
    for (size_t idx = GTID; idx < total; idx += GSZ) {
        const int i = (int)(idx & 15), head = (int)((idx >> 4) % 20), t = (int)((idx >> 4) / 20);
        bf16_t* p = PROJ + (size_t)t * 3072 + head * 64;
        float a1 = bf2f(p[i]), a2 = bf2f(p[16 + i]), b1 = bf2f(p[32 + i]), b2 = bf2f(p[48 + i]);
        float ss = a1 * a1 + a2 * a2 + b1 * b1 + b2 * b2;
        ss += __shfl_xor(ss, 1); ss += __shfl_xor(ss, 2); ss += __shfl_xor(ss, 4); ss += __shfl_xor(ss, 8);
        const float r = 1.f / sqrtf(ss * (1.f / 64.f) + 1e-6f);
        const float* g = head < 16 ? qg : kg;
        a1 *= r * g[i]; a2 *= r * g[16 + i]; b1 *= r * g[32 + i]; b2 *= r * g[48 + i];
        const float frow = (float)(t >> 6), fcol = (float)(t & 63);
        const float sc = head < 16 ? C2 : 1.f;
        const float inv = powf(10000.f, -((float)(2 * i) / 32.f));
        const float ar = frow * inv, ac = fcol * inv;
        const float cr = cosf(ar), sr = sinf(ar), cc = cosf(ac), scn = sinf(ac);
        p[i] = f2bf((a1 * cr - a2 * sr) * sc); p[16 + i] = f2bf((a2 * cr + a1 * sr) * sc);
        p[32 + i] = f2bf((b1 * cc - b2 * scn) * sc); p[48 + i] = f2bf((b2 * cc + b1 * scn) * sc);
    }
}
DEV void attn_naive(const bf16_t* PROJ, bf16_t* BR, float* lds) {
    const int nth = blockDim.x, qblocks = S_ / nth, items = 16 * qblocks;
    float* Ks = lds; float* Vs = lds + 64 * 64;
    for (int it = blockIdx.x; it < items; it += gridDim.x) {
        const int hq = it / qblocks, qb = it % qblocks, kvh = hq >> 2, t = qb * nth + ltid();
        float q[64], o[64]; float m = -1e30f, l = 0.f;
#pragma unroll
        for (int c = 0; c < 8; ++c) load8(PROJ + (size_t)t * 3072 + hq * 64 + c * 8, q + c * 8);
#pragma unroll
        for (int d = 0; d < 64; ++d) o[d] = 0.f;
        for (int k0 = 0; k0 < S_; k0 += 64) {
            __syncthreads();
            for (int e = ltid(); e < 64 * 8; e += nth) {
                const int r = e >> 3, c8 = e & 7; float tmp[8];
                load8(PROJ + (size_t)(k0 + r) * 3072 + 1024 + kvh * 64 + c8 * 8, tmp);
#pragma unroll
                for (int j = 0; j < 8; ++j) Ks[r * 64 + c8 * 8 + j] = tmp[j];
                load8(PROJ + (size_t)(k0 + r) * 3072 + 1280 + kvh * 64 + c8 * 8, tmp);
#pragma unroll
                for (int j = 0; j < 8; ++j) Vs[r * 64 + c8 * 8 + j] = tmp[j];
            }
            __syncthreads();
            for (int r = 0; r < 64; ++r) {
                float s = 0.f;
#pragma unroll
                for (int d = 0; d < 64; d += 4) { const f32x4 kk = *(const f32x4*)(Ks + r * 64 + d); s += q[d] * kk.x + q[d + 1] * kk.y + q[d + 2] * kk.z + q[d + 3] * kk.w; }
                if (s > m) { const float f = exp2f(m - s); l *= f;
#pragma unroll
                    for (int d = 0; d < 64; ++d) o[d] *= f;
                    m = s; }
                const float p = exp2f(s - m); l += p;
#pragma unroll
                for (int d = 0; d < 64; d += 4) { const f32x4 vv = *(const f32x4*)(Vs + r * 64 + d); o[d] += p * vv.x; o[d + 1] += p * vv.y; o[d + 2] += p * vv.z; o[d + 3] += p * vv.w; }
            }
        }
        const float rl = 1.f / l;
#pragma unroll
        for (int d = 0; d < 64; ++d) o[d] *= rl;
#pragma unroll
        for (int c = 0; c < 8; ++c) store8(BR + (size_t)t * 1024 + hq * 64 + c * 8, o + c * 8);
    }
    __syncthreads();
}
DEV void rope_c(bf16_t* QKV, const float* tab) {
    const size_t total = (size_t)S_ * 32;
    for (size_t idx = GTID; idx < total; idx += GSZ) {
        const int hh = (int)(idx & 31), t = (int)(idx >> 5);
        bf16_t* p = QKV + (size_t)t * 3072 + hh * 64;
        float x[64];
#pragma unroll
        for (int c = 0; c < 8; ++c) load8(p + c * 8, x + c * 8);
        const float sc = hh < 16 ? C2 : 1.f;
        const float* tb = tab + (size_t)t * 64;
#pragma unroll
        for (int i = 0; i < 32; ++i) {
            const float c = tb[2 * i], s = tb[2 * i + 1];
            const float a1 = x[i], a2 = x[32 + i];
            x[i] = (a1 * c - a2 * s) * sc; x[32 + i] = (a2 * c + a1 * s) * sc;
        }
#pragma unroll
        for (int c = 0; c < 8; ++c) store8(p + c * 8, x + c * 8);
    }
}
DEV void dil_naive(const bf16_t* QKV, float* OACC, float* ML, int g) {
    const int dil = g == 0 ? 1 : (g == 1 ? 4 : 16);
    const size_t total = (size_t)16 * S_;
    for (size_t idx = GTID; idx < total; idx += GSZ) {
        const int head = (int)(idx >> 14), t = (int)(idx & 16383);
        float q[64], o[64]; float m, l;
#pragma unroll
        for (int c = 0; c < 8; ++c) load8(QKV + (size_t)t * 3072 + head * 64 + c * 8, q + c * 8);
        if (g == 0) { m = -1e30f; l = 0.f;
#pragma unroll
            for (int d = 0; d < 64; ++d) o[d] = 0.f;
        } else {
            m = ML[((size_t)t * 16 + head) * 2]; l = ML[((size_t)t * 16 + head) * 2 + 1];
#pragma unroll
            for (int d = 0; d < 64; d += 4) { const f32x4 v = *(const f32x4*)(OACC + (size_t)t * 1024 + head * 64 + d); o[d] = v.x; o[d + 1] = v.y; o[d + 2] = v.z; o[d + 3] = v.w; }
        }
        for (int mm = -64; mm <= 64; ++mm) {
            const int tk = t + mm * dil;
            if (tk < 0 || tk >= S_) continue;
            const bf16_t* kp = QKV + (size_t)tk * 3072 + 1024 + head * 64;
            float s = 0.f;
#pragma unroll
            for (int c = 0; c < 8; ++c) { float kk[8]; load8(kp + c * 8, kk);
#pragma unroll
                for (int j = 0; j < 8; ++j) s += q[c * 8 + j] * kk[j]; }
            if (s > m) { const float f = exp2f(m - s); l *= f;
#pragma unroll
                for (int d = 0; d < 64; ++d) o[d] *= f;
                m = s; }
            const float p = exp2f(s - m); l += p;
#pragma unroll
            for (int c = 0; c < 8; ++c) { float vv[8]; load8(kp + 1024 + c * 8, vv);
#pragma unroll
                for (int j = 0; j < 8; ++j) o[c * 8 + j] += p * vv[j]; }
        }
        ML[((size_t)t * 16 + head) * 2] = m; ML[((size_t)t * 16 + head) * 2 + 1] = l;
#pragma unroll
        for (int d = 0; d < 64; d += 4) *(f32x4*)(OACC + (size_t)t * 1024 + head * 64 + d) = (f32x4){o[d], o[d + 1], o[d + 2], o[d + 3]};
    }
}

DEV void dil_mfma(const bf16_t* QKV, float* OACC, float* ML, int g) {
    const int sh = 2 * g, dil = 1 << sh, L = S_ >> sh, nqb = L >> 5;
    const int tid = ltid(), lane = tid & 63, r32 = lane & 31, hi = lane >> 5, wpb = blockDim.x >> 6;
    const int gw = blockIdx.x * wpb + (tid >> 6), nw = gridDim.x * wpb;
    for (int task = gw; task < 16 * 512; task += nw) {
        const int a = task % nqb, hc = task / nqb, c = hc & (dil - 1), head = hc >> sh;
        const int tq = ((32 * a + r32) << sh) + c;
        const bf16_t* qp = QKV + (size_t)tq * 3072 + head * 64 + 8 * hi;
        bf16x8 qf[4];
#pragma unroll
        for (int ks = 0; ks < 4; ++ks) qf[ks] = *(const bf16x8*)(qp + 16 * ks);
        f32x16 st[5];
#pragma unroll
        for (int kt = 0; kt < 5; ++kt) {
            int jj = 32 * a - 64 + 32 * kt + r32; jj = jj < 0 ? 0 : (jj > L - 1 ? L - 1 : jj);
            const bf16_t* kp = QKV + (size_t)((jj << sh) + c) * 3072 + 1024 + head * 64 + 8 * hi;
#pragma unroll
            for (int r = 0; r < 16; ++r) st[kt][r] = 0.f;
#pragma unroll
            for (int ks = 0; ks < 4; ++ks) st[kt] = __builtin_amdgcn_mfma_f32_32x32x16_bf16(*(const bf16x8*)(kp + 16 * ks), qf[ks], st[kt], 0, 0, 0);
        }
        float mx = -1e30f;
#pragma unroll
        for (int kt = 0; kt < 5; ++kt)
#pragma unroll
            for (int r = 0; r < 16; ++r) {
                const int kvl = 32 * kt + crow16(r, hi), jj = 32 * a - 64 + kvl;
                const bool valid = (kvl >= r32) && (kvl <= r32 + 128) && (jj >= 0) && (jj < L);
                const float v = valid ? st[kt][r] : -1e30f; st[kt][r] = v; mx = fmaxf(mx, v);
            }
        mx = fmaxf(mx, __shfl_xor(mx, 32));
        float m_old = -1e30f, l_old = 0.f;
        if (g != 0) { m_old = ML[((size_t)tq * 16 + head) * 2]; l_old = ML[((size_t)tq * 16 + head) * 2 + 1]; }
        const float m_new = fmaxf(m_old, mx), f = exp2f(m_old - m_new);
        float ls = 0.f;
#pragma unroll
        for (int kt = 0; kt < 5; ++kt)
#pragma unroll
            for (int r = 0; r < 16; ++r) { const float pv = exp2f(st[kt][r] - m_new); st[kt][r] = pv; ls += pv; }
        ls += __shfl_xor(ls, 32);
        const float l_new = l_old * f + ls;
        f32x16 o[2];
#pragma unroll
        for (int dt = 0; dt < 2; ++dt)
#pragma unroll
            for (int r = 0; r < 16; ++r) o[dt][r] = 0.f;
#pragma unroll
        for (int kt = 0; kt < 5; ++kt)
#pragma unroll
            for (int s = 0; s < 2; ++s) {
                bf16x8 pf;
#pragma unroll
                for (int e = 0; e < 8; ++e) pf[e] = (short)f2bf(st[kt][8 * s + e]);
                const bf16_t* vrow[8];
#pragma unroll
                for (int e = 0; e < 8; ++e) {
                    int jj = 32 * a - 64 + 32 * kt + 16 * s + (e & 3) + 8 * (e >> 2) + 4 * hi; jj = jj < 0 ? 0 : (jj > L - 1 ? L - 1 : jj);
                    vrow[e] = QKV + (size_t)((jj << sh) + c) * 3072 + 2048 + head * 64 + r32;
                }
#pragma unroll
                for (int dt = 0; dt < 2; ++dt) {
                    bf16x8 vf;
#pragma unroll
                    for (int e = 0; e < 8; ++e) vf[e] = (short)vrow[e][32 * dt];
                    o[dt] = __builtin_amdgcn_mfma_f32_32x32x16_bf16(vf, pf, o[dt], 0, 0, 0);
                }
            }
        float* op = OACC + (size_t)tq * 1024 + head * 64 + 4 * hi;
#pragma unroll
        for (int dt = 0; dt < 2; ++dt)
#pragma unroll
            for (int i = 0; i < 4; ++i) {
                f32x4 old = (f32x4){0.f, 0.f, 0.f, 0.f};
                if (g != 0) old = *(const f32x4*)(op + 32 * dt + 8 * i);
                const f32x4 nw4 = (f32x4){o[dt][4 * i], o[dt][4 * i + 1], o[dt][4 * i + 2], o[dt][4 * i + 3]};
                *(f32x4*)(op + 32 * dt + 8 * i) = old * f + nw4;
            }
        if (hi == 0) { ML[((size_t)tq * 16 + head) * 2] = m_new; ML[((size_t)tq * 16 + head) * 2 + 1] = l_new; }
    }
}
DEV void gate_naive(const bf16_t* BR, const float* OACC, const float* ML, const bf16_t* TAIL, int ldt, const float* MKV, bf16_t* YIN) {
    const size_t total = (size_t)S_ * 1024;
    for (size_t idx = GTID; idx < total; idx += GSZ) {
        const int c = (int)(idx & 1023), t = (int)(idx >> 10);
        const float br = OACC ? OACC[idx] / ML[((size_t)t * 16 + (c >> 6)) * 2 + 1] : bf2f(BR[idx]);
        const float gt = bf2f(TAIL[(size_t)t * ldt + c]);
        YIN[(size_t)t * 1280 + c] = f2bf(br * silu(gt));
    }
    const size_t total2 = (size_t)4 * S_;
    for (size_t idx = GTID; idx < total2; idx += GSZ) {
        const int mh = (int)(idx >> 14), t = (int)(idx & 16383);
        float q[64], o[64]; float m = -1e30f, l = 0.f;
#pragma unroll
        for (int c = 0; c < 8; ++c) load8(TAIL + (size_t)t * ldt + 1280 + mh * 64 + c * 8, q + c * 8);
#pragma unroll
        for (int d = 0; d < 64; ++d) { q[d] *= C2; o[d] = 0.f; }
        for (int mm = 0; mm < 256; ++mm) {
            const float* kp = MKV + (size_t)mm * 512 + mh * 64;
            float s = 0.f;
#pragma unroll
            for (int d = 0; d < 64; ++d) s += q[d] * kp[d];
            if (s > m) { const float f = exp2f(m - s); l *= f;
#pragma unroll
                for (int d = 0; d < 64; ++d) o[d] *= f;
                m = s; }
            const float p = exp2f(s - m); l += p;
#pragma unroll
            for (int d = 0; d < 64; ++d) o[d] += p * kp[256 + d];
        }
        const float rl = 1.f / l;
#pragma unroll
        for (int c = 0; c < 8; ++c) { float gt[8]; load8(TAIL + (size_t)t * ldt + 1024 + mh * 64 + c * 8, gt);
#pragma unroll
            for (int j = 0; j < 8; ++j) o[c * 8 + j] = o[c * 8 + j] * rl * silu(gt[j]); }
#pragma unroll
        for (int c = 0; c < 8; ++c) store8(YIN + (size_t)t * 1280 + 1024 + mh * 64 + c * 8, o + c * 8);
    }
}


#define LAS3 __attribute__((address_space(3)))
DEV void gemm_bf16(unsigned char* lds_raw, const bf16_t* A, int lda, const bf16_t* Bt, int M, int N, int K, bf16_t* C, int ldc, int G, int c) {
    pg8::Gemm g{A, Bt, M, N, K, lda}; pg8::StaticOrder So; So.init(M, N, G, c);
    pg8::EpiBf16<0> E{C, ldc, nullptr, 0, 0, 1.f};
    pg8::gemm_phase<pg8::EpiBf16<0>, pg8::StaticOrder, PG8_ALIGN, PG8_SP2>((LAS3 unsigned char*)lds_raw, g, So, E);
}
DEV void gemm_f32(unsigned char* lds_raw, const bf16_t* A, int lda, const bf16_t* Bt, int M, int N, int K, float* C, int ldc, int G, int c) {
    pg8::Gemm g{A, Bt, M, N, K, lda}; pg8::StaticOrder So; So.init(M, N, G, c);
    pg8::EpiF32 E{C, ldc};
    pg8::gemm_phase<pg8::EpiF32, pg8::StaticOrder, PG8_ALIGN, PG8_SP2>((LAS3 unsigned char*)lds_raw, g, So, E);
}

DEV void gate_fast(const bf16_t* BR, const float* OACC, const float* ML, const bf16_t* TAIL, int ldt, const bf16_t* MKb, const bf16_t* MVp, bf16_t* YIN) {
    if (BR || OACC) {
        const size_t total = (size_t)S_ * 128;
        for (size_t idx = GTID; idx < total; idx += GSZ) {
            const int c = (int)(idx & 127) * 8, t = (int)(idx >> 7);
            float br[8], gt[8];
            if (OACC) {
                const float rl = 1.f / ML[((size_t)t * 16 + (c >> 6)) * 2 + 1];
                const f32x4 a = *(const f32x4*)(OACC + (size_t)t * 1024 + c), b = *(const f32x4*)(OACC + (size_t)t * 1024 + c + 4);
                br[0] = a.x * rl; br[1] = a.y * rl; br[2] = a.z * rl; br[3] = a.w * rl; br[4] = b.x * rl; br[5] = b.y * rl; br[6] = b.z * rl; br[7] = b.w * rl;
            } else load8(BR + (size_t)t * 1024 + c, br);
            load8(TAIL + (size_t)t * ldt + c, gt);
#pragma unroll
            for (int e = 0; e < 8; ++e) br[e] *= silu(gt[e]);
            store8(YIN + (size_t)t * 1280 + c, br);
        }
    }
    const int tid = ltid(), lane = tid & 63, r32 = lane & 31, hi = lane >> 5, wpb = blockDim.x >> 6;
    const int gw = blockIdx.x * wpb + (tid >> 6), nw = gridDim.x * wpb;
    for (int task = gw; task < 512 * 4; task += nw) {
        const int tb = task >> 2, mh = task & 3, t = tb * 32 + r32;
        const bf16_t* trow = TAIL + (size_t)t * ldt;
        bf16x8 qf[4];
#pragma unroll
        for (int ks = 0; ks < 4; ++ks) qf[ks] = *(const bf16x8*)(trow + 1280 + mh * 64 + 16 * ks + 8 * hi);
        f32x16 st[8];
#pragma unroll
        for (int kt = 0; kt < 8; ++kt) {
#pragma unroll
            for (int r = 0; r < 16; ++r) st[kt][r] = 0.f;
            const bf16_t* kp = MKb + (size_t)(32 * kt + r32) * 256 + mh * 64 + 8 * hi;
#pragma unroll
            for (int ks = 0; ks < 4; ++ks) st[kt] = __builtin_amdgcn_mfma_f32_32x32x16_bf16(*(const bf16x8*)(kp + 16 * ks), qf[ks], st[kt], 0, 0, 0);
        }
        float mx = -1e30f;
#pragma unroll
        for (int kt = 0; kt < 8; ++kt)
#pragma unroll
            for (int r = 0; r < 16; ++r) mx = fmaxf(mx, st[kt][r]);
        mx = fmaxf(mx, __shfl_xor(mx, 32));
        float ls = 0.f;
#pragma unroll
        for (int kt = 0; kt < 8; ++kt)
#pragma unroll
            for (int r = 0; r < 16; ++r) { const float pv = exp2f((st[kt][r] - mx) * C2); st[kt][r] = pv; ls += pv; }
        ls += __shfl_xor(ls, 32);
        f32x16 o[2];
#pragma unroll
        for (int dt = 0; dt < 2; ++dt)
#pragma unroll
            for (int r = 0; r < 16; ++r) o[dt][r] = 0.f;
#pragma unroll
        for (int kt = 0; kt < 8; ++kt)
#pragma unroll
            for (int s = 0; s < 2; ++s) {
                bf16x8 pf;
#pragma unroll
                for (int e = 0; e < 8; ++e) pf[e] = (short)f2bf(st[kt][8 * s + e]);
#pragma unroll
                for (int dt = 0; dt < 2; ++dt) {
                    const bf16x8 vf = *(const bf16x8*)(MVp + (size_t)(((mh * 64 + 32 * dt + r32) * 8 + kt) * 2 + s) * 16 + hi * 8);
                    o[dt] = __builtin_amdgcn_mfma_f32_32x32x16_bf16(vf, pf, o[dt], 0, 0, 0);
                }
            }
        const float rl = 1.f / ls;
#pragma unroll
        for (int dt = 0; dt < 2; ++dt)
#pragma unroll
            for (int i = 0; i < 4; ++i) {
                const int d = 32 * dt + 8 * i + 4 * hi;
                const u32x2 gw2 = *(const u32x2*)(trow + 1024 + mh * 64 + d);
                const float g0 = __uint_as_float(gw2.x << 16), g1 = __uint_as_float(gw2.x & 0xffff0000u), g2 = __uint_as_float(gw2.y << 16), g3 = __uint_as_float(gw2.y & 0xffff0000u);
                u32x2 w; w.x = pk2(o[dt][4 * i] * rl * silu(g0), o[dt][4 * i + 1] * rl * silu(g1)); w.y = pk2(o[dt][4 * i + 2] * rl * silu(g2), o[dt][4 * i + 3] * rl * silu(g3));
                *(u32x2*)(YIN + (size_t)t * 1280 + 1024 + mh * 64 + d) = w;
            }
    }
}

#define LAS __attribute__((address_space(3)))
#define XB_TMO      128
#define XB_XCNT(j)  (256  + 64 * (j))
#define XB_XSUB(j)  (1280 + 64 * (j))
#define XB_XGEN(j)  (2304 + 64 * (j))
#define XB_TOP      3328
#define XB_TOPGEN   3392
#define XCD_BAR_WORDS 3456
#define XB_SPIN_CAP (1u << 18)

__device__ __forceinline__ unsigned xb_ld(unsigned* p)              { return __hip_atomic_load(p, __ATOMIC_RELAXED, __HIP_MEMORY_SCOPE_AGENT); }
__device__ __forceinline__ unsigned xb_add(unsigned* p, unsigned v) { return __hip_atomic_fetch_add(p, v, __ATOMIC_RELAXED, __HIP_MEMORY_SCOPE_AGENT); }
__device__ __forceinline__ unsigned xb_xcc_id() { return (unsigned)__builtin_amdgcn_s_getreg((3 << 11) | 20) & 0xFu; }
#define XB_SPIN(cond, bar) do { unsigned _sp = 0; while (cond) { __builtin_amdgcn_s_sleep(1); \
    if ((++_sp & 255u) == 0u) { if (xb_ld(&(bar)[XB_TMO])) break; if (_sp > XB_SPIN_CAP) { atomicAdd(&(bar)[XB_TMO], 1u); break; } } } } while (0)

struct XcdBarrier {
    unsigned* bar; unsigned x;
    volatile LAS unsigned* st;
};

__device__ __forceinline__ XcdBarrier xcd_barrier_post(unsigned* bar, volatile LAS unsigned* st) {
    XcdBarrier b; b.bar = bar; b.x = xb_xcc_id(); b.st = st;
    if (threadIdx.x == 0) (void)xb_add(&bar[XB_XCNT(b.x)], 1u);
    return b;
}
__device__ __forceinline__ void xcd_barrier_complete(unsigned* bar, unsigned x, unsigned& nloc, unsigned& nx) {
    const unsigned G = gridDim.x * gridDim.y * gridDim.z;
    unsigned sum, cnt, mine, sp = 0u;
    for (;;) {
        sum = 0u; cnt = 0u; mine = 0u;
#pragma unroll
        for (unsigned j = 0; j < 16; ++j) { const unsigned c = xb_ld(&bar[XB_XCNT(j)]); sum += c; cnt += (c > 0u) ? 1u : 0u; mine = (j == x) ? c : mine; }
        if (sum == G) break;
        __builtin_amdgcn_s_sleep(1);
        if ((++sp & 255u) == 0u) { if (xb_ld(&bar[XB_TMO])) break; if (sp > XB_SPIN_CAP) { atomicAdd(&bar[XB_TMO], 1u); break; } }
    }
    nloc = mine > 0u ? mine : 1u; nx = cnt > 0u ? cnt : 1u;
}

__device__ __forceinline__ void xcd_barrier(const XcdBarrier& b) {
    asm volatile("s_waitcnt vmcnt(0)" ::: "memory");
    __syncthreads();
    if (threadIdx.x == 0) {
        unsigned* bar = b.bar;
        __builtin_amdgcn_s_waitcnt(0);
        unsigned nloc = b.st[0], nx = b.st[1];
        if (nloc == 0u) { xcd_barrier_complete(bar, b.x, nloc, nx); b.st[0] = nloc; b.st[1] = nx; }
        const unsigned old = xb_add(&bar[XB_XSUB(b.x)], 1u);
        const unsigned gen = old / nloc;
        if (old + 1u == (gen + 1u) * nloc) {
            __builtin_amdgcn_fence(__ATOMIC_RELEASE, "agent");
            asm volatile("s_waitcnt vmcnt(0)" ::: "memory");
            const unsigned og = xb_add(&bar[XB_TOP], 1u);
            const unsigned tg = og / nx;
            if (og + 1u == (tg + 1u) * nx) xb_add(&bar[XB_TOPGEN], 1u);
            else XB_SPIN(xb_ld(&bar[XB_TOPGEN]) == tg, bar);
            __builtin_amdgcn_fence(__ATOMIC_ACQUIRE, "agent");
            xb_add(&bar[XB_XGEN(b.x)], 1u);
            asm volatile("s_waitcnt vmcnt(0)" ::: "memory");
        } else {
            XB_SPIN(xb_ld(&bar[XB_XGEN(b.x)]) == gen, bar);
            __builtin_amdgcn_fence(__ATOMIC_ACQUIRE, "agent");
            asm volatile("s_waitcnt vmcnt(0)" ::: "memory");
        }
    }
    __syncthreads();
}
DEV void seam(const Params& p, unsigned char* lds_raw) {
    unsigned char* w = p.ws; asm volatile("" : "+s"(w));
    XcdBarrier b; b.bar = (unsigned*)(w + 16384); b.st = (volatile LAS unsigned*)((LAS unsigned char*)lds_raw + (LDS_BYTES - 64)); b.x = b.st[2];
    xcd_barrier(b);
}
#define STEP_BEGIN { unsigned char* ws = p.ws; asm volatile("" : "+s"(ws)); float* H = p.out; float* lds = (float*)lds_raw;
#define STEP_END   } seam(p, lds_raw);
#define AR(off) (ws + WS_AR + (size_t)(off) * MiB)
#define P_WtA ((bf16_t*)(ws + WS_WA))
#define P_WtB ((bf16_t*)(ws + WS_WB))
#define P_WtC ((bf16_t*)(ws + WS_WC))
#define P_WtO ((bf16_t*)(ws + WS_WO))
#define P_Wdft ((bf16_t*)(ws + WS_WDFT))
#define P_MKB ((bf16_t*)(ws + WS_MKV))
#define P_MVP ((bf16_t*)(ws + WS_MKV + 131072))
#define P_XN ((bf16_t*)(ws + WS_XN))
#define GC (int)gridDim.x, (int)blockIdx.x
#define LNG (p.ln_g + LAYER * 1024)
#define LNB (p.ln_b + LAYER * 1024)
#define WO (P_WtO + (size_t)LAYER * 1024 * 1280)

template <int LAYER> DEV void layer_A(const Params& p, unsigned char* lds_raw) {
    STEP_BEGIN
        gemm_bf16(lds_raw, P_XN, 1024, P_WtA + (size_t)(LAYER / 3) * 1536 * 1024, S_, 1536, 1024, (bf16_t*)AR(0), 1536, GC);
        if ((gridDim.x & 3) == 0) { const int g = blockIdx.x & 3; gemm_bf16(lds_raw, P_XN + g * 256, 1024, P_Wdft, S_, 512, 256, (bf16_t*)AR(48) + g * 512, 2048, (int)gridDim.x >> 2, (int)blockIdx.x >> 2); }
        else for (int g = 0; g < 4; ++g) gemm_bf16(lds_raw, P_XN + g * 256, 1024, P_Wdft, S_, 512, 256, (bf16_t*)AR(48) + g * 512, 2048, GC);
    STEP_END
    STEP_BEGIN fft_s1_mfma((bf16_t*)AR(48), (bf16_t*)AR(112), lds_raw); STEP_END
    STEP_BEGIN fft_s2_mfma((bf16_t*)AR(112), (bf16_t*)AR(48), lds_raw); STEP_END
    STEP_BEGIN gate_fast((bf16_t*)AR(48), nullptr, nullptr, (bf16_t*)AR(0), 1536, P_MKB, P_MVP, (bf16_t*)AR(80)); STEP_END
    STEP_BEGIN gemm_f32(lds_raw, (bf16_t*)AR(80), 1280, WO, S_, 1024, 1280, (float*)AR(0), 1024, GC); STEP_END
    STEP_BEGIN ln_rows(H, (float*)AR(0), ALPHA, LNG, LNB, H, P_XN); STEP_END
}
template <int LAYER> DEV void layer_B(const Params& p, unsigned char* lds_raw) {
    STEP_BEGIN gemm_bf16(lds_raw, P_XN, 1024, P_WtB, S_, 3072, 1024, (bf16_t*)AR(0), 3072, GC); STEP_END
    STEP_BEGIN qk_post((bf16_t*)AR(0), p.q_norm_g, p.k_norm_g); STEP_END
    STEP_BEGIN
        bf16_t* PROJ = (bf16_t*)AR(0); bf16_t* BR = (bf16_t*)AR(96);
        if (gridDim.x == 256) {
            const attn_body::AttnTensors AT{(const attn_body::bf16*)PROJ, (const attn_body::bf16*)(PROJ + 1024), (const attn_body::bf16*)(PROJ + 1280), (attn_body::bf16*)BR};
            const attn_body::StaticOrder SA((int)gridDim.x, (int)blockIdx.x);
            attn_body::attn_phase<attn_body::StaticOrder>((char*)lds_raw, AT, SA);
        } else attn_naive(PROJ, BR, lds);
    STEP_END
    STEP_BEGIN gate_fast((bf16_t*)AR(96), nullptr, nullptr, (bf16_t*)AR(0) + 1536, 3072, P_MKB, P_MVP, (bf16_t*)AR(128)); STEP_END
    STEP_BEGIN gemm_f32(lds_raw, (bf16_t*)AR(128), 1280, WO, S_, 1024, 1280, (float*)AR(0), 1024, GC); STEP_END
    STEP_BEGIN ln_rows(H, (float*)AR(0), ALPHA, LNG, LNB, H, P_XN); STEP_END
}
template <int LAYER> DEV void layer_C(const Params& p, unsigned char* lds_raw) {
    for (int g = 0; g < 3; ++g) {
        STEP_BEGIN
            gemm_bf16(lds_raw, P_XN, 1024, P_WtC + (size_t)g * 3072 * 1024, S_, 3072, 1024, (bf16_t*)AR(0), 3072, GC);
            if (g == 0) make_rope1d((float*)AR(164));
        STEP_END
        STEP_BEGIN rope_c((bf16_t*)AR(0), (float*)AR(164)); STEP_END
        STEP_BEGIN dil_mfma((bf16_t*)AR(0), (float*)AR(96), (float*)AR(160), g); STEP_END
    }
    STEP_BEGIN gemm_bf16(lds_raw, P_XN, 1024, P_WtC + (size_t)9216 * 1024, S_, 1536, 1024, (bf16_t*)AR(0), 1536, GC); STEP_END
    STEP_BEGIN gate_fast(nullptr, (float*)AR(96), (float*)AR(160), (bf16_t*)AR(0), 1536, P_MKB, P_MVP, (bf16_t*)AR(48)); STEP_END
    STEP_BEGIN gemm_f32(lds_raw, (bf16_t*)AR(48), 1280, WO, S_, 1024, 1280, (float*)AR(96), 1024, GC); STEP_END
    STEP_BEGIN ln_rows(H, (float*)AR(96), ALPHA, LNG, LNB, H, P_XN); STEP_END
}

__global__ void __launch_bounds__(NTHREADS, 2) mk(Params p) {
    extern __shared__ __attribute__((aligned(16))) unsigned char lds_raw[];
    cg::grid_group grid = cg::this_grid();
    volatile LAS unsigned* bst = (volatile LAS unsigned*)((LAS unsigned char*)lds_raw + (LDS_BYTES - 64));
    if (threadIdx.x < 16) bst[threadIdx.x] = 0u;
    __syncthreads();
    { const XcdBarrier b0 = xcd_barrier_post((unsigned*)(p.ws + 16384), bst); if (threadIdx.x == 0) bst[2] = b0.x; }
    __syncthreads();
    STEP_BEGIN
        tconv(p.w_in_a, 1024, 1536, 1536, P_WtA, 0);
        tconv(p.w_in_a + (size_t)1024 * 1536, 1024, 1536, 1536, P_WtA + (size_t)1536 * 1024, 0);
        tconv(p.w_in_b, 1024, 3072, 3072, P_WtB, 0);
        tconv(p.w_in_c, 1024, 10752, 10752, P_WtC, 1);
        for (int i = 0; i < 4; ++i) tconv(p.w_out + (size_t)i * 1280 * 1024, 1280, 1024, 1024, P_WtO + (size_t)i * 1024 * 1280, 0);
        make_wdft(P_Wdft);
        make_mkv(p.mem, p.w_mem_kv, P_MKB, P_MVP);
        ln_rows(p.x, nullptr, 1.f, p.ln_in_g, p.ln_in_b, H, P_XN);
    } grid.sync();
    layer_A<0>(p, lds_raw);
    layer_B<1>(p, lds_raw);
    layer_C<2>(p, lds_raw);
    layer_A<3>(p, lds_raw);
}

extern "C" void kernel_launch(void* const* d_in, const int* in_sizes, int n_in, void* d_out, int out_size, void* d_ws, size_t ws_size, hipStream_t stream) {
    if (n_in != 13 || ws_size < 256 * MiB) { fprintf(stderr, "kernel_launch: unexpected inputs (n_in %d, ws %zu)\n", n_in, ws_size); return; }
    Params p{};
    p.x = (const float*)d_in[0]; p.mem = (const float*)d_in[1]; p.ln_in_g = (const float*)d_in[2]; p.ln_in_b = (const float*)d_in[3];
    p.w_mem_kv = (const float*)d_in[4]; p.w_in_a = (const float*)d_in[5]; p.w_in_b = (const float*)d_in[6]; p.q_norm_g = (const float*)d_in[7];
    p.k_norm_g = (const float*)d_in[8]; p.w_in_c = (const float*)d_in[9]; p.w_out = (const float*)d_in[10]; p.ln_g = (const float*)d_in[11]; p.ln_b = (const float*)d_in[12];
    p.out = (float*)d_out; p.ws = (unsigned char*)d_ws;
    static int grid_blocks = 0;
    if (!grid_blocks) {
        int dev = 0, cus = 0, per_cu = 0;
        hipGetDevice(&dev);
        hipDeviceGetAttribute(&cus, hipDeviceAttributeMultiprocessorCount, dev);
        hipFuncSetAttribute((const void*)mk, hipFuncAttributeMaxDynamicSharedMemorySize, LDS_BYTES);
        hipOccupancyMaxActiveBlocksPerMultiprocessor(&per_cu, (const void*)mk, NTHREADS, LDS_BYTES);
        if (per_cu < 1) per_cu = 1;
        grid_blocks = cus * per_cu;
    }
    p.s0 = 0; p.s1 = NSTEPS;
    hipMemsetAsync(d_ws, 0, 65536, stream);
    void* args[] = {&p};
    hipError_t e = hipLaunchCooperativeKernel((const void*)mk, dim3(grid_blocks), dim3(NTHREADS), args, LDS_BYTES, stream);
    if (e != hipSuccess) fprintf(stderr, "cooperative launch failed: %s (grid %d)\n", hipGetErrorString(e), grid_blocks);
}
```

```cpp
#include <hip/hip_runtime.h>
#include <hip/hip_cooperative_groups.h>
#include <cstdio>
#include <cstdint>
namespace cg = cooperative_groups;

#define DEV __device__ __forceinline__
typedef unsigned short bf16_t;
typedef short bf16x8 __attribute__((ext_vector_type(8)));
typedef float f32x4 __attribute__((ext_vector_type(4)));
typedef unsigned u32x4 __attribute__((ext_vector_type(4)));
typedef unsigned u32x2 __attribute__((ext_vector_type(2)));

constexpr int S_ = 16384, DM = 1024;
constexpr float ALPHA = 1.681792830507429f;
constexpr float C2 = 0.125f * 1.4426950408889634f;
constexpr float LN_EPS = 1e-5f;
constexpr size_t MiB = 1u << 20;
constexpr size_t WS_WA = 2 * MiB, WS_WB = 8 * MiB, WS_WC = 14 * MiB, WS_WO = 35 * MiB, WS_WDFT = 45 * MiB, WS_MKV = 45 * MiB + 512 * 1024;
constexpr size_t WS_XN = 48 * MiB, WS_AR = 80 * MiB;
constexpr int NTHREADS = 512;
constexpr int NSTEPS = 32;
constexpr int LDS_BYTES = 147456;


namespace pg8 {
#define PG8_LAS __attribute__((address_space(3)))
typedef unsigned short bf16_t;
typedef short bf16x8 __attribute__((ext_vector_type(8)));
typedef float f32x4 __attribute__((ext_vector_type(4)));
typedef unsigned u32x4 __attribute__((ext_vector_type(4)));
constexpr int BM = 256, BK = 64, HALF = 128, HTB = HALF * BK * 2  , STAGE_BYTES = 8 * HTB, NXCD = 8, WGM = 8;

__host__ __device__ __forceinline__ int lds_byte(int r, int c) { const int st = (r >> 4) * 2 + (c >> 5), rr = r & 15, cc = c & 31, ob = rr * 64 + cc * 2; return st * 1024 + (ob ^ (((ob >> 9) & 1) << 5)); }
__host__ __device__ __forceinline__ void stage_rc(int b, int& R, int& C) { const int st = b / 1024, sb = b % 1024, swz = sb ^ (((sb >> 9) & 1) << 5); R = (st >> 1) * 16 + swz / 64; C = (st & 1) * 32 + (swz % 64) / 2; }
__host__ __device__ __forceinline__ int perm32(int rho) { const int n = rho >> 4, i = rho & 15; return 8 * (i >> 2) + 4 * n + (i & 3); }

struct Unit { int pm, pn; };
struct Gemm { const bf16_t* A; const bf16_t* Bt; int M, N, K, lda; };

struct StaticOrder {
    int nM, nN, nwg, G, c;
    __host__ __device__ void init(int M, int N, int G_, int c_) { nM = M / BM; nN = N / BM; nwg = nM * nN; G = G_; c = c_; }
    __host__ __device__ bool next(int i, Unit& u) const {
        const long L = (long)i * G + c; if (L >= nwg) return false;
        int wgid = (int)L; { const int q = nwg / NXCD, r = nwg % NXCD, xcd = wgid % NXCD, off = wgid / NXCD; wgid = (xcd < r ? xcd * (q + 1) : r * (q + 1) + (xcd - r) * q) + off; }
        const int nig = WGM * nN, gid = wgid / nig, fm = gid * WGM, gsz = (nM - fm) < WGM ? (nM - fm) : WGM;
        u.pm = fm + ((wgid % nig) % gsz); u.pn = (wgid % nig) / gsz; return true;
    }
    __device__ __forceinline__ void a_ready(const Unit&) const {}
    __device__ __forceinline__ void done(const Unit&) const {}
};

__device__ __forceinline__ unsigned cvt_pk_bf16(float lo, float hi) { unsigned r; asm volatile("v_cvt_pk_bf16_f32 %0, %1, %2" : "=v"(r) : "v"(lo), "v"(hi)); return r; }
typedef float f32x2 __attribute__((ext_vector_type(2)));
__device__ __forceinline__ f32x2 gelu_pk(f32x2 v) {
    const f32x2 av = __builtin_elementwise_abs(v), d = av * 0.2316418882f + 1.0f;
    f32x2 t; t.x = __builtin_amdgcn_rcpf(d.x); t.y = __builtin_amdgcn_rcpf(d.y);
    f32x2 q = t * 0.5307027145f + (-0.7265760135f); q = q * t + 0.7107068705f; q = q * t + (-0.142248368f); q = q * t + 0.127414796f; q = q * t;
    const f32x2 s = (v * v) * (-0.72134752044f);
    f32x2 e; e.x = __builtin_amdgcn_exp2f(s.x); e.y = __builtin_amdgcn_exp2f(s.y);
    const f32x2 m = v * (q * e), r = v - m;
    f32x2 o; o.x = v.x < 0.f ? m.x : r.x; o.y = v.y < 0.f ? m.y : r.y; return o;
}

template <int ACT  > struct EpiBf16 {
    static constexpr bool PERM = true, AFTER_DRAIN = false; static_assert(ACT == 0 || ACT == 1, "EpiBf16: ACT is 0 (none) or 1 (gelu_pk)");
    bf16_t* O; int ldc; const float* bias; int split_cols; size_t split_stride; float scale0;
    __device__ __forceinline__ void operator()(const f32x4 (&acc)[2][2][4][2], const Unit& u, int wr, int wc, int fr, int fq) const {
        const int row0 = u.pm * BM + wr * 64 + fr; int colt = u.pn * BM; bf16_t* base = O;
        float sc = 1.f; if (split_cols) { const int t = colt / split_cols; base += (size_t)t * split_stride; colt -= t * split_cols; if (t == 0) sc = scale0; }
        const int col0 = colt + wc * 32 + 8 * fq, bcol0 = u.pn * BM + wc * 32 + 8 * fq;
        f32x4 bv[2][2];
#pragma unroll
        for (int bj = 0; bj < 2; ++bj)
#pragma unroll
            for (int n = 0; n < 2; ++n) bv[bj][n] = bias ? *(const f32x4*)(bias + bcol0 + bj * HALF + 4 * n) : (f32x4){0.f, 0.f, 0.f, 0.f};
#pragma unroll
        for (int ai = 0; ai < 2; ++ai)
#pragma unroll
            for (int m = 0; m < 4; ++m) { bf16_t* rowp = base + (size_t)(row0 + ai * HALF + m * 16) * ldc + col0;
#pragma unroll
                for (int bj = 0; bj < 2; ++bj) { f32x4 v0 = acc[ai][bj][m][0] + bv[bj][0], v1 = acc[ai][bj][m][1] + bv[bj][1];
                    if (ACT == 1) { f32x2 a = gelu_pk((f32x2){v0[0], v0[1]}), b = gelu_pk((f32x2){v0[2], v0[3]}), c = gelu_pk((f32x2){v1[0], v1[1]}), d = gelu_pk((f32x2){v1[2], v1[3]});
                        v0 = (f32x4){a.x, a.y, b.x, b.y}; v1 = (f32x4){c.x, c.y, d.x, d.y}; }
                    v0 = v0 * sc; v1 = v1 * sc; u32x4 w; w.x = cvt_pk_bf16(v0[0], v0[1]); w.y = cvt_pk_bf16(v0[2], v0[3]); w.z = cvt_pk_bf16(v1[0], v1[1]); w.w = cvt_pk_bf16(v1[2], v1[3]);
                    *(u32x4*)(rowp + bj * HALF) = w; } }
    }
};

struct EpiF32 {
    static constexpr bool PERM = false, AFTER_DRAIN = false;
    float* O; int ldc;
    __device__ __forceinline__ void operator()(const f32x4 (&acc)[2][2][4][2], const Unit& u, int wr, int wc, int fr, int fq) const {
        const int row0 = u.pm * BM + wr * 64 + fr, col0 = u.pn * BM + wc * 32 + 4 * fq;
#pragma unroll
        for (int ai = 0; ai < 2; ++ai)
#pragma unroll
            for (int m = 0; m < 4; ++m) { float* rowp = O + (size_t)(row0 + ai * HALF + m * 16) * ldc + col0;
#pragma unroll
                for (int bj = 0; bj < 2; ++bj)
#pragma unroll
                    for (int n = 0; n < 2; ++n) *(f32x4*)(rowp + bj * HALF + n * 16) = acc[ai][bj][m][n]; }
    }
};
struct EpiBf16Rope {
    static constexpr bool PERM = true, AFTER_DRAIN = false;
    bf16_t* O; int ldc; const unsigned* rope; float qscale;
    __device__ __forceinline__ void operator()(const f32x4 (&acc)[2][2][4][2], const Unit& u, int wr, int wc, int fr, int fq) const {
        const int row0 = u.pm * BM + wr * 64 + fr, col0 = u.pn * BM + wc * 32 + 8 * fq;
        const bool dorope = u.pn < 8; const float sc = u.pn < 4 ? qscale : 1.f;
#pragma unroll
        for (int ai = 0; ai < 2; ++ai)
#pragma unroll
            for (int m = 0; m < 4; ++m) { const int row = row0 + ai * HALF + m * 16; bf16_t* rowp = O + (size_t)row * ldc + col0;
#pragma unroll
                for (int bj = 0; bj < 2; ++bj) { f32x4 v0 = acc[ai][bj][m][0], v1 = acc[ai][bj][m][1];
                    if (dorope) {
                        const int i0 = ((col0 + bj * HALF) & 63) >> 1;
                        const u32x4 cs = *(const u32x4*)(rope + (size_t)row * 32 + i0);
                        float c, s, a, b;
#define ROPE1(W, X1, X2) c = (float)__builtin_bit_cast(_Float16, (unsigned short)((W) & 0xffffu)); s = (float)__builtin_bit_cast(_Float16, (unsigned short)((W) >> 16)); a = X1; b = X2; X1 = (a * c - b * s) * sc; X2 = (b * c + a * s) * sc;
                        ROPE1(cs.x, v0[0], v0[1]) ROPE1(cs.y, v0[2], v0[3]) ROPE1(cs.z, v1[0], v1[1]) ROPE1(cs.w, v1[2], v1[3])
#undef ROPE1
                    }
                    u32x4 w; w.x = cvt_pk_bf16(v0[0], v0[1]); w.y = cvt_pk_bf16(v0[2], v0[3]); w.z = cvt_pk_bf16(v1[0], v1[1]); w.w = cvt_pk_bf16(v1[2], v1[3]);
                    *(u32x4*)(rowp + bj * HALF) = w; } }
    }
};
template <class Epi, class Sched, bool ALIGN_EPI = false, bool SP2 = false>
__device__ __forceinline__ void gemm_phase(PG8_LAS unsigned char* lds, const Gemm g, const Sched& S, const Epi& E) {
    int tid_ = threadIdx.x; asm volatile("" : "+v"(tid_)); const int tid = tid_, wid = __builtin_amdgcn_readfirstlane(tid >> 6), lane = tid & 63, wr = wid >> 2, wc = wid & 3, fr = lane & 15, fq = lane >> 4;
    const int K = g.K, nt = K / BK;
    unsigned voffA[2], voffB[2];
#pragma unroll
    for (int i = 0; i < 2; ++i) { int R, C; stage_rc(tid * 16 + i * 8192, R, C); const int Rb = Epi::PERM ? ((R & ~31) + perm32(R & 31)) : R;
        voffA[i] = (unsigned)(R * g.lda + C) * 2u; voffB[i] = (unsigned)(Rb * K + C) * 2u; }
    const size_t kstep = (size_t)(BK * 2);
    const size_t hstepB = (size_t)HALF * K * 2, hstepA = (size_t)HALF * g.lda * 2;
    const size_t tstepA = 2 * hstepA, tstepB = 2 * hstepB;
    const unsigned ldsw = (unsigned)wid * 1024u;
    const int aoff = lds_byte(wr * 64 + fr, fq * 8), boff = lds_byte(wc * 32 + fr, fq * 8);
#define PG8_SA(b, h) (((b) * 2 + (h)) * HTB)
#define PG8_SB(b, h) ((4 + (b) * 2 + (h)) * HTB)
#define PG8_STAGE(bufoff, gbase, voff) do { _Pragma("unroll") for (int _i = 0; _i < 2; ++_i) \
        __builtin_amdgcn_global_load_lds((const unsigned*)((const char*)(gbase) + (voff)[_i]), (PG8_LAS unsigned*)(lds + (bufoff) + ldsw + _i * 8192), 16, 0, 0); } while (0)
#define PG8_LDA(dst, b, h) do { _Pragma("unroll") for (int m = 0; m < 4; ++m) _Pragma("unroll") for (int k = 0; k < 2; ++k) dst[m][k] = *(const PG8_LAS bf16x8*)(lds + PG8_SA(b, h) + aoff + m * 2048 + k * 1024); } while (0)
#define PG8_LDB(dst, b, h) do { _Pragma("unroll") for (int n = 0; n < 2; ++n) _Pragma("unroll") for (int k = 0; k < 2; ++k) dst[n][k] = *(const PG8_LAS bf16x8*)(lds + PG8_SB(b, h) + boff + n * 2048 + k * 1024); } while (0)
#define PG8_MMA(ai, bj, At, Bt) do { __builtin_amdgcn_s_setprio(1); _Pragma("unroll") for (int m = 0; m < 4; ++m) _Pragma("unroll") for (int n = 0; n < 2; ++n) _Pragma("unroll") for (int k = 0; k < 2; ++k) \
        acc[ai][bj][m][n] = __builtin_amdgcn_mfma_f32_16x16x32_bf16(Bt[n][k], At[m][k], acc[ai][bj][m][n], 0, 0, 0); __builtin_amdgcn_s_setprio(0); } while (0)
#define PG8_WAIT_V(n) asm volatile("s_waitcnt vmcnt(" #n ")" ::: "memory")
#define PG8_WAIT_L(n) asm volatile("s_waitcnt lgkmcnt(" #n ")" ::: "memory")
#define PG8_BAR __builtin_amdgcn_s_barrier()
#define PG8_SCHED __builtin_amdgcn_sched_barrier(0)
    Unit cur, nxt; int ui = 0;
    if (!S.next(0, cur)) return;
    f32x4 acc[2][2][4][2];
#pragma unroll
    for (int a = 0; a < 2; ++a)
#pragma unroll
        for (int b = 0; b < 2; ++b)
#pragma unroll
            for (int m = 0; m < 4; ++m)
#pragma unroll
                for (int n = 0; n < 2; ++n) acc[a][b][m][n] = (f32x4){0.f, 0.f, 0.f, 0.f};
    bf16x8 At[4][2], B0[2][2], B1[2][2];
    const char* cA = (const char*)g.A + (size_t)cur.pm * tstepA; const char* cB = (const char*)g.Bt + (size_t)cur.pn * tstepB;
    S.a_ready(cur);
    if constexpr (SP2) {
        PG8_STAGE(PG8_SB(0, 0), cB, voffB); PG8_STAGE(PG8_SB(0, 1), cB + hstepB, voffB); PG8_STAGE(PG8_SA(0, 0), cA, voffA); PG8_STAGE(PG8_SA(0, 1), cA + hstepA, voffA);
        if (wr == 1) PG8_BAR;
        PG8_WAIT_V(2); PG8_BAR;
        PG8_STAGE(PG8_SB(1, 0), cB + kstep, voffB); PG8_STAGE(PG8_SA(1, 0), cA + kstep, voffA); PG8_STAGE(PG8_SB(1, 1), cB + hstepB + kstep, voffB);
        PG8_WAIT_V(6); PG8_BAR;
    } else {
        PG8_STAGE(PG8_SB(0, 0), cB, voffB); PG8_STAGE(PG8_SA(0, 0), cA, voffA); PG8_STAGE(PG8_SB(0, 1), cB + hstepB, voffB); PG8_STAGE(PG8_SA(0, 1), cA + hstepA, voffA);
        if (wr == 1) PG8_BAR;
        PG8_WAIT_V(4); PG8_BAR;
        PG8_STAGE(PG8_SB(1, 0), cB + kstep, voffB); PG8_STAGE(PG8_SA(1, 0), cA + kstep, voffA); PG8_STAGE(PG8_SB(1, 1), cB + hstepB + kstep, voffB);
        PG8_WAIT_V(6); PG8_BAR;
    }
    for (;;) {
        const bool has_next = S.next(ui + 1, nxt);
        const char* nA = has_next ? (const char*)g.A + (size_t)nxt.pm * tstepA : cA; const char* nB = has_next ? (const char*)g.Bt + (size_t)nxt.pn * tstepB : cB;
        for (int t = 0; t < nt; t += 2) {
            const bool last = (t == nt - 2);
            const char* a1 = cA + (size_t)(t + 1) * kstep;
            const char* a2 = last ? nA : cA + (size_t)(t + 2) * kstep; const char* b2 = last ? nB : cB + (size_t)(t + 2) * kstep;
            const char* a3 = a2 + kstep; const char* b3 = b2 + kstep;
            if (last && has_next) S.a_ready(nxt);
            if constexpr (SP2) {
            PG8_LDB(B0, 0, 0); PG8_LDB(B1, 0, 1); PG8_SCHED; PG8_LDA(At, 0, 0); PG8_STAGE(PG8_SA(1, 1), a1 + hstepA, voffA);
            PG8_WAIT_V(8); PG8_WAIT_L(0); PG8_BAR; PG8_MMA(0, 0, At, B0); PG8_MMA(0, 1, At, B1); PG8_BAR; PG8_SCHED;
            PG8_LDA(At, 0, 1); PG8_STAGE(PG8_SB(0, 0), b2, voffB); PG8_STAGE(PG8_SB(0, 1), b2 + hstepB, voffB); PG8_STAGE(PG8_SA(0, 0), a2, voffA);
            PG8_WAIT_V(8); PG8_WAIT_L(0); PG8_BAR; PG8_MMA(1, 0, At, B0); PG8_MMA(1, 1, At, B1); PG8_BAR; PG8_SCHED;
            PG8_LDB(B0, 1, 0); PG8_LDB(B1, 1, 1); PG8_SCHED; PG8_LDA(At, 1, 0); PG8_STAGE(PG8_SA(0, 1), a2 + hstepA, voffA);
            PG8_WAIT_V(8); PG8_WAIT_L(0); PG8_BAR; PG8_MMA(0, 0, At, B0); PG8_MMA(0, 1, At, B1); PG8_BAR; PG8_SCHED;
            PG8_LDA(At, 1, 1); PG8_STAGE(PG8_SB(1, 0), b3, voffB); PG8_STAGE(PG8_SB(1, 1), b3 + hstepB, voffB); PG8_STAGE(PG8_SA(1, 0), a3, voffA);
            PG8_WAIT_V(8); PG8_WAIT_L(0); PG8_BAR; PG8_MMA(1, 0, At, B0); PG8_MMA(1, 1, At, B1); PG8_BAR; PG8_SCHED;
            } else {
            PG8_LDB(B0, 0, 0); PG8_SCHED; PG8_LDA(At, 0, 0); PG8_STAGE(PG8_SA(1, 1), a1 + hstepA, voffA);
            PG8_WAIT_L(8); PG8_BAR; PG8_WAIT_L(0); PG8_MMA(0, 0, At, B0); PG8_BAR; PG8_SCHED;
            PG8_LDB(B1, 0, 1); PG8_STAGE(PG8_SB(0, 0), b2, voffB);
            PG8_BAR; PG8_WAIT_L(0); PG8_MMA(0, 1, At, B1); PG8_BAR;
            PG8_LDA(At, 0, 1); PG8_STAGE(PG8_SA(0, 0), a2, voffA);
            PG8_BAR; PG8_WAIT_L(0); PG8_MMA(1, 0, At, B0); PG8_BAR; PG8_SCHED;
            PG8_STAGE(PG8_SB(0, 1), b2 + hstepB, voffB);
            PG8_WAIT_V(6); PG8_BAR; PG8_MMA(1, 1, At, B1); PG8_BAR;
            PG8_LDB(B0, 1, 0); PG8_SCHED; PG8_LDA(At, 1, 0); PG8_STAGE(PG8_SA(0, 1), a2 + hstepA, voffA);
            PG8_WAIT_L(8); PG8_BAR; PG8_WAIT_L(0); PG8_MMA(0, 0, At, B0); PG8_BAR; PG8_SCHED;
            PG8_LDB(B1, 1, 1); PG8_STAGE(PG8_SB(1, 0), b3, voffB);
            PG8_BAR; PG8_WAIT_L(0); PG8_MMA(0, 1, At, B1); PG8_BAR;
            PG8_LDA(At, 1, 1); PG8_STAGE(PG8_SA(1, 0), a3, voffA);
            PG8_BAR; PG8_WAIT_L(0); PG8_MMA(1, 0, At, B0); PG8_BAR; PG8_SCHED;
            PG8_STAGE(PG8_SB(1, 1), b3 + hstepB, voffB);
            PG8_WAIT_V(6); PG8_BAR; PG8_MMA(1, 1, At, B1); PG8_BAR;
            }
        }
        if constexpr (ALIGN_EPI) { if (wr == 0) PG8_BAR; }
        if constexpr (!Epi::AFTER_DRAIN) { E(acc, cur, wr, wc, fr, fq); S.done(cur); }
        if (!has_next) break;
#pragma unroll
        for (int a = 0; a < 2; ++a)
#pragma unroll
            for (int b = 0; b < 2; ++b)
#pragma unroll
                for (int m = 0; m < 4; ++m)
#pragma unroll
                    for (int n = 0; n < 2; ++n) acc[a][b][m][n] = (f32x4){0.f, 0.f, 0.f, 0.f};
        cur = nxt; cA = nA; cB = nB; ++ui;
        if constexpr (ALIGN_EPI) { if (wr == 1) PG8_BAR; }
    }
    PG8_WAIT_V(0);
    if constexpr (!ALIGN_EPI) { if (wr == 0) PG8_BAR; }
    PG8_BAR;
    if constexpr (Epi::AFTER_DRAIN) { E.fused(acc, cur, wr, wc, fr, fq, lds, wid, lane); S.done(cur); }
#undef PG8_SA
#undef PG8_SB
#undef PG8_STAGE
#undef PG8_LDA
#undef PG8_LDB
#undef PG8_MMA
#undef PG8_WAIT_V
#undef PG8_WAIT_L
#undef PG8_BAR
#undef PG8_SCHED
}
}

#define PG8_SP2 true
#define PG8_ALIGN true
#include <hip/hip_bf16.h>
#include <cmath>
namespace attn_body {
using bf16=__hip_bfloat16;
using bf16x8=__attribute__((ext_vector_type(8)))short;
using s16x4=__attribute__((ext_vector_type(4)))short;
using f32x16=__attribute__((ext_vector_type(16)))float;
using u32x4=__attribute__((ext_vector_type(4)))unsigned;
constexpr int BATCH=1,NHEAD=16,SEQ=16384,D=64,DM=NHEAD*D,QP=3072,KP=3072,OP=1024;
constexpr int NW=8,QBLK=32,QB=QBLK*NW,KVBLK=64,NQB=SEQ/QB;
constexpr int ATTN_PITCH=DM, ATTN_UNIT_ROWS=QB;
__device__ __forceinline__ int crow(int r,int hi){return (r&3)+8*(r>>2)+4*hi;}
#define SBAR() __builtin_amdgcn_sched_barrier(0)
__device__ __forceinline__ void cmask(f32x16&p0,f32x16&p1,int jb,int qrel,int hi){
  const float NEG=-INFINITY; int kb=64*jb+4*hi;
  #pragma unroll
  for(int r=0;r<16;++r){int kv=kb+(r&3)+8*(r>>2); if(kv>qrel)p0[r]=NEG; if(kv+32>qrel)p1[r]=NEG;}
}

constexpr int NSLOT=3, SLOTB=8192;
constexpr int LDS_K=0, LDS_V=NSLOT*SLOTB, LDS_WS=2*NSLOT*SLOTB, LDS_OST=LDS_WS+NW*64*4, LDS_BYTES=LDS_OST+NW*4096;
constexpr float C2=0.125f*1.4426950408889634f;
__device__ __forceinline__ void glds16(const void*gsrc,unsigned lds_dst){unsigned keep;
  asm volatile("s_mov_b32 %0, m0\n\ts_mov_b32 m0, %2\n\ts_nop 0\n\tglobal_load_lds_dwordx4 %1, off\n\ts_mov_b32 m0, %0":"=&s"(keep):"v"(gsrc),"s"(lds_dst):"memory");}
__device__ __forceinline__ float max3f(float a,float b,float c){float r;asm("v_max3_f32 %0, %1, %2, %3":"=v"(r):"v"(a),"v"(b),"v"(c));return r;}
__device__ __forceinline__ float max2f(float a,float b){float r;asm("v_max_f32_e32 %0, %1, %2":"=v"(r):"v"(a),"v"(b));return r;}
__device__ __forceinline__ float fadd_s(float a,float b){float r;asm("v_add_f32_e32 %0, %1, %2":"=v"(r):"v"(a),"v"(b));return r;}
__device__ __forceinline__ float fsub_s(float a,float b){float r;asm("v_sub_f32_e32 %0, %1, %2":"=v"(r):"v"(a),"v"(b));return r;}
typedef float f32x2_t __attribute__((ext_vector_type(2))); typedef __bf16 bf16x2_t __attribute__((ext_vector_type(2)));
__device__ __forceinline__ unsigned cvtpk_s(float lo,float hi){f32x2_t v={lo,hi};bf16x2_t b=__builtin_convertvector(v,bf16x2_t);return __builtin_bit_cast(unsigned,b);}
#define WAIT_BAR(N) asm volatile("s_waitcnt vmcnt(" #N ") lgkmcnt(0)\n\ts_barrier":::"memory")

__device__ __forceinline__ void qkt(f32x16&p0,f32x16&p1,const char*Kslot,const bf16x8*qr,const f32x16&negm,int r32,int hi){
  const char*kb=Kslot+hi*1024+r32*16;
  #pragma unroll
  for(int d0=0;d0<4;++d0){
    const bf16x8 b0=*reinterpret_cast<const bf16x8*>(kb+d0*2048);
    const bf16x8 b1=*reinterpret_cast<const bf16x8*>(kb+d0*2048+512);
    if(d0==0){p0=__builtin_amdgcn_mfma_f32_32x32x16_bf16(b0,qr[0],negm,0,0,0);p1=__builtin_amdgcn_mfma_f32_32x32x16_bf16(b1,qr[0],negm,0,0,0);}
    else{p0=__builtin_amdgcn_mfma_f32_32x32x16_bf16(b0,qr[d0],p0,0,0,0);p1=__builtin_amdgcn_mfma_f32_32x32x16_bf16(b1,qr[d0],p1,0,0,0);}}
}
typedef __attribute__((address_space(3))) const char* lds_cptr;
typedef short v4i16_t __attribute__((ext_vector_type(4)));
__device__ __forceinline__ void kload8(bf16x8*kf,lds_cptr kp){
  kf[0]=*(const __attribute__((address_space(3))) bf16x8*)(kp);      kf[1]=*(const __attribute__((address_space(3))) bf16x8*)(kp+512);
  kf[2]=*(const __attribute__((address_space(3))) bf16x8*)(kp+2048); kf[3]=*(const __attribute__((address_space(3))) bf16x8*)(kp+2560);
  kf[4]=*(const __attribute__((address_space(3))) bf16x8*)(kp+4096); kf[5]=*(const __attribute__((address_space(3))) bf16x8*)(kp+4608);
  kf[6]=*(const __attribute__((address_space(3))) bf16x8*)(kp+6144); kf[7]=*(const __attribute__((address_space(3))) bf16x8*)(kp+6656);
}
__device__ __forceinline__ void kload2(bf16x8*kf,lds_cptr kp,int j){ kf[2*j]=*(const __attribute__((address_space(3))) bf16x8*)(kp+j*2048); kf[2*j+1]=*(const __attribute__((address_space(3))) bf16x8*)(kp+j*2048+512); }
__device__ __forceinline__ s16x4 vtr(lds_cptr p){ return __builtin_bit_cast(s16x4,__builtin_amdgcn_ds_read_tr16_b64_v4i16((__attribute__((address_space(3))) v4i16_t*)p)); }
__device__ __forceinline__ float rowmax(const f32x16&p0,const f32x16&p1){
  float a=max3f(p0[0],p0[1],p1[0]),b=max3f(p0[2],p0[3],p1[1]);a=max3f(a,p1[2],p1[3]);
  #pragma unroll
  for(int r=4;r<16;r+=4){a=max3f(a,p0[r],p0[r+1]);b=max3f(b,p0[r+2],p0[r+3]);a=max3f(a,p1[r],p1[r+1]);b=max3f(b,p1[r+2],p1[r+3]);}
  const float m=max2f(a,b);
  auto rr=__builtin_amdgcn_permlane32_swap(__float_as_uint(m),__float_as_uint(m),false,false);
  return max2f(__uint_as_float(rr[0]),__uint_as_float(rr[1]));
}
__device__ __forceinline__ void pv(f32x16*o,int vb,bf16x8 pa0,bf16x8 pa1,bf16x8 pa2,bf16x8 pa3){
  #pragma unroll
  for(int d0=0;d0<2;++d0){s16x4 lo[4],hi[4];
    #pragma unroll
    for(int ks=0;ks<4;++ks){
      asm volatile("ds_read_b64_tr_b16 %0,%1 offset:%c2":"=&v"(lo[ks]):"v"(vb),"i"(d0*4096+ks*1024):"memory");
      asm volatile("ds_read_b64_tr_b16 %0,%1 offset:%c2":"=&v"(hi[ks]):"v"(vb),"i"(d0*4096+ks*1024+512):"memory");}
    asm volatile("s_waitcnt lgkmcnt(0)":::"memory");SBAR();
    #define PK(k) (bf16x8){lo[k][0],lo[k][1],lo[k][2],lo[k][3],hi[k][0],hi[k][1],hi[k][2],hi[k][3]}
    o[d0]=__builtin_amdgcn_mfma_f32_32x32x16_bf16(pa0,PK(0),o[d0],0,0,0);
    o[d0]=__builtin_amdgcn_mfma_f32_32x32x16_bf16(pa1,PK(1),o[d0],0,0,0);
    o[d0]=__builtin_amdgcn_mfma_f32_32x32x16_bf16(pa2,PK(2),o[d0],0,0,0);
    o[d0]=__builtin_amdgcn_mfma_f32_32x32x16_bf16(pa3,PK(3),o[d0],0,0,0);
    #undef PK
  }
}

#ifndef ATTN_STORE16
#define ATTN_STORE16(p,v) (*(u32x4*)(p)=(v))
#endif
template<int THRL> __device__ __forceinline__ void attn_unit(int b,int h,int qb,const bf16*Q,const bf16*__restrict__ K,const bf16*__restrict__ V,bf16*O,char*shm){
  int tid_=threadIdx.x; asm volatile("":"+v"(tid_)); const int tid=tid_,lane=tid&63,r32=lane&31,hi=lane>>5; const int wid=__builtin_amdgcn_readfirstlane(tid>>6);
  const long rowbase=(long)b*SEQ; const int q0=qb*QB;
  const bf16*Qw=Q+(rowbase+q0+wid*QBLK)*QP+h*D;
  const int kvh=h>>2; const bf16*Kh=K+rowbase*KP+kvh*D,*Vh=V+rowbase*KP+kvh*D;
  const unsigned lds0=(unsigned)(uintptr_t)shm;
  float*wsf=(float*)(shm+LDS_WS)+wid*64;
  const bf16*ksrc=Kh+(long)lane*KP+wid*8;
  const bf16*vsrc=Vh+(long)(16*(wid&3)+(lane>>2))*KP+(wid>>2)*32+(lane&3)*8;
  const unsigned kdst=lds0+LDS_K+wid*1024, vdst=lds0+LDS_V+wid*1024;
  #define DMA_K(t,slot) glds16(ksrc+(long)(t)*KVBLK*KP,(unsigned)__builtin_amdgcn_readfirstlane(kdst+(slot)))
  #define DMA_V(t,slot) glds16(vsrc+(long)(t)*KVBLK*KP,(unsigned)__builtin_amdgcn_readfirstlane(vdst+(slot)))
  const int vb0=(int)(lds0+LDS_V)+((lane>>4)&1)*32+(lane&3)*8+(4*hi+((lane&15)>>2))*64;
  const char*Kbase=shm+LDS_K; bf16x8 kf[8];
  const lds_cptr shm3=(lds_cptr)shm; const lds_cptr kp0=shm3+LDS_K+hi*1024+r32*16; const lds_cptr vp0=shm3+LDS_V+((lane>>4)&1)*32+(lane&3)*8+(4*hi+((lane&15)>>2))*64;
  const int NT=SEQ/KVBLK;
  DMA_K(0,0);DMA_V(0,0);DMA_K(1,SLOTB);
  bf16x8 qr[4];
  #pragma unroll
  for(int d0=0;d0<4;++d0)qr[d0]=*reinterpret_cast<const bf16x8*>(&Qw[(long)r32*QP+d0*16+hi*8]);
  float mhat=0.f,l_reg=0.f;f32x16 o[2];o[0]=f32x16{};o[1]=f32x16{};f32x16 negm=f32x16{};asm volatile("":"+v"(negm));
  const int qrel=wid*QBLK+r32;
  #define CMASK(P0,P1,t) do{}while(0)
  bool resc=false;
  #define START(P0,P1) do{ const float rm=rowmax(P0,P1); resc=false; \
    { const float dl=rm; mhat=fadd_s(mhat,dl); \
      _Pragma("unroll") for(int r=0;r<16;++r){P0[r]=fsub_s(P0[r],dl);P1[r]=fsub_s(P1[r],dl);} \
      _Pragma("unroll") for(int r=0;r<16;++r)negm[r]=-mhat; asm volatile("":"+v"(negm)); } \
    _Pragma("unroll") for(int r=0;r<16;++r)P0[r]=__builtin_amdgcn_exp2f(P0[r]); }while(0)
  #define RESC() do{ if(resc){ asm volatile("s_waitcnt lgkmcnt(0)":::"memory"); \
      _Pragma("unroll") for(int d_=0;d_<2;++d_) _Pragma("unroll") for(int r=0;r<16;++r)o[d_][r]*=wsf[crow(r,hi)]; } }while(0)
  f32x16 pA0,pA1,pB0,pB1;
  int sl_prev=0,sl_cur=0,sl_next=SLOTB;
  #define ROT() do{sl_prev=sl_cur;sl_cur=sl_next;sl_next=(sl_next==(NSLOT-1)*SLOTB)?0:sl_next+SLOTB;}while(0)
  DMA_K(2,2*SLOTB);
  WAIT_BAR(3);
  qkt(pA0,pA1,Kbase,qr,negm,r32,hi);asm volatile("s_nop 15\n\ts_nop 7":"+v"(pA0),"+v"(pA1));CMASK(pA0,pA1,0);
  START(pA0,pA1);
  _Pragma("unroll") for(int r=0;r<16;++r)pA1[r]=__builtin_amdgcn_exp2f(pA1[r]);
  WAIT_BAR(0);
  DMA_K(3,0);DMA_V(1,SLOTB);
  ROT();
  kload8(kf,kp0+sl_cur);
  WAIT_BAR(2);
  s16x4 vlo[8],vhi[8]; u32x4 pw0,pw1,pw2,pw3;
  #define PKW(P,B) cvtpk_s(P[B],P[B+1])
  #define PAF(k) __builtin_bit_cast(bf16x8,pw##k)
  #define VFR(i) (bf16x8){vlo[i][0],vlo[i][1],vlo[i][2],vlo[i][3],vhi[i][0],vhi[i][1],vhi[i][2],vhi[i][3]}
  #define PIN(x) asm volatile("":"+v"(x))
  #define MX3(a,b,c) __builtin_fmaxf(__builtin_fmaxf((a),(b)),(c))
  #define GAPA(MF,A0,A1,A2,A3,W0,W1,PW) do{ MF; sacc+=A0; sacc+=A1; sacc+=A2; sacc+=A3; PIN(sacc); W0; W1; PIN(PW); SBAR(); }while(0)
  #define EX(v) __builtin_amdgcn_exp2f(v)
  #define GAPB(MF,X,B) do{ MF; X[B]=EX(X[B]); X[B+1]=EX(X[B+1]); X[B+2]=EX(X[B+2]); X[B+3]=EX(X[B+3]); PIN(X); SBAR(); }while(0)
  #define VRD(i) do{ vlo[i]=vtr(vp_+(((i)>>2)*4096+((i)&3)*1024)); vhi[i]=vtr(vp_+(((i)>>2)*4096+((i)&3)*1024+512)); }while(0)
  #define KRD(G,j) do{ if(G){ kload2(kf,kp0+sl_next,j); SBAR(); } }while(0)
  #define STEP(C0,C1,P0,P1,t,GK,GV,GL) do{ SBAR(); \
    const lds_cptr vp_=vp0+sl_prev; \
    VRD(0); SBAR(); float sacc=(P0[0]+P0[1]); \
    GAPA(C0=__builtin_amdgcn_mfma_f32_32x32x16_bf16(kf[0],qr[0],negm,0,0,0), P0[2],P0[3],P0[4],P0[5],     pw0[0]=PKW(P0,0), pw0[1]=PKW(P0,2), pw0); \
    VRD(4); SBAR(); GAPA(C1=__builtin_amdgcn_mfma_f32_32x32x16_bf16(kf[1],qr[0],negm,0,0,0), P0[6],P0[7],P0[8],P0[9],     pw0[2]=PKW(P0,4), pw0[3]=PKW(P0,6), pw0); \
    VRD(1); SBAR(); GAPA(C0=__builtin_amdgcn_mfma_f32_32x32x16_bf16(kf[2],qr[1],C0,0,0,0),   P0[10],P0[11],P0[12],P0[13], pw1[0]=PKW(P0,8), pw1[1]=PKW(P0,10), pw1); \
    VRD(5); SBAR(); GAPA(C1=__builtin_amdgcn_mfma_f32_32x32x16_bf16(kf[3],qr[1],C1,0,0,0),   P0[14],P0[15],P1[0],P1[1],   pw1[2]=PKW(P0,12),pw1[3]=PKW(P0,14), pw1); \
    VRD(2); SBAR(); GAPA(C0=__builtin_amdgcn_mfma_f32_32x32x16_bf16(kf[4],qr[2],C0,0,0,0),   P1[2],P1[3],P1[4],P1[5],     pw2[0]=PKW(P1,0), pw2[1]=PKW(P1,2), pw2); \
    VRD(6); SBAR(); GAPA(C1=__builtin_amdgcn_mfma_f32_32x32x16_bf16(kf[5],qr[2],C1,0,0,0),   P1[6],P1[7],P1[8],P1[9],     pw2[2]=PKW(P1,4), pw2[3]=PKW(P1,6), pw2); \
    VRD(3); SBAR(); GAPA(C0=__builtin_amdgcn_mfma_f32_32x32x16_bf16(kf[6],qr[3],C0,0,0,0),   P1[10],P1[11],P1[12],P1[13], pw3[0]=PKW(P1,8), pw3[1]=PKW(P1,10), pw3); \
    VRD(7); SBAR(); GAPA(C1=__builtin_amdgcn_mfma_f32_32x32x16_bf16(kf[7],qr[3],C1,0,0,0),   P1[14],P1[15],0.f,0.f,       pw3[2]=PKW(P1,12),pw3[3]=PKW(P1,14), pw3); \
    l_reg+=sacc; \
    if(GK){DMA_K((t)+3,sl_cur);} if(GV){DMA_V((t)+1,sl_next);} \
    CMASK(C0,C1,t); \
    { float a=MX3(C0[0],C0[1],C1[0]),b=MX3(C0[2],C0[3],C1[1]); a=MX3(a,C1[2],C1[3]); \
      _Pragma("unroll") for(int r=4;r<16;r+=4){a=MX3(a,C0[r],C0[r+1]);b=MX3(b,C0[r+2],C0[r+3]);a=MX3(a,C1[r],C1[r+1]);b=MX3(b,C1[r+2],C1[r+3]);} \
      float rm=__builtin_fmaxf(a,b); { auto rr=__builtin_amdgcn_permlane32_swap(__float_as_uint(rm),__float_as_uint(rm),false,false); rm=__builtin_fmaxf(__uint_as_float(rr[0]),__uint_as_float(rr[1])); } \
      resc=false; \
      if(__builtin_expect(__any(rm>(float)THRL),0)){ const float dl=__builtin_fmaxf(rm,0.f); mhat+=dl; \
        _Pragma("unroll") for(int r=0;r<16;++r){C0[r]-=dl;C1[r]-=dl;} \
        _Pragma("unroll") for(int r=0;r<16;++r)negm[r]=-mhat; asm volatile("":"+v"(negm)); \
        const float f=__builtin_amdgcn_exp2f(-dl); l_reg*=f; if(hi==0)wsf[r32]=f; resc=true; } } \
    SBAR(); \
    GAPB(o[0]=__builtin_amdgcn_mfma_f32_32x32x16_bf16(PAF(0),VFR(0),o[0],0,0,0), C0,0); \
    GAPB(o[1]=__builtin_amdgcn_mfma_f32_32x32x16_bf16(PAF(0),VFR(4),o[1],0,0,0), C0,4); \
    KRD(GL,0); GAPB(o[0]=__builtin_amdgcn_mfma_f32_32x32x16_bf16(PAF(1),VFR(1),o[0],0,0,0), C0,8); \
    KRD(GL,1); GAPB(o[1]=__builtin_amdgcn_mfma_f32_32x32x16_bf16(PAF(1),VFR(5),o[1],0,0,0), C0,12); \
    KRD(GL,2); GAPB(o[0]=__builtin_amdgcn_mfma_f32_32x32x16_bf16(PAF(2),VFR(2),o[0],0,0,0), C1,0); \
    KRD(GL,3); GAPB(o[1]=__builtin_amdgcn_mfma_f32_32x32x16_bf16(PAF(2),VFR(6),o[1],0,0,0), C1,4); \
    GAPB(o[0]=__builtin_amdgcn_mfma_f32_32x32x16_bf16(PAF(3),VFR(3),o[0],0,0,0), C1,8); \
    GAPB(o[1]=__builtin_amdgcn_mfma_f32_32x32x16_bf16(PAF(3),VFR(7),o[1],0,0,0), C1,12); \
    }while(0)
  int t=1;
  #undef CMASK
  #define CMASK(P0,P1,t) do{}while(0)
  for(;t+5<NT;t+=2){
    STEP(pB0,pB1,pA0,pA1,t,true,true,true);     WAIT_BAR(2); RESC(); ROT();
    STEP(pA0,pA1,pB0,pB1,t+1,true,true,true);   WAIT_BAR(2); RESC(); ROT();
  }
  #undef CMASK
  #define CMASK(P0,P1,t) do{}while(0)
  #define ENDW(tt) do{ if((tt)+3<NT){WAIT_BAR(2);} else if((tt)+2<NT){WAIT_BAR(1);} else {WAIT_BAR(0);} }while(0)
  for(;t+1<NT;t+=2){
    STEP(pB0,pB1,pA0,pA1,t,(t+3<NT),(t+1<NT),(t+1<NT));       ENDW(t);   RESC(); ROT();
    STEP(pA0,pA1,pB0,pB1,t+1,(t+4<NT),(t+2<NT),(t+2<NT));     ENDW(t+1); RESC(); ROT();
  }
  STEP(pB0,pB1,pA0,pA1,NT-1,false,false,false); RESC();
  { float sacc=pB0[0]+pB0[1]; _Pragma("unroll") for(int r=2;r<16;++r)sacc+=pB0[r]; _Pragma("unroll") for(int r=0;r<16;++r)sacc+=pB1[r]; l_reg+=sacc;
    pw0=(u32x4){PKW(pB0,0),PKW(pB0,2),PKW(pB0,4),PKW(pB0,6)};pw1=(u32x4){PKW(pB0,8),PKW(pB0,10),PKW(pB0,12),PKW(pB0,14)};pw2=(u32x4){PKW(pB1,0),PKW(pB1,2),PKW(pB1,4),PKW(pB1,6)};pw3=(u32x4){PKW(pB1,8),PKW(pB1,10),PKW(pB1,12),PKW(pB1,14)};
    SBAR(); pv(o,vb0+sl_cur,PAF(0),PAF(1),PAF(2),PAF(3)); }
  #undef PKW
  #undef PAF
  #undef VFR
  #undef PIN
  #undef MX3
  #undef GAPA
  #undef GAPB
  #undef EX
  #undef VRD
  #undef KRD
  #undef STEP
  #undef ENDW
  {auto rr=__builtin_amdgcn_permlane32_swap(__float_as_uint(l_reg),__float_as_uint(l_reg),false,false);l_reg=__uint_as_float(rr[0])+__uint_as_float(rr[1]);}
  if(hi==0)wsf[32+r32]=l_reg;asm volatile("s_waitcnt lgkmcnt(0)":::"memory");
  float rli[16];
  #pragma unroll
  for(int r=0;r<16;++r)rli[r]=__builtin_amdgcn_rcpf(wsf[32+crow(r,hi)]);
  bf16*Ow=O+(rowbase+q0+wid*QBLK)*OP+h*D;
  { bf16*stg=(bf16*)(shm+LDS_OST)+wid*2048;
    #pragma unroll
    for(int r=0;r<16;++r){const int orow=crow(r,hi);
      #pragma unroll
      for(int d0=0;d0<2;++d0)stg[orow*64+d0*32+r32]=__float2bfloat16(o[d0][r]*rli[r]);}
    asm volatile("s_waitcnt lgkmcnt(0)":::"memory");
    #pragma unroll
    for(int i=0;i<4;++i){const int row=i*8+(lane>>3),ch=lane&7; const u32x4 v=*(const u32x4*)(stg+row*64+ch*8); ATTN_STORE16(Ow+(long)row*OP+ch*8,v);} }
  asm volatile("s_waitcnt lgkmcnt(0)\n\ts_barrier":::"memory");
  #undef DMA_K
  #undef DMA_V
  #undef CMASK
  #undef START
  #undef RESC
  #undef ROT
}
constexpr int ATTN_LDS_BYTES=LDS_BYTES;
struct AttnTensors { const bf16* Q; const bf16* K; const bf16* V; bf16* O; };
struct AttnUnit { int bh; int qb; };
struct StaticOrder {
  int vcu;
  __device__ __forceinline__ explicit StaticOrder(int grid,int block):vcu((block%8)*(grid/8)+block/8){}
  __device__ __forceinline__ bool next(int i,AttnUnit&u)const{ if(i>=4)return false; u.bh=vcu>>4; u.qb=(vcu&15)*4+i; return true; }
  __device__ __forceinline__ void a_ready(const AttnUnit&)const{}
  __device__ __forceinline__ void done(const AttnUnit&)const{}
};
template<class Sched,int THRL=8> __device__ __forceinline__ void attn_phase(char*lds,const AttnTensors&T,const Sched&S){
  AttnUnit u;
  for(int i=0;S.next(i,u);++i){ S.a_ready(u); attn_unit<THRL>(u.bh/NHEAD,u.bh%NHEAD,u.qb,T.Q,T.K,T.V,T.O,lds); S.done(u); }
}
#undef SBAR
#undef WAIT_BAR
}

struct Params {
    const float *x, *mem, *ln_in_g, *ln_in_b, *w_mem_kv, *w_in_a, *w_in_b, *q_norm_g, *k_norm_g, *w_in_c, *w_out, *ln_g, *ln_b;
    float* out; unsigned char* ws;
    int s0, s1;
};

DEV float bf2f(bf16_t b) { return __uint_as_float(((unsigned)b) << 16); }
DEV bf16_t f2bf(float f) { unsigned u = __float_as_uint(f); return (bf16_t)((u + 0x7fffu + ((u >> 16) & 1u)) >> 16); }
DEV unsigned pk2(float lo, float hi) { return (unsigned)f2bf(lo) | ((unsigned)f2bf(hi) << 16); }
DEV float wave_sum(float v) {
#pragma unroll
    for (int o = 1; o < 64; o <<= 1) v += __shfl_xor(v, o);
    return v;
}
DEV float silu(float x) { return x / (1.f + __expf(-x)); }
DEV void load8(const bf16_t* p, float* o) {
    u32x4 v = *(const u32x4*)p;
    o[0] = __uint_as_float(v.x << 16); o[1] = __uint_as_float(v.x & 0xffff0000u);
    o[2] = __uint_as_float(v.y << 16); o[3] = __uint_as_float(v.y & 0xffff0000u);
    o[4] = __uint_as_float(v.z << 16); o[5] = __uint_as_float(v.z & 0xffff0000u);
    o[6] = __uint_as_float(v.w << 16); o[7] = __uint_as_float(v.w & 0xffff0000u);
}
DEV void store8(bf16_t* p, const float* o) {
    u32x4 v; v.x = pk2(o[0], o[1]); v.y = pk2(o[2], o[3]); v.z = pk2(o[4], o[5]); v.w = pk2(o[6], o[7]);
    *(u32x4*)p = v;
}
DEV int ltid() { int t = threadIdx.x; asm volatile("" : "+v"(t)); return t; }
#define GTID ((size_t)blockIdx.x * blockDim.x + ltid())
#define GSZ ((size_t)gridDim.x * blockDim.x)

DEV void tconv(const float* src, int K, int Ntot, int ncols, bf16_t* dst, int mode) {
    const size_t total = (size_t)ncols * (K / 8);
    for (size_t idx = GTID; idx < total; idx += GSZ) {
        const int n = (int)(idx % ncols), kc = (int)(idx / ncols);
        int sc = n;
        if (mode == 1 && n < 9216) { const int g = n / 3072, rem = n % 3072, which = rem / 1024, r = rem % 1024, hd = r >> 6, pos = r & 63;
            const int d = which < 2 ? ((pos & 1) ? 32 + (pos >> 1) : (pos >> 1)) : pos;
            sc = which * 3072 + g * 1024 + hd * 64 + d; }
        float v[8];
#pragma unroll
        for (int j = 0; j < 8; ++j) v[j] = src[(size_t)(kc * 8 + j) * Ntot + sc];
        store8(dst + (size_t)n * K + kc * 8, v);
    }
}
DEV void make_wdft(bf16_t* w) {
    for (size_t idx = GTID; idx < 512 * 256; idx += GSZ) {
        const int n = (int)(idx >> 8), c = (int)(idx & 255), which = n >> 8, l = n & 255;
        float s, co; sincospif((float)((l * c) & 255) / 128.f, &s, &co);
        w[idx] = f2bf(which == 0 ? co : -s);
    }
}
DEV void make_mkv(const float* mem, const float* w, bf16_t* MKb, bf16_t* MVp) {
    for (size_t idx = GTID; idx < 256 * 512; idx += GSZ) {
        const int m = (int)(idx >> 9), n = (int)(idx & 511);
        float a = 0.f;
        for (int k = 0; k < 1024; ++k) a += mem[m * 1024 + k] * w[(size_t)k * 512 + n];
        if (n < 256) MKb[m * 256 + n] = f2bf(a);
        else { const int np = n - 256, kt = m >> 5, s = (m >> 4) & 1, wv = m & 15, hi = (wv >> 2) & 1, e = (wv & 3) + 4 * (wv >> 3);
               MVp[((np * 8 + kt) * 2 + s) * 16 + hi * 8 + e] = f2bf(a); }
    }
}
DEV unsigned short f2h(float x) { return __builtin_bit_cast(unsigned short, (_Float16)x); }
DEV float h2f(unsigned short u) { return (float)__builtin_bit_cast(_Float16, u); }
DEV void make_rope1d(unsigned* tab) {
    for (size_t idx = GTID; idx < (size_t)S_ * 32; idx += GSZ) {
        const int t = (int)(idx >> 5), i = (int)(idx & 31);
        const float inv = powf(10000.f, -((float)(2 * i) / 64.f));
        const float a = (float)t * inv;
        tab[idx] = (unsigned)f2h(cosf(a)) | ((unsigned)f2h(sinf(a)) << 16);
    }
}
DEV void ln_rows(const float* a, const float* y, float alpha, const float* g, const float* b, float* outH, bf16_t* outXN) {
    const int lane = ltid() & 63, wpb = blockDim.x >> 6;
    const int gw = blockIdx.x * wpb + (ltid() >> 6), nw = gridDim.x * wpb;
    for (int row = gw; row < S_; row += nw) {
        f32x4 v[4]; float s = 0.f;
#pragma unroll
        for (int j = 0; j < 4; ++j) {
            v[j] = *(const f32x4*)(a + (size_t)row * DM + j * 256 + lane * 4);
            if (y) { const f32x4 u = *(const f32x4*)(y + (size_t)row * DM + j * 256 + lane * 4); v[j] = v[j] * alpha + u; }
            s += (v[j].x + v[j].y) + (v[j].z + v[j].w);
        }
        const float mean = wave_sum(s) * (1.f / DM); float s2 = 0.f;
#pragma unroll
        for (int j = 0; j < 4; ++j) { v[j] = v[j] - mean; s2 += (v[j].x * v[j].x + v[j].y * v[j].y) + (v[j].z * v[j].z + v[j].w * v[j].w); }
        const float rstd = 1.f / sqrtf(wave_sum(s2) * (1.f / DM) + LN_EPS);
#pragma unroll
        for (int j = 0; j < 4; ++j) {
            const f32x4 gg = *(const f32x4*)(g + j * 256 + lane * 4), bb = *(const f32x4*)(b + j * 256 + lane * 4);
            const f32x4 o = v[j] * rstd * gg + bb;
            *(f32x4*)(outH + (size_t)row * DM + j * 256 + lane * 4) = o;
            u32x2 w; w.x = pk2(o.x, o.y); w.y = pk2(o.z, o.w);
            *(u32x2*)(outXN + (size_t)row * DM + j * 256 + lane * 4) = w;
        }
    }
}
DEV void gemm_simple(const bf16_t* A, int lda, const bf16_t* Bt, int ldb, int M, int N, int K, void* C, int ldc, int f32out) {
    const int lane = ltid() & 63, wpb = blockDim.x >> 6;
    const int gw = blockIdx.x * wpb + (ltid() >> 6), nw = gridDim.x * wpb;
    const int tn = N / 64, tiles = (M / 64) * tn, fr = lane & 15, fq = lane >> 4;
    for (int t = gw; t < tiles; t += nw) {
        const int tm = t / tn, tc = t % tn;
        f32x4 acc[4][4];
#pragma unroll
        for (int i = 0; i < 4; ++i)
#pragma unroll
            for (int j = 0; j < 4; ++j) acc[i][j] = (f32x4){0.f, 0.f, 0.f, 0.f};
        const bf16_t* ap = A + (size_t)(tm * 64 + fr) * lda + fq * 8;
        const bf16_t* bp = Bt + (size_t)(tc * 64 + fr) * ldb + fq * 8;
        for (int k0 = 0; k0 < K; k0 += 32) {
            bf16x8 a[4], b[4];
#pragma unroll
            for (int i = 0; i < 4; ++i) { a[i] = *(const bf16x8*)(ap + (size_t)i * 16 * lda + k0); b[i] = *(const bf16x8*)(bp + (size_t)i * 16 * ldb + k0); }
#pragma unroll
            for (int i = 0; i < 4; ++i)
#pragma unroll
                for (int j = 0; j < 4; ++j) acc[i][j] = __builtin_amdgcn_mfma_f32_16x16x32_bf16(a[i], b[j], acc[i][j], 0, 0, 0);
        }
#pragma unroll
        for (int i = 0; i < 4; ++i)
#pragma unroll
            for (int j = 0; j < 4; ++j)
#pragma unroll
                for (int r = 0; r < 4; ++r) {
                    const size_t off = (size_t)(tm * 64 + i * 16 + fq * 4 + r) * ldc + tc * 64 + j * 16 + fr;
                    if (f32out) ((float*)C)[off] = acc[i][j][r]; else ((bf16_t*)C)[off] = f2bf(acc[i][j][r]);
                }
    }
}
DEV int zc(int j) { return ((j >> 8) << 9) + (j & 255); }
DEV void fft_tab(float* tab) {
    __syncthreads();
    for (int i = ltid(); i < 128; i += blockDim.x) { float s, c; sincospif((float)i / 64.f, &s, &c); tab[i] = c; tab[128 + i] = s; }
    __syncthreads();
}
DEV void fft_s1(const bf16_t* Z, bf16_t* T, float* tab) {
    fft_tab(tab);
    const size_t total = (size_t)S_ * 1024;
    for (size_t idx = GTID; idx < total; idx += GSZ) {
        const int j = (int)(idx & 1023), r = (int)(idx >> 10), k1 = r >> 7, s2 = r & 127, cj = zc(j);
        float ar = 0.f, ai = 0.f;
        for (int s1 = 0; s1 < 128; ++s1) {
            const int n = (s1 * k1) & 127; const float c = tab[n], s = tab[128 + n];
            const bf16_t* zp = Z + (size_t)(128 * s1 + s2) * 2048 + cj;
            const float zr = bf2f(zp[0]), zi = bf2f(zp[256]);
            ar += zr * c + zi * s; ai += zi * c - zr * s;
        }
        float ts, tc; sincospif((float)(s2 * k1) / 8192.f, &ts, &tc);
        const float tr = ar * tc + ai * ts, ti = ai * tc - ar * ts;
        T[(size_t)r * 2048 + cj] = f2bf(tr); T[(size_t)r * 2048 + cj + 256] = f2bf(ti);
    }
}
DEV void fft_s2(const bf16_t* T, bf16_t* BR, float* tab) {
    fft_tab(tab);
    const size_t total = (size_t)S_ * 1024;
    for (size_t idx = GTID; idx < total; idx += GSZ) {
        const int j = (int)(idx & 1023), k = (int)(idx >> 10), k1 = k & 127, k2 = k >> 7, cj = zc(j);
        float acc = 0.f;
        for (int s2 = 0; s2 < 128; ++s2) {
            const int n = (s2 * k2) & 127; const float c = tab[n], s = tab[128 + n];
            const bf16_t* tp = T + (size_t)(k1 * 128 + s2) * 2048 + cj;
            acc += bf2f(tp[0]) * c + bf2f(tp[256]) * s;
        }
        BR[(size_t)k * 1024 + j] = f2bf(acc * (1.f / 2048.f));
    }
}

typedef float f32x16 __attribute__((ext_vector_type(16)));
constexpr int FT_LD = 136;
DEV void fft_tables(bf16_t* Ct, bf16_t* St) {
    __syncthreads();
    for (int e = ltid(); e < 128 * 128; e += blockDim.x) { const int r = e >> 7, c = e & 127; float s, co; sincospif((float)((r * c) & 127) / 64.f, &s, &co); Ct[r * FT_LD + c] = f2bf(co); St[r * FT_LD + c] = f2bf(s); }
    __syncthreads();
}
DEV int crow16(int r, int hi) { return (r & 3) + 8 * (r >> 2) + 4 * hi; }
DEV void fft_s1_mfma(const bf16_t* Z, bf16_t* T, unsigned char* lds_raw) {
    bf16_t* Ct = (bf16_t*)lds_raw; bf16_t* St = Ct + 128 * FT_LD;
    fft_tables(Ct, St);
    const int tid = ltid(), lane = tid & 63, r32 = lane & 31, hi = lane >> 5, wpb = blockDim.x >> 6;
    const int gw = blockIdx.x * wpb + (tid >> 6), nw = gridDim.x * wpb;
    for (int task = gw; task < 128 * 32; task += nw) {
        const int s2 = task >> 5, jt = task & 31, j = jt * 32 + r32, cj = zc(j);
        const bf16_t* zp = Z + (size_t)s2 * 2048 + cj;
        f32x16 ore[4], oim[4];
#pragma unroll
        for (int mt = 0; mt < 4; ++mt)
#pragma unroll
            for (int r = 0; r < 16; ++r) { ore[mt][r] = 0.f; oim[mt][r] = 0.f; }
#pragma unroll 1
        for (int sh = 0; sh < 2; ++sh) {
            bf16x8 zr[4], zi[4];
#pragma unroll
            for (int s = 0; s < 4; ++s)
#pragma unroll
                for (int e = 0; e < 8; ++e) { const size_t off = (size_t)(64 * sh + 16 * s + 8 * hi + e) * (128 * 2048); zr[s][e] = (short)zp[off]; zi[s][e] = (short)zp[off + 256]; }
#pragma unroll
            for (int s = 0; s < 4; ++s) {
                bf16x8 nzr;
#pragma unroll
                for (int e = 0; e < 8; ++e) nzr[e] = (short)(zr[s][e] ^ (short)0x8000);
#pragma unroll
                for (int mt = 0; mt < 4; ++mt) {
                    const bf16x8 c = *(const bf16x8*)(Ct + (mt * 32 + r32) * FT_LD + 64 * sh + 16 * s + 8 * hi);
                    const bf16x8 sn = *(const bf16x8*)(St + (mt * 32 + r32) * FT_LD + 64 * sh + 16 * s + 8 * hi);
                    ore[mt] = __builtin_amdgcn_mfma_f32_32x32x16_bf16(c, zr[s], ore[mt], 0, 0, 0);
                    ore[mt] = __builtin_amdgcn_mfma_f32_32x32x16_bf16(sn, zi[s], ore[mt], 0, 0, 0);
                    oim[mt] = __builtin_amdgcn_mfma_f32_32x32x16_bf16(c, zi[s], oim[mt], 0, 0, 0);
                    oim[mt] = __builtin_amdgcn_mfma_f32_32x32x16_bf16(sn, nzr, oim[mt], 0, 0, 0);
                }
            }
        }
#pragma unroll
        for (int mt = 0; mt < 4; ++mt)
#pragma unroll
            for (int r = 0; r < 16; ++r) {
                const int k1 = mt * 32 + crow16(r, hi);
                const float xr = (float)(s2 * k1) * (1.f / 16384.f);
                const float tc = __builtin_amdgcn_cosf(xr), ts = __builtin_amdgcn_sinf(xr);
                const float ar = ore[mt][r], ai = oim[mt][r];
                bf16_t* tp = T + (size_t)(k1 * 128 + s2) * 2048 + cj;
                tp[0] = f2bf(ar * tc + ai * ts); tp[256] = f2bf(ai * tc - ar * ts);
            }
    }
    __syncthreads();
}
DEV void fft_s2_mfma(const bf16_t* T, bf16_t* BR, unsigned char* lds_raw) {
    bf16_t* Ct = (bf16_t*)lds_raw; bf16_t* St = Ct + 128 * FT_LD;
    fft_tables(Ct, St);
    const int tid = ltid(), lane = tid & 63, r32 = lane & 31, hi = lane >> 5, wpb = blockDim.x >> 6;
    const int gw = blockIdx.x * wpb + (tid >> 6), nw = gridDim.x * wpb;
    for (int task = gw; task < 128 * 32; task += nw) {
        const int k1 = task >> 5, jt = task & 31, j = jt * 32 + r32, cj = zc(j);
        const bf16_t* tp = T + (size_t)(k1 * 128) * 2048 + cj;
        bf16x8 tr[8], ti[8];
#pragma unroll
        for (int s = 0; s < 8; ++s)
#pragma unroll
            for (int e = 0; e < 8; ++e) { const size_t off = (size_t)(16 * s + 8 * hi + e) * 2048; tr[s][e] = (short)tp[off]; ti[s][e] = (short)tp[off + 256]; }
        f32x16 o[4];
#pragma unroll
        for (int mt = 0; mt < 4; ++mt)
#pragma unroll
            for (int r = 0; r < 16; ++r) o[mt][r] = 0.f;
#pragma unroll
        for (int s = 0; s < 8; ++s)
#pragma unroll
            for (int mt = 0; mt < 4; ++mt) {
                const bf16x8 c = *(const bf16x8*)(Ct + (mt * 32 + r32) * FT_LD + 16 * s + 8 * hi);
                const bf16x8 sn = *(const bf16x8*)(St + (mt * 32 + r32) * FT_LD + 16 * s + 8 * hi);
                o[mt] = __builtin_amdgcn_mfma_f32_32x32x16_bf16(c, tr[s], o[mt], 0, 0, 0);
                o[mt] = __builtin_amdgcn_mfma_f32_32x32x16_bf16(sn, ti[s], o[mt], 0, 0, 0);
            }
#pragma unroll
        for (int mt = 0; mt < 4; ++mt)
#pragma unroll
            for (int r = 0; r < 16; ++r) {
                const int k = k1 + 128 * (mt * 32 + crow16(r, hi));
                BR[(size_t)k * 1024 + j] = f2bf(o[mt][r] * (1.f / 2048.f));
            }
    }
    __syncthreads();
}
DEV void qk_post(bf16_t* PROJ, const float* qg, const float* kg, float* lds) {
    __syncthreads();
    for (int e = ltid(); e < 320 * 16; e += blockDim.x) {
        const int pos = e >> 4, i = e & 15; const float inv = powf(10000.f, -((float)(2 * i) / 32.f));
        const float a = (float)(pos < 256 ? pos : pos - 256) * inv;
        lds[2 * e] = cosf(a); lds[2 * e + 1] = sinf(a);
    }
    __syncthreads();
    const size_t total = (size_t)S_ * 20 * 16;
    for (size_t idx = GTID; idx < total; idx += GSZ) {
        const int i = (int)(idx & 15), head = (int)((idx >> 4) % 20), t = (int)((idx >> 4) / 20);
        bf16_t* p = PROJ + (size_t)t * 3072 + head * 64;
        float a1 = bf2f(p[i]), a2 = bf2f(p[16 + i]), b1 = bf2f(p[32 + i]), b2 = bf2f(p[48 + i]);
        float ss = a1 * a1 + a2 * a2 + b1 * b1 + b2 * b2;
        ss += __shfl_xor(ss, 1); ss += __shfl_xor(ss, 2); ss += __shfl_xor(ss, 4); ss += __shfl_xor(ss, 8);
        const float r = 1.f / sqrtf(ss * (1.f / 64.f) + 1e-6f);
        const float* g = head < 16 ? qg : kg;
        a1 *= r * g[i]; a2 *= r * g[16 + i]; b1 *= r * g[32 + i]; b2 *= r * g[48 + i];
        const float sc = head < 16 ? C2 : 1.f;
        const float cr = lds[2 * (((t >> 6) << 4) + i)], sr = lds[2 * (((t >> 6) << 4) + i) + 1];
        const float cc = lds[2 * (((256 + (t & 63)) << 4) + i)], scn = lds[2 * (((256 + (t & 63)) << 4) + i) + 1];
        p[i] = f2bf((a1 * cr - a2 * sr) * sc); p[16 + i] = f2bf((a2 * cr + a1 * sr) * sc);
        p[32 + i] = f2bf((b1 * cc - b2 * scn) * sc); p[48 + i] = f2bf((b2 * cc + b1 * scn) * sc);
    }
    __syncthreads();
}
DEV void attn_naive(const bf16_t* PROJ, bf16_t* BR, float* lds) {
    const int nth = blockDim.x, qblocks = S_ / nth, items = 16 * qblocks;
    float* Ks = lds; float* Vs = lds + 64 * 64;
    for (int it = blockIdx.x; it < items; it += gridDim.x) {
        const int hq = it / qblocks, qb = it % qblocks, kvh = hq >> 2, t = qb * nth + ltid();
        float q[64], o[64]; float m = -1e30f, l = 0.f;
#pragma unroll
        for (int c = 0; c < 8; ++c) load8(PROJ + (size_t)t * 3072 + hq * 64 + c * 8, q + c * 8);
#pragma unroll
        for (int d = 0; d < 64; ++d) o[d] = 0.f;
        for (int k0 = 0; k0 < S_; k0 += 64) {
            __syncthreads();
            for (int e = ltid(); e < 64 * 8; e += nth) {
                const int r = e >> 3, c8 = e & 7; float tmp[8];
                load8(PROJ + (size_t)(k0 + r) * 3072 + 1024 + kvh * 64 + c8 * 8, tmp);
#pragma unroll
                for (int j = 0; j < 8; ++j) Ks[r * 64 + c8 * 8 + j] = tmp[j];
                load8(PROJ + (size_t)(k0 + r) * 3072 + 1280 + kvh * 64 + c8 * 8, tmp);
#pragma unroll
                for (int j = 0; j < 8; ++j) Vs[r * 64 + c8 * 8 + j] = tmp[j];
            }
            __syncthreads();
            for (int r = 0; r < 64; ++r) {
                float s = 0.f;
#pragma unroll
                for (int d = 0; d < 64; d += 4) { const f32x4 kk = *(const f32x4*)(Ks + r * 64 + d); s += q[d] * kk.x + q[d + 1] * kk.y + q[d + 2] * kk.z + q[d + 3] * kk.w; }
                if (s > m) { const float f = exp2f(m - s); l *= f;
#pragma unroll
                    for (int d = 0; d < 64; ++d) o[d] *= f;
                    m = s; }
                const float p = exp2f(s - m); l += p;
#pragma unroll
                for (int d = 0; d < 64; d += 4) { const f32x4 vv = *(const f32x4*)(Vs + r * 64 + d); o[d] += p * vv.x; o[d + 1] += p * vv.y; o[d + 2] += p * vv.z; o[d + 3] += p * vv.w; }
            }
        }
        const float rl = 1.f / l;
#pragma unroll
        for (int d = 0; d < 64; ++d) o[d] *= rl;
#pragma unroll
        for (int c = 0; c < 8; ++c) store8(BR + (size_t)t * 1024 + hq * 64 + c * 8, o + c * 8);
    }
    __syncthreads();
}
DEV void dil_naive(const bf16_t* QKV, float* OACC, float* ML, int g) {
    const int dil = g == 0 ? 1 : (g == 1 ? 4 : 16);
    const size_t total = (size_t)16 * S_;
    for (size_t idx = GTID; idx < total; idx += GSZ) {
        const int head = (int)(idx >> 14), t = (int)(idx & 16383);
        float q[64], o[64]; float m, l;
#pragma unroll
        for (int c = 0; c < 8; ++c) load8(QKV + (size_t)t * 3072 + head * 64 + c * 8, q + c * 8);
        if (g == 0) { m = -1e30f; l = 0.f;
#pragma unroll
            for (int d = 0; d < 64; ++d) o[d] = 0.f;
        } else {
            m = ML[((size_t)t * 16 + head) * 2]; l = ML[((size_t)t * 16 + head) * 2 + 1];
#pragma unroll
            for (int d = 0; d < 64; d += 4) { const f32x4 v = *(const f32x4*)(OACC + (size_t)t * 1024 + head * 64 + d); o[d] = v.x; o[d + 1] = v.y; o[d + 2] = v.z; o[d + 3] = v.w; }
        }
        for (int mm = -64; mm <= 64; ++mm) {
            const int tk = t + mm * dil;
            if (tk < 0 || tk >= S_) continue;
            const bf16_t* kp = QKV + (size_t)tk * 3072 + 1024 + head * 64;
            float s = 0.f;
#pragma unroll
            for (int c = 0; c < 8; ++c) { float kk[8]; load8(kp + c * 8, kk);
#pragma unroll
                for (int j = 0; j < 8; ++j) s += q[c * 8 + j] * kk[j]; }
            if (s > m) { const float f = exp2f(m - s); l *= f;
#pragma unroll
                for (int d = 0; d < 64; ++d) o[d] *= f;
                m = s; }
            const float p = exp2f(s - m); l += p;
#pragma unroll
            for (int c = 0; c < 8; ++c) { float vv[8]; load8(kp + 1024 + c * 8, vv);
#pragma unroll
                for (int j = 0; j < 8; ++j) o[c * 8 + j] += p * vv[j]; }
        }
        ML[((size_t)t * 16 + head) * 2] = m; ML[((size_t)t * 16 + head) * 2 + 1] = l;
#pragma unroll
        for (int d = 0; d < 64; d += 4) *(f32x4*)(OACC + (size_t)t * 1024 + head * 64 + d) = (f32x4){o[d], o[d + 1], o[d + 2], o[d + 3]};
    }
}

DEV void dil_mfma(const bf16_t* QKV, float* OACC, float* ML, int g) {
    const int sh = 2 * g, dil = 1 << sh, L = S_ >> sh, nqb = L >> 5;
    const int tid = ltid(), lane = tid & 63, r32 = lane & 31, hi = lane >> 5, wpb = blockDim.x >> 6;
    const int gw = blockIdx.x * wpb + (tid >> 6), nw = gridDim.x * wpb;
    for (int task = gw; task < 16 * 512; task += nw) {
        const int a = task % nqb, hc = task / nqb, c = hc & (dil - 1), head = hc >> sh;
        const int tq = ((32 * a + r32) << sh) + c;
        const bf16_t* qp = QKV + (size_t)tq * 3072 + head * 64 + 8 * hi;
        bf16x8 qf[4];
#pragma unroll
        for (int ks = 0; ks < 4; ++ks) qf[ks] = *(const bf16x8*)(qp + 16 * ks);
        f32x16 st[5];
#pragma unroll
        for (int kt = 0; kt < 5; ++kt) {
            int jj = 32 * a - 64 + 32 * kt + r32; jj = jj < 0 ? 0 : (jj > L - 1 ? L - 1 : jj);
            const bf16_t* kp = QKV + (size_t)((jj << sh) + c) * 3072 + 1024 + head * 64 + 8 * hi;
#pragma unroll
            for (int r = 0; r < 16; ++r) st[kt][r] = 0.f;
#pragma unroll
            for (int ks = 0; ks < 4; ++ks) st[kt] = __builtin_amdgcn_mfma_f32_32x32x16_bf16(*(const bf16x8*)(kp + 16 * ks), qf[ks], st[kt], 0, 0, 0);
        }
        float mx = -1e30f;
#pragma unroll
        for (int kt = 0; kt < 5; ++kt)
#pragma unroll
            for (int r = 0; r < 16; ++r) {
                const int kvl = 32 * kt + crow16(r, hi), jj = 32 * a - 64 + kvl;
                const bool valid = (kvl >= r32) && (kvl <= r32 + 128) && (jj >= 0) && (jj < L);
                const float v = valid ? st[kt][r] : -1e30f; st[kt][r] = v; mx = fmaxf(mx, v);
            }
        mx = fmaxf(mx, __shfl_xor(mx, 32));
        float m_old = -1e30f, l_old = 0.f;
        if (g != 0) { m_old = ML[((size_t)tq * 16 + head) * 2]; l_old = ML[((size_t)tq * 16 + head) * 2 + 1]; }
        const float m_new = fmaxf(m_old, mx), f = exp2f(m_old - m_new);
        float ls = 0.f;
#pragma unroll
        for (int kt = 0; kt < 5; ++kt)
#pragma unroll
            for (int r = 0; r < 16; ++r) { const float pv = exp2f(st[kt][r] - m_new); st[kt][r] = pv; ls += pv; }
        ls += __shfl_xor(ls, 32);
        const float l_new = l_old * f + ls;
        f32x16 o[2];
#pragma unroll
        for (int dt = 0; dt < 2; ++dt)
#pragma unroll
            for (int r = 0; r < 16; ++r) o[dt][r] = 0.f;
#pragma unroll
        for (int kt = 0; kt < 5; ++kt)
#pragma unroll
            for (int s = 0; s < 2; ++s) {
                bf16x8 pf;
#pragma unroll
                for (int e = 0; e < 8; ++e) pf[e] = (short)f2bf(st[kt][8 * s + e]);
                const bf16_t* vrow[8];
#pragma unroll
                for (int e = 0; e < 8; ++e) {
                    int jj = 32 * a - 64 + 32 * kt + 16 * s + (e & 3) + 8 * (e >> 2) + 4 * hi; jj = jj < 0 ? 0 : (jj > L - 1 ? L - 1 : jj);
                    vrow[e] = QKV + (size_t)((jj << sh) + c) * 3072 + 2048 + head * 64 + r32;
                }
#pragma unroll
                for (int dt = 0; dt < 2; ++dt) {
                    bf16x8 vf;
#pragma unroll
                    for (int e = 0; e < 8; ++e) vf[e] = (short)vrow[e][32 * dt];
                    o[dt] = __builtin_amdgcn_mfma_f32_32x32x16_bf16(vf, pf, o[dt], 0, 0, 0);
                }
            }
        float* op = OACC + (size_t)tq * 1024 + head * 64 + 4 * hi;
#pragma unroll
        for (int dt = 0; dt < 2; ++dt)
#pragma unroll
            for (int i = 0; i < 4; ++i) {
                f32x4 old = (f32x4){0.f, 0.f, 0.f, 0.f};
                if (g != 0) old = *(const f32x4*)(op + 32 * dt + 8 * i);
                const f32x4 nw4 = (f32x4){o[dt][4 * i], o[dt][4 * i + 1], o[dt][4 * i + 2], o[dt][4 * i + 3]};
                *(f32x4*)(op + 32 * dt + 8 * i) = old * f + nw4;
            }
        if (hi == 0) { ML[((size_t)tq * 16 + head) * 2] = m_new; ML[((size_t)tq * 16 + head) * 2 + 1] = l_new; }
    }
}
DEV void gate_naive(const bf16_t* BR, const float* OACC, const float* ML, const bf16_t* TAIL, int ldt, const float* MKV, bf16_t* YIN) {
    const size_t total = (size_t)S_ * 1024;
    for (size_t idx = GTID; idx < total; idx += GSZ) {
        const int c = (int)(idx & 1023), t = (int)(idx >> 10);
        const float br = OACC ? OACC[idx] / ML[((size_t)t * 16 + (c >> 6)) * 2 + 1] : bf2f(BR[idx]);
        const float gt = bf2f(TAIL[(size_t)t * ldt + c]);
        YIN[(size_t)t * 1280 + c] = f2bf(br * silu(gt));
    }
    const size_t total2 = (size_t)4 * S_;
    for (size_t idx = GTID; idx < total2; idx += GSZ) {
        const int mh = (int)(idx >> 14), t = (int)(idx & 16383);
        float q[64], o[64]; float m = -1e30f, l = 0.f;
#pragma unroll
        for (int c = 0; c < 8; ++c) load8(TAIL + (size_t)t * ldt + 1280 + mh * 64 + c * 8, q + c * 8);
#pragma unroll
        for (int d = 0; d < 64; ++d) { q[d] *= C2; o[d] = 0.f; }
        for (int mm = 0; mm < 256; ++mm) {
            const float* kp = MKV + (size_t)mm * 512 + mh * 64;
            float s = 0.f;
#pragma unroll
            for (int d = 0; d < 64; ++d) s += q[d] * kp[d];
            if (s > m) { const float f = exp2f(m - s); l *= f;
#pragma unroll
                for (int d = 0; d < 64; ++d) o[d] *= f;
                m = s; }
            const float p = exp2f(s - m); l += p;
#pragma unroll
            for (int d = 0; d < 64; ++d) o[d] += p * kp[256 + d];
        }
        const float rl = 1.f / l;
#pragma unroll
        for (int c = 0; c < 8; ++c) { float gt[8]; load8(TAIL + (size_t)t * ldt + 1024 + mh * 64 + c * 8, gt);
#pragma unroll
            for (int j = 0; j < 8; ++j) o[c * 8 + j] = o[c * 8 + j] * rl * silu(gt[j]); }
#pragma unroll
        for (int c = 0; c < 8; ++c) store8(YIN + (size_t)t * 1280 + 1024 + mh * 64 + c * 8, o + c * 8);
    }
}


#define LAS3 __attribute__((address_space(3)))
DEV void gemm_bf16(unsigned char* lds_raw, const bf16_t* A, int lda, const bf16_t* Bt, int M, int N, int K, bf16_t* C, int ldc, int G, int c) {
    pg8::Gemm g{A, Bt, M, N, K, lda}; pg8::StaticOrder So; So.init(M, N, G, c);
    pg8::EpiBf16<0> E{C, ldc, nullptr, 0, 0, 1.f};
    pg8::gemm_phase<pg8::EpiBf16<0>, pg8::StaticOrder, PG8_ALIGN, PG8_SP2>((LAS3 unsigned char*)lds_raw, g, So, E);
}
DEV void gemm_bf16_rope(unsigned char* lds_raw, const bf16_t* A, int lda, const bf16_t* Bt, int M, int N, int K, bf16_t* C, int ldc, const unsigned* rope, int G, int c) {
    pg8::Gemm g{A, Bt, M, N, K, lda}; pg8::StaticOrder So; So.init(M, N, G, c);
    pg8::EpiBf16Rope E{C, ldc, rope, C2};
    pg8::gemm_phase<pg8::EpiBf16Rope, pg8::StaticOrder, PG8_ALIGN, PG8_SP2>((LAS3 unsigned char*)lds_raw, g, So, E);
}
DEV void gemm_f32(unsigned char* lds_raw, const bf16_t* A, int lda, const bf16_t* Bt, int M, int N, int K, float* C, int ldc, int G, int c) {
    pg8::Gemm g{A, Bt, M, N, K, lda}; pg8::StaticOrder So; So.init(M, N, G, c);
    pg8::EpiF32 E{C, ldc};
    pg8::gemm_phase<pg8::EpiF32, pg8::StaticOrder, PG8_ALIGN, PG8_SP2>((LAS3 unsigned char*)lds_raw, g, So, E);
}

DEV void gate_fast(const bf16_t* BR, const float* OACC, const float* ML, const bf16_t* TAIL, int ldt, const bf16_t* MKb, const bf16_t* MVp, bf16_t* YIN) {
    if (BR || OACC) {
        const size_t total = (size_t)S_ * 128;
        for (size_t idx = GTID; idx < total; idx += GSZ) {
            const int c = (int)(idx & 127) * 8, t = (int)(idx >> 7);
            float br[8], gt[8];
            if (OACC) {
                const float rl = 1.f / ML[((size_t)t * 16 + (c >> 6)) * 2 + 1];
                const f32x4 a = *(const f32x4*)(OACC + (size_t)t * 1024 + c), b = *(const f32x4*)(OACC + (size_t)t * 1024 + c + 4);
                br[0] = a.x * rl; br[1] = a.y * rl; br[2] = a.z * rl; br[3] = a.w * rl; br[4] = b.x * rl; br[5] = b.y * rl; br[6] = b.z * rl; br[7] = b.w * rl;
            } else load8(BR + (size_t)t * 1024 + c, br);
            load8(TAIL + (size_t)t * ldt + c, gt);
#pragma unroll
            for (int e = 0; e < 8; ++e) br[e] *= silu(gt[e]);
            store8(YIN + (size_t)t * 1280 + c, br);
        }
    }
    const int tid = ltid(), lane = tid & 63, r32 = lane & 31, hi = lane >> 5, wpb = blockDim.x >> 6;
    const int gw = blockIdx.x * wpb + (tid >> 6), nw = gridDim.x * wpb;
    for (int task = gw; task < 512 * 4; task += nw) {
        const int tb = task >> 2, mh = task & 3, t = tb * 32 + r32;
        const bf16_t* trow = TAIL + (size_t)t * ldt;
        bf16x8 qf[4];
#pragma unroll
        for (int ks = 0; ks < 4; ++ks) qf[ks] = *(const bf16x8*)(trow + 1280 + mh * 64 + 16 * ks + 8 * hi);
        f32x16 st[8];
#pragma unroll
        for (int kt = 0; kt < 8; ++kt) {
#pragma unroll
            for (int r = 0; r < 16; ++r) st[kt][r] = 0.f;
            const bf16_t* kp = MKb + (size_t)(32 * kt + r32) * 256 + mh * 64 + 8 * hi;
#pragma unroll
            for (int ks = 0; ks < 4; ++ks) st[kt] = __builtin_amdgcn_mfma_f32_32x32x16_bf16(*(const bf16x8*)(kp + 16 * ks), qf[ks], st[kt], 0, 0, 0);
        }
        float mx = -1e30f;
#pragma unroll
        for (int kt = 0; kt < 8; ++kt)
#pragma unroll
            for (int r = 0; r < 16; ++r) mx = fmaxf(mx, st[kt][r]);
        mx = fmaxf(mx, __shfl_xor(mx, 32));
        float ls = 0.f;
#pragma unroll
        for (int kt = 0; kt < 8; ++kt)
#pragma unroll
            for (int r = 0; r < 16; ++r) { const float pv = exp2f((st[kt][r] - mx) * C2); st[kt][r] = pv; ls += pv; }
        ls += __shfl_xor(ls, 32);
        f32x16 o[2];
#pragma unroll
        for (int dt = 0; dt < 2; ++dt)
#pragma unroll
            for (int r = 0; r < 16; ++r) o[dt][r] = 0.f;
#pragma unroll
        for (int kt = 0; kt < 8; ++kt)
#pragma unroll
            for (int s = 0; s < 2; ++s) {
                bf16x8 pf;
#pragma unroll
                for (int e = 0; e < 8; ++e) pf[e] = (short)f2bf(st[kt][8 * s + e]);
#pragma unroll
                for (int dt = 0; dt < 2; ++dt) {
                    const bf16x8 vf = *(const bf16x8*)(MVp + (size_t)(((mh * 64 + 32 * dt + r32) * 8 + kt) * 2 + s) * 16 + hi * 8);
                    o[dt] = __builtin_amdgcn_mfma_f32_32x32x16_bf16(vf, pf, o[dt], 0, 0, 0);
                }
            }
        const float rl = 1.f / ls;
#pragma unroll
        for (int dt = 0; dt < 2; ++dt)
#pragma unroll
            for (int i = 0; i < 4; ++i) {
                const int d = 32 * dt + 8 * i + 4 * hi;
                const u32x2 gw2 = *(const u32x2*)(trow + 1024 + mh * 64 + d);
                const float g0 = __uint_as_float(gw2.x << 16), g1 = __uint_as_float(gw2.x & 0xffff0000u), g2 = __uint_as_float(gw2.y << 16), g3 = __uint_as_float(gw2.y & 0xffff0000u);
                u32x2 w; w.x = pk2(o[dt][4 * i] * rl * silu(g0), o[dt][4 * i + 1] * rl * silu(g1)); w.y = pk2(o[dt][4 * i + 2] * rl * silu(g2), o[dt][4 * i + 3] * rl * silu(g3));
                *(u32x2*)(YIN + (size_t)t * 1280 + 1024 + mh * 64 + d) = w;
            }
    }
}

#define LAS __attribute__((address_space(3)))
#define XB_TMO      128
#define XB_XCNT(j)  (256  + 64 * (j))
#define XB_XSUB(j)  (1280 + 64 * (j))
#define XB_XGEN(j)  (2304 + 64 * (j))
#define XB_TOP      3328
#define XB_TOPGEN   3392
#define XCD_BAR_WORDS 3456
#define XB_SPIN_CAP (1u << 18)

__device__ __forceinline__ unsigned xb_ld(unsigned* p)              { return __hip_atomic_load(p, __ATOMIC_RELAXED, __HIP_MEMORY_SCOPE_AGENT); }
__device__ __forceinline__ unsigned xb_add(unsigned* p, unsigned v) { return __hip_atomic_fetch_add(p, v, __ATOMIC_RELAXED, __HIP_MEMORY_SCOPE_AGENT); }
__device__ __forceinline__ unsigned xb_xcc_id() { return (unsigned)__builtin_amdgcn_s_getreg((3 << 11) | 20) & 0xFu; }
#define XB_SPIN(cond, bar) do { unsigned _sp = 0; while (cond) { __builtin_amdgcn_s_sleep(1); \
    if ((++_sp & 255u) == 0u) { if (xb_ld(&(bar)[XB_TMO])) break; if (_sp > XB_SPIN_CAP) { atomicAdd(&(bar)[XB_TMO], 1u); break; } } } } while (0)

struct XcdBarrier {
    unsigned* bar; unsigned x;
    volatile LAS unsigned* st;
};

__device__ __forceinline__ XcdBarrier xcd_barrier_post(unsigned* bar, volatile LAS unsigned* st) {
    XcdBarrier b; b.bar = bar; b.x = xb_xcc_id(); b.st = st;
    if (threadIdx.x == 0) (void)xb_add(&bar[XB_XCNT(b.x)], 1u);
    return b;
}
__device__ __forceinline__ void xcd_barrier_complete(unsigned* bar, unsigned x, unsigned& nloc, unsigned& nx) {
    const unsigned G = gridDim.x * gridDim.y * gridDim.z;
    unsigned sum, cnt, mine, sp = 0u;
    for (;;) {
        sum = 0u; cnt = 0u; mine = 0u;
#pragma unroll
        for (unsigned j = 0; j < 16; ++j) { const unsigned c = xb_ld(&bar[XB_XCNT(j)]); sum += c; cnt += (c > 0u) ? 1u : 0u; mine = (j == x) ? c : mine; }
        if (sum == G) break;
        __builtin_amdgcn_s_sleep(1);
        if ((++sp & 255u) == 0u) { if (xb_ld(&bar[XB_TMO])) break; if (sp > XB_SPIN_CAP) { atomicAdd(&bar[XB_TMO], 1u); break; } }
    }
    nloc = mine > 0u ? mine : 1u; nx = cnt > 0u ? cnt : 1u;
}

__device__ __forceinline__ void xcd_barrier(const XcdBarrier& b) {
    asm volatile("s_waitcnt vmcnt(0)" ::: "memory");
    __syncthreads();
    if (threadIdx.x == 0) {
        unsigned* bar = b.bar;
        __builtin_amdgcn_s_waitcnt(0);
        unsigned nloc = b.st[0], nx = b.st[1];
        if (nloc == 0u) { xcd_barrier_complete(bar, b.x, nloc, nx); b.st[0] = nloc; b.st[1] = nx; }
        const unsigned old = xb_add(&bar[XB_XSUB(b.x)], 1u);
        const unsigned gen = old / nloc;
        if (old + 1u == (gen + 1u) * nloc) {
            __builtin_amdgcn_fence(__ATOMIC_RELEASE, "agent");
            asm volatile("s_waitcnt vmcnt(0)" ::: "memory");
            const unsigned og = xb_add(&bar[XB_TOP], 1u);
            const unsigned tg = og / nx;
            if (og + 1u == (tg + 1u) * nx) xb_add(&bar[XB_TOPGEN], 1u);
            else XB_SPIN(xb_ld(&bar[XB_TOPGEN]) == tg, bar);
            __builtin_amdgcn_fence(__ATOMIC_ACQUIRE, "agent");
            xb_add(&bar[XB_XGEN(b.x)], 1u);
            asm volatile("s_waitcnt vmcnt(0)" ::: "memory");
        } else {
            XB_SPIN(xb_ld(&bar[XB_XGEN(b.x)]) == gen, bar);
            __builtin_amdgcn_fence(__ATOMIC_ACQUIRE, "agent");
            asm volatile("s_waitcnt vmcnt(0)" ::: "memory");
        }
    }
    __syncthreads();
}
DEV void seam(const Params& p, unsigned char* lds_raw) {
    unsigned char* w = p.ws; asm volatile("" : "+s"(w));
    XcdBarrier b; b.bar = (unsigned*)(w + 16384); b.st = (volatile LAS unsigned*)((LAS unsigned char*)lds_raw + (LDS_BYTES - 64)); b.x = b.st[2];
    xcd_barrier(b);
}
#define STEP_BEGIN { unsigned char* ws = p.ws; asm volatile("" : "+s"(ws)); float* H = p.out; float* lds = (float*)lds_raw;
#define STEP_END   } seam(p, lds_raw);
#define AR(off) (ws + WS_AR + (size_t)(off) * MiB)
#define P_WtA ((bf16_t*)(ws + WS_WA))
#define P_WtB ((bf16_t*)(ws + WS_WB))
#define P_WtC ((bf16_t*)(ws + WS_WC))
#define P_WtO ((bf16_t*)(ws + WS_WO))
#define P_Wdft ((bf16_t*)(ws + WS_WDFT))
#define P_MKB ((bf16_t*)(ws + WS_MKV))
#define P_MVP ((bf16_t*)(ws + WS_MKV + 131072))
#define P_XN ((bf16_t*)(ws + WS_XN))
#define P_ROPE ((unsigned*)(ws + 46 * MiB))
#define GC (int)gridDim.x, (int)blockIdx.x
#define LNG (p.ln_g + LAYER * 1024)
#define LNB (p.ln_b + LAYER * 1024)
#define WO (P_WtO + (size_t)LAYER * 1024 * 1280)

template <int LAYER> DEV void layer_A(const Params& p, unsigned char* lds_raw) {
    STEP_BEGIN
        gemm_bf16(lds_raw, P_XN, 1024, P_WtA + (size_t)(LAYER / 3) * 1536 * 1024, S_, 1536, 1024, (bf16_t*)AR(0), 1536, GC);
        if ((gridDim.x & 3) == 0) { const int g = blockIdx.x & 3; gemm_bf16(lds_raw, P_XN + g * 256, 1024, P_Wdft, S_, 512, 256, (bf16_t*)AR(48) + g * 512, 2048, (int)gridDim.x >> 2, (int)blockIdx.x >> 2); }
        else for (int g = 0; g < 4; ++g) gemm_bf16(lds_raw, P_XN + g * 256, 1024, P_Wdft, S_, 512, 256, (bf16_t*)AR(48) + g * 512, 2048, GC);
    STEP_END
    STEP_BEGIN fft_s1_mfma((bf16_t*)AR(48), (bf16_t*)AR(112), lds_raw); STEP_END
    STEP_BEGIN fft_s2_mfma((bf16_t*)AR(112), (bf16_t*)AR(48), lds_raw); STEP_END
    STEP_BEGIN gate_fast((bf16_t*)AR(48), nullptr, nullptr, (bf16_t*)AR(0), 1536, P_MKB, P_MVP, (bf16_t*)AR(80)); STEP_END
    STEP_BEGIN gemm_f32(lds_raw, (bf16_t*)AR(80), 1280, WO, S_, 1024, 1280, (float*)AR(0), 1024, GC); STEP_END
    STEP_BEGIN ln_rows(H, (float*)AR(0), ALPHA, LNG, LNB, H, P_XN); STEP_END
}
template <int LAYER> DEV void layer_B(const Params& p, unsigned char* lds_raw) {
    STEP_BEGIN gemm_bf16(lds_raw, P_XN, 1024, P_WtB, S_, 3072, 1024, (bf16_t*)AR(0), 3072, GC); STEP_END
    STEP_BEGIN qk_post((bf16_t*)AR(0), p.q_norm_g, p.k_norm_g, lds); STEP_END
    STEP_BEGIN
        bf16_t* PROJ = (bf16_t*)AR(0); bf16_t* BR = (bf16_t*)AR(96);
        if (gridDim.x == 256) {
            const attn_body::AttnTensors AT{(const attn_body::bf16*)PROJ, (const attn_body::bf16*)(PROJ + 1024), (const attn_body::bf16*)(PROJ + 1280), (attn_body::bf16*)BR};
            const attn_body::StaticOrder SA((int)gridDim.x, (int)blockIdx.x);
            attn_body::attn_phase<attn_body::StaticOrder>((char*)lds_raw, AT, SA);
        } else attn_naive(PROJ, BR, lds);
    STEP_END
    STEP_BEGIN gate_fast((bf16_t*)AR(96), nullptr, nullptr, (bf16_t*)AR(0) + 1536, 3072, P_MKB, P_MVP, (bf16_t*)AR(128)); STEP_END
    STEP_BEGIN gemm_f32(lds_raw, (bf16_t*)AR(128), 1280, WO, S_, 1024, 1280, (float*)AR(0), 1024, GC); STEP_END
    STEP_BEGIN ln_rows(H, (float*)AR(0), ALPHA, LNG, LNB, H, P_XN); STEP_END
}
template <int LAYER> DEV void layer_C(const Params& p, unsigned char* lds_raw) {
    for (int g = 0; g < 3; ++g) {
        STEP_BEGIN gemm_bf16_rope(lds_raw, P_XN, 1024, P_WtC + (size_t)g * 3072 * 1024, S_, 3072, 1024, (bf16_t*)AR(0), 3072, P_ROPE, GC); STEP_END
        STEP_BEGIN dil_mfma((bf16_t*)AR(0), (float*)AR(96), (float*)AR(160), g); STEP_END
    }
    STEP_BEGIN gemm_bf16(lds_raw, P_XN, 1024, P_WtC + (size_t)9216 * 1024, S_, 1536, 1024, (bf16_t*)AR(0), 1536, GC); STEP_END
    STEP_BEGIN gate_fast(nullptr, (float*)AR(96), (float*)AR(160), (bf16_t*)AR(0), 1536, P_MKB, P_MVP, (bf16_t*)AR(48)); STEP_END
    STEP_BEGIN gemm_f32(lds_raw, (bf16_t*)AR(48), 1280, WO, S_, 1024, 1280, (float*)AR(96), 1024, GC); STEP_END
    STEP_BEGIN ln_rows(H, (float*)AR(96), ALPHA, LNG, LNB, H, P_XN); STEP_END
}

__global__ void __launch_bounds__(NTHREADS, 2) mk(Params p) {
    extern __shared__ __attribute__((aligned(16))) unsigned char lds_raw[];
    cg::grid_group grid = cg::this_grid();
    volatile LAS unsigned* bst = (volatile LAS unsigned*)((LAS unsigned char*)lds_raw + (LDS_BYTES - 64));
    if (threadIdx.x < 16) bst[threadIdx.x] = 0u;
    __syncthreads();
    { const XcdBarrier b0 = xcd_barrier_post((unsigned*)(p.ws + 16384), bst); if (threadIdx.x == 0) bst[2] = b0.x; }
    __syncthreads();
    STEP_BEGIN
        tconv(p.w_in_a, 1024, 1536, 1536, P_WtA, 0);
        tconv(p.w_in_a + (size_t)1024 * 1536, 1024, 1536, 1536, P_WtA + (size_t)1536 * 1024, 0);
        tconv(p.w_in_b, 1024, 3072, 3072, P_WtB, 0);
        tconv(p.w_in_c, 1024, 10752, 10752, P_WtC, 1);
        for (int i = 0; i < 4; ++i) tconv(p.w_out + (size_t)i * 1280 * 1024, 1280, 1024, 1024, P_WtO + (size_t)i * 1024 * 1280, 0);
        make_wdft(P_Wdft);
        make_rope1d(P_ROPE);
        make_mkv(p.mem, p.w_mem_kv, P_MKB, P_MVP);
        ln_rows(p.x, nullptr, 1.f, p.ln_in_g, p.ln_in_b, H, P_XN);
    } grid.sync();
    layer_A<0>(p, lds_raw);
    layer_B<1>(p, lds_raw);
    layer_C<2>(p, lds_raw);
    layer_A<3>(p, lds_raw);
}

extern "C" void kernel_launch(void* const* d_in, const int* in_sizes, int n_in, void* d_out, int out_size, void* d_ws, size_t ws_size, hipStream_t stream) {
    if (n_in != 13 || ws_size < 256 * MiB) { fprintf(stderr, "kernel_launch: unexpected inputs (n_in %d, ws %zu)\n", n_in, ws_size); return; }
    Params p{};
    p.x = (const float*)d_in[0]; p.mem = (const float*)d_in[1]; p.ln_in_g = (const float*)d_in[2]; p.ln_in_b = (const float*)d_in[3];
    p.w_mem_kv = (const float*)d_in[4]; p.w_in_a = (const float*)d_in[5]; p.w_in_b = (const float*)d_in[6]; p.q_norm_g = (const float*)d_in[7];
    p.k_norm_g = (const float*)d_in[8]; p.w_in_c = (const float*)d_in[9]; p.w_out = (const float*)d_in[10]; p.ln_g = (const float*)d_in[11]; p.ln_b = (const float*)d_in[12];
    p.out = (float*)d_out; p.ws = (unsigned char*)d_ws;
    static int grid_blocks = 0;
    if (!grid_blocks) {
        int dev = 0, cus = 0, per_cu = 0;
        hipGetDevice(&dev);
        hipDeviceGetAttribute(&cus, hipDeviceAttributeMultiprocessorCount, dev);
        hipFuncSetAttribute((const void*)mk, hipFuncAttributeMaxDynamicSharedMemorySize, LDS_BYTES);
        hipOccupancyMaxActiveBlocksPerMultiprocessor(&per_cu, (const void*)mk, NTHREADS, LDS_BYTES);
        if (per_cu < 1) per_cu = 1;
        grid_blocks = cus * per_cu;
    }
    p.s0 = 0; p.s1 = NSTEPS;
    hipMemsetAsync(d_ws, 0, 65536, stream);
    void* args[] = {&p};
    hipError_t e = hipLaunchCooperativeKernel((const void*)mk, dim3(grid_blocks), dim3(NTHREADS), args, LDS_BYTES, stream);
    if (e != hipSuccess) fprintf(stderr, "cooperative launch failed: %s (grid %d)\n", hipGetErrorString(e), grid_blocks);
}
```
